# Optimizing an MI355X kernel written in HIP

```python
import math
import jax, jax.numpy as jnp
from jax import lax
import numpy as np

D_MODEL = 1024
BATCH = 2
SEQ = 8192
DEPTH = 2

GRID_W = 64
CTX_LEN = 256
N_MIXERS = 2
N_SUB = 3
MACARON_WEIGHT = 0.5
FFN_HIDDEN = 2816
RMS_EPS = 1e-6
S5_GROUP = 16
S5_GROUPS = D_MODEL // S5_GROUP
S5_STATE = 64
S5_MIN_NEG_RE = -1e-4
NA_HEADS = 16
NA_HEAD_DIM = D_MODEL // NA_HEADS
WIN_H = 8
WIN_W = 16
N_SSM_LAYERS = (DEPTH + 1) // 2
N_NA_LAYERS = DEPTH // 2

kernel_name = "hybrid_s5_natten_macaron_dit"

F32 = jnp.float32


def _rms_norm(x, g):
    xf = x.astype(F32)
    y = xf * lax.rsqrt(jnp.mean(xf * xf, axis=-1, keepdims=True) + RMS_EPS)
    return (y * g.astype(F32)).astype(x.dtype)


def _modulate(x, g, shift, scale):
    return _rms_norm(x, g) * (1 + scale) + shift


def _swiglu(h, w_in, w_out):
    gate, up = jnp.split(h @ w_in, 2, axis=-1)
    return (jax.nn.silu(gate) * up) @ w_out


def _cmul(ar, ai, br, bi):
    return ar * br - ai * bi, ar * bi + ai * br


def _zoh(lam_re, lam_im, log_step, b_re, b_im):
    lr = jnp.minimum(lam_re.astype(F32), S5_MIN_NEG_RE)
    li = lam_im.astype(F32)
    dt = jnp.exp(log_step.astype(F32))[:, None]
    mag = jnp.exp(lr * dt)
    ar = mag * jnp.cos(li * dt)
    ai = mag * jnp.sin(li * dt)
    den = lr * lr + li * li
    cr = ((ar - 1) * lr + ai * li) / den
    ci = (ai * lr - (ar - 1) * li) / den
    bbr, bbi = _cmul(cr[..., None], ci[..., None], b_re.astype(F32), b_im.astype(F32))
    return ar, ai, bbr, bbi


def _scan_op(e1, e2):
    a1r, a1i, b1r, b1i = e1
    a2r, a2i, b2r, b2i = e2
    ar, ai = _cmul(a2r, a2i, a1r, a1i)
    tr, ti = _cmul(a2r, a2i, b1r, b1i)
    return ar, ai, tr + b2r, ti + b2i


def _ssm_scan(u, ar, ai, bbr, bbi, h0, reverse):
    bur = jnp.einsum('blgh,gph->blgp', u, bbr)
    bui = jnp.einsum('blgh,gph->blgp', u, bbi)
    if h0 is not None:
        sr, si = _cmul(ar, ai, h0[0], h0[1])
        t0 = -1 if reverse else 0
        bur = bur.at[:, t0].add(sr)
        bui = bui.at[:, t0].add(si)
    a_r = jnp.broadcast_to(ar, bur.shape)
    a_i = jnp.broadcast_to(ai, bur.shape)
    _, _, xr, xi = lax.associative_scan(_scan_op, (a_r, a_i, bur, bui), reverse=reverse, axis=1)
    return xr, xi


def _ssm_readout(xr, xi, c_re, c_im):
    return jnp.einsum('blgp,ghp->blgh', xr, c_re) - jnp.einsum('blgp,ghp->blgh', xi, c_im)


def _glu(y, w_glu):
    g = jax.nn.gelu(y)
    a, b = jnp.split(g @ w_glu, 2, axis=-1)
    return a * jax.nn.sigmoid(b)


def _s5_mixer(h, hc, w_in, lam_re, lam_im, log_step, b_re, b_im, c_re, c_im, d_skip, w_glu, need_ctx_out):
    bsz, seq_len, _ = h.shape
    clen = hc.shape[1]
    u = (h @ w_in).astype(F32).reshape(bsz, seq_len, S5_GROUPS, S5_GROUP)
    uc = (hc @ w_in).astype(F32).reshape(bsz, clen, S5_GROUPS, S5_GROUP)
    d = d_skip.astype(F32).reshape(S5_GROUPS, S5_GROUP)
    y = u * d
    yc = uc * d if need_ctx_out else None
    for dirn, rev in enumerate((False, True)):
        ar, ai, bbr, bbi = _zoh(lam_re[dirn], lam_im[dirn], log_step[dirn], b_re[dirn], b_im[dirn])
        cr = c_re[dirn].astype(F32)
        ci = c_im[dirn].astype(F32)
        xcr, xci = _ssm_scan(uc, ar, ai, bbr, bbi, None, rev)
        last = 0 if rev else -1
        xr, xi = _ssm_scan(u, ar, ai, bbr, bbi, (xcr[:, last], xci[:, last]), rev)
        y = y + _ssm_readout(xr, xi, cr, ci)
        if need_ctx_out:
            yc = yc + _ssm_readout(xcr, xci, cr, ci)
    out = _glu(y.reshape(bsz, seq_len, D_MODEL).astype(h.dtype), w_glu)
    out_c = _glu(yc.reshape(bsz, clen, D_MODEL).astype(hc.dtype), w_glu) if need_ctx_out else None
    return out, out_c


def _na_mixer(h, hc, w_qkv, q_g, k_g, rpb, w_o, need_ctx_out):
    bsz, seq_len, _ = h.shape
    clen = hc.shape[1]
    rows = seq_len // GRID_W
    kh = min(WIN_H, rows)
    scale = NA_HEAD_DIM ** -0.5
    qkv = (h @ w_qkv).reshape(bsz, seq_len, 3, NA_HEADS, NA_HEAD_DIM)
    q = _rms_norm(qkv[:, :, 0], q_g)
    k = _rms_norm(qkv[:, :, 1], k_g)
    v = qkv[:, :, 2]
    qkv_c = (hc @ w_qkv).reshape(bsz, clen, 3, NA_HEADS, NA_HEAD_DIM)
    kc = _rms_norm(qkv_c[:, :, 1], k_g)
    vc = qkv_c[:, :, 2]

    grid = (bsz, rows, GRID_W, NA_HEADS, NA_HEAD_DIM)
    qg, kg, vg = q.reshape(grid), k.reshape(grid), v.reshape(grid)
    r = jnp.arange(rows)
    rs = jnp.clip(r - kh // 2, 0, rows - kh)
    row_idx = rs[:, None] + jnp.arange(kh)[None, :]
    k_band = kg[:, row_idx]
    v_band = vg[:, row_idx]
    s_loc = jnp.einsum('brqhd,brikhd->bhrqik', qg, k_band, preferred_element_type=F32) * scale

    wcol = jnp.arange(GRID_W)
    cs = jnp.clip(wcol - WIN_W // 2, 0, GRID_W - WIN_W)
    col_valid = (wcol[None, :] >= cs[:, None]) & (wcol[None, :] < cs[:, None] + WIN_W)
    row_bias_idx = row_idx - r[:, None] + WIN_H - 1
    col_bias_idx = jnp.clip(wcol[None, :] - wcol[:, None] + WIN_W - 1, 0, 2 * WIN_W - 2)
    bias = rpb[:, row_bias_idx[:, None, :, None], col_bias_idx[None, :, None, :]]
    s_loc = jnp.where(col_valid[:, None, :], s_loc + bias.astype(F32), -jnp.inf)

    s_ctx = jnp.einsum('brqhd,bchd->bhrqc', qg, kc, preferred_element_type=F32) * scale
    n_loc = kh * GRID_W
    scores = jnp.concatenate([s_loc.reshape(bsz, NA_HEADS, rows, GRID_W, n_loc), s_ctx], axis=-1)
    p = jax.nn.softmax(scores, axis=-1)
    p_loc = p[..., :n_loc].reshape(bsz, NA_HEADS, rows, GRID_W, kh, GRID_W).astype(v.dtype)
    p_ctx = p[..., n_loc:].astype(v.dtype)
    o = (jnp.einsum('bhrqik,brikhd->brqhd', p_loc, v_band)
         + jnp.einsum('bhrqc,bchd->brqhd', p_ctx, vc))
    out = o.reshape(bsz, seq_len, D_MODEL) @ w_o

    out_c = None
    if need_ctx_out:
        qc = _rms_norm(qkv_c[:, :, 0], q_g)
        s_cc = jnp.einsum('bqhd,bkhd->bhqk', qc, kc, preferred_element_type=F32) * scale
        p_cc = jax.nn.softmax(s_cc, axis=-1).astype(vc.dtype)
        oc = jnp.einsum('bhqk,bkhd->bqhd', p_cc, vc)
        out_c = oc.reshape(bsz, clen, D_MODEL) @ w_o
    return out, out_c


def setup_inputs(seed: int = 0) -> dict:
    key = jax.random.key(seed)
    ks = jax.random.split(key, 24)
    D = D_MODEL
    F = FFN_HIDDEN
    G, P, GS = S5_GROUPS, S5_STATE, S5_GROUP

    def nrm(k, shape, s):
        return jax.random.normal(k, shape, F32) * s

    n = jnp.arange(P, dtype=F32)
    return {
        "x": nrm(ks[0], (BATCH, SEQ, D), 1.0),
        "c": nrm(ks[1], (BATCH, D), 1.0),
        "ctx": nrm(ks[2], (BATCH, CTX_LEN, D), 1.0),
        "c_ctx": nrm(ks[3], (D,), 1.0),
        "norm_g": 1.0 + nrm(ks[4], (DEPTH, N_SUB, D), 0.02),
        "ada_w": nrm(ks[5], (DEPTH, D, N_SUB * 3 * D), 0.5 * D ** -0.5),
        "ada_b": nrm(ks[6], (DEPTH, N_SUB * 3 * D), 0.02),
        "ffn_w_in": nrm(ks[7], (DEPTH, 2, D, 2 * F), D ** -0.5),
        "ffn_w_out": nrm(ks[8], (DEPTH, 2, F, D), F ** -0.5),
        "ssm_w_in": nrm(ks[9], (N_SSM_LAYERS, D, D), D ** -0.5),
        "ssm_lambda_re": -0.5 + nrm(ks[10], (N_SSM_LAYERS, 2, G, P), 0.01),
        "ssm_lambda_im": math.pi * n + nrm(ks[11], (N_SSM_LAYERS, 2, G, P), 0.01),
        "ssm_log_step": jax.random.uniform(ks[12], (N_SSM_LAYERS, 2, G), F32, math.log(1e-3), math.log(1e-1)),
        "ssm_b_re": nrm(ks[13], (N_SSM_LAYERS, 2, G, P, GS), (2 * GS) ** -0.5),
        "ssm_b_im": nrm(ks[14], (N_SSM_LAYERS, 2, G, P, GS), (2 * GS) ** -0.5),
        "ssm_c_re": nrm(ks[15], (N_SSM_LAYERS, 2, G, GS, P), P ** -0.5),
        "ssm_c_im": nrm(ks[16], (N_SSM_LAYERS, 2, G, GS, P), P ** -0.5),
        "ssm_d": nrm(ks[17], (N_SSM_LAYERS, D), 1.0),
        "ssm_w_glu": nrm(ks[18], (N_SSM_LAYERS, D, 2 * D), D ** -0.5),
        "na_w_qkv": nrm(ks[19], (N_NA_LAYERS, D, 3 * D), D ** -0.5),
        "na_q_norm": 1.0 + nrm(ks[20], (N_NA_LAYERS, NA_HEAD_DIM), 0.02),
        "na_k_norm": 1.0 + nrm(ks[21], (N_NA_LAYERS, NA_HEAD_DIM), 0.02),
        "na_rpb": nrm(ks[22], (N_NA_LAYERS, NA_HEADS, 2 * WIN_H - 1, 2 * WIN_W - 1), 0.02),
        "na_w_o": nrm(ks[23], (N_NA_LAYERS, D, D), D ** -0.5),
    }


def reference(x, c, ctx, c_ctx, norm_g, ada_w, ada_b, ffn_w_in, ffn_w_out,
              ssm_w_in, ssm_lambda_re, ssm_lambda_im, ssm_log_step, ssm_b_re, ssm_b_im,
              ssm_c_re, ssm_c_im, ssm_d, ssm_w_glu,
              na_w_qkv, na_q_norm, na_k_norm, na_rpb, na_w_o):
    D = D_MODEL
    sc = jax.nn.silu(c)
    scc = jax.nn.silu(c_ctx)
    for i in range(DEPTH):
        last = i == DEPTH - 1
        m = (sc @ ada_w[i] + ada_b[i]).reshape(-1, N_SUB, 3, D)[:, :, :, None, :]
        mc = (scc @ ada_w[i] + ada_b[i]).reshape(N_SUB, 3, D)

        h = _modulate(x, norm_g[i, 0], m[:, 0, 0], m[:, 0, 1])
        x = x + MACARON_WEIGHT * m[:, 0, 2] * _swiglu(h, ffn_w_in[i, 0], ffn_w_out[i, 0])
        hc = _modulate(ctx, norm_g[i, 0], mc[0, 0], mc[0, 1])
        ctx = ctx + MACARON_WEIGHT * mc[0, 2] * _swiglu(hc, ffn_w_in[i, 0], ffn_w_out[i, 0])

        h = _modulate(x, norm_g[i, 1], m[:, 1, 0], m[:, 1, 1])
        hc = _modulate(ctx, norm_g[i, 1], mc[1, 0], mc[1, 1])
        j = i // N_MIXERS
        if i % N_MIXERS == 0:
            y, yc = _s5_mixer(h, hc, ssm_w_in[j], ssm_lambda_re[j], ssm_lambda_im[j], ssm_log_step[j],
                              ssm_b_re[j], ssm_b_im[j], ssm_c_re[j], ssm_c_im[j], ssm_d[j], ssm_w_glu[j],
                              not last)
        else:
            y, yc = _na_mixer(h, hc, na_w_qkv[j], na_q_norm[j], na_k_norm[j], na_rpb[j], na_w_o[j],
                              not last)
        x = x + m[:, 1, 2] * y

        h = _modulate(x, norm_g[i, 2], m[:, 2, 0], m[:, 2, 1])
        x = x + MACARON_WEIGHT * m[:, 2, 2] * _swiglu(h, ffn_w_in[i, 1], ffn_w_out[i, 1])
        if not last:
            ctx = ctx + mc[1, 2] * yc
            hc = _modulate(ctx, norm_g[i, 2], mc[2, 0], mc[2, 1])
            ctx = ctx + MACARON_WEIGHT * mc[2, 2] * _swiglu(hc, ffn_w_in[i, 1], ffn_w_out[i, 1])
    return x
```

```cpp
#include <hip/hip_runtime.h>
#include <hip/hip_cooperative_groups.h>
#include <cstdio>
#include <cstdint>
namespace cg = cooperative_groups;

#ifndef REP_S5
#define REP_S5 1
#endif
#ifndef REP_ATTN
#define REP_ATTN 1
#endif
#ifndef REP_FFNIN
#define REP_FFNIN 1
#endif
#ifndef REP_NORM
#define REP_NORM 1
#endif
#ifndef REP_CONV
#define REP_CONV 1
#endif
#ifndef MK_COOP
#define MK_COOP 1
#endif

#define LAS __attribute__((address_space(3)))
typedef _Float16 f16;
typedef f16 f16x8 __attribute__((ext_vector_type(8)));
typedef f16 f16x4 __attribute__((ext_vector_type(4)));
typedef f16 f16x2 __attribute__((ext_vector_type(2)));
typedef float f32x4 __attribute__((ext_vector_type(4)));
typedef float f32x2 __attribute__((ext_vector_type(2)));
typedef unsigned u32x4 __attribute__((ext_vector_type(4)));
typedef unsigned u32x2 __attribute__((ext_vector_type(2)));
typedef unsigned short u16;

constexpr int D = 1024, SEQ = 8192, NB = 2, CTX = 256, FH = 2816;
constexpr int MLAT = NB * SEQ;
constexpr int MALL = MLAT + NB * CTX;
constexpr int NCH = 132;
constexpr float EPS = 1e-6f;

constexpr size_t MiB = 1u << 20;
constexpr size_t WS_MOD = 0;
constexpr size_t MOD_BYTES = 262144;
constexpr size_t WS_BAR = 229376;
constexpr size_t WS_LAM = 262144;
constexpr size_t WS_LAMT = WS_LAM + 65536;
constexpr size_t WS_BMAT = WS_LAMT + 65536;
constexpr size_t WS_CMAT = WS_BMAT + 524288;
constexpr size_t WS_WFI = 2 * MiB;
constexpr size_t WFI_SZ = (size_t)5632 * 1024 * 2;
constexpr size_t WS_WFO = WS_WFI + 4 * WFI_SZ;
constexpr size_t WFO_SZ = (size_t)1024 * 2816 * 2;
constexpr size_t WS_WSI = WS_WFO + 4 * WFO_SZ;
constexpr size_t WS_WGLU = WS_WSI + 2 * MiB;
constexpr size_t WS_WQKV = WS_WGLU + 4 * MiB;
constexpr size_t WS_WO = WS_WQKV + 6 * MiB;
constexpr size_t WS_X = 82 * MiB;
constexpr size_t WS_H16 = 148 * MiB;
constexpr size_t WS_R = 181 * MiB;
constexpr size_t WS_HID = WS_R;
constexpr size_t WS_U16 = WS_R;
constexpr size_t WS_G16 = WS_R + 33 * MiB;
constexpr size_t WS_E = WS_R + 66 * MiB;
constexpr size_t WS_CIN = WS_R + 83 * MiB;
constexpr size_t WS_Q16 = WS_R;
constexpr size_t WS_K16 = WS_R + 33 * MiB;
constexpr size_t WS_V16 = WS_R + 66 * MiB;
constexpr size_t WS_VT = WS_R + 99 * MiB;
constexpr size_t WS_VTC = WS_R + 131 * MiB;
constexpr size_t WS_SS = WS_CMAT + 524288;
constexpr size_t WS_GS = WS_SS + (size_t)6 * 16896 * 4;
constexpr size_t WS_BIAS = 313 * MiB;
constexpr size_t WS_END = 314 * MiB;
static_assert(WS_GS + 6 * 3 * 1024 * 4 <= 2 * MiB, "small tables below the weights");
static_assert(WS_WO + 2 * MiB == WS_X, "weights end at X");

constexpr int LDS_BYTES = 163840;
constexpr int NPHASE = 24;

namespace pg8 {
constexpr int BM = 256, BK = 64, HALF = 128, HTB = HALF * BK * 2, STAGE_BYTES = 8 * HTB, NXCD = 8, WGM = 8;
__host__ __device__ __forceinline__ int lds_byte(int r, int c) { const int st = (r >> 4) * 2 + (c >> 5), rr = r & 15, cc = c & 31, ob = rr * 64 + cc * 2; return st * 1024 + (ob ^ (((ob >> 9) & 1) << 5)); }
__host__ __device__ __forceinline__ void stage_rc(int b, int& R, int& C) { const int st = b / 1024, sb = b % 1024, swz = sb ^ (((sb >> 9) & 1) << 5); R = (st >> 1) * 16 + swz / 64; C = (st & 1) * 32 + (swz % 64) / 2; }
__host__ __device__ __forceinline__ int perm32(int rho) { const int n = rho >> 4, i = rho & 15; return 8 * (i >> 2) + 4 * n + (i & 3); }

struct Unit { int pm, pn; };
struct Gemm { const u16* A; const u16* Bt; int M, N, K; };

struct StaticOrder {
    int nM, nN, nwg, G, c;
    __device__ void init(int M, int N, int G_, int c_) { nM = M / BM; nN = N / BM; nwg = nM * nN; G = G_; c = c_; }
    __device__ bool next(int i, Unit& u) const {
        const long L = (long)i * G + c; if (L >= nwg) return false;
        int wgid = (int)L; { const int q = nwg / NXCD, r = nwg % NXCD, xcd = wgid % NXCD, off = wgid / NXCD; wgid = (xcd < r ? xcd * (q + 1) : r * (q + 1) + (xcd - r) * q) + off; }
        const int nig = WGM * nN, gid = wgid / nig, fm = gid * WGM, gsz = (nM - fm) < WGM ? (nM - fm) : WGM;
        u.pm = fm + ((wgid % nig) % gsz); u.pn = (wgid % nig) / gsz; return true;
    }
};

__device__ __forceinline__ unsigned pk2h(float a, float b) { f16x2 v; v.x = (f16)a; v.y = (f16)b; return __builtin_bit_cast(unsigned, v); }
__device__ __forceinline__ float sigmoidf_(float x) { return __builtin_amdgcn_rcpf(1.0f + __expf(-x)); }

struct Epi {
    static constexpr bool PERM = true;
    f16* O16; size_t split_stride;
    const float* Xs; float* Xd; const float* gate;
    const float* ss; const float* bias;
    f16* An; const float* gsn; float* ssn;
    int mode;
    int ldo; int split_cols; float coef;
    __device__ __forceinline__ void operator()(const f32x4 (&acc)[2][2][4][2], const Unit& u, int wr, int wc, int fr, int fq) const {
        const int row0 = u.pm * BM + wr * 64 + fr;
        const int rowt = u.pm * BM; const int mi = rowt < SEQ ? 0 : (rowt < MLAT ? 1 : 2);
        if (mode == 0) {
            int colt = u.pn * BM; f16* base = O16;
            const float* bp = bias + mi * 5632 + colt + wc * 32 + 8 * fq;
            if (split_cols) { const int t = colt / split_cols; base += (size_t)t * split_stride; colt -= t * split_cols; }
            const int col0 = colt + wc * 32 + 8 * fq;
            f32x4 bv[2][2];
#pragma unroll
            for (int bj = 0; bj < 2; ++bj)
#pragma unroll
                for (int n = 0; n < 2; ++n) bv[bj][n] = *(const f32x4*)(bp + bj * HALF + 4 * n);
#pragma unroll
            for (int ai = 0; ai < 2; ++ai)
#pragma unroll
                for (int m = 0; m < 4; ++m) { const int row = row0 + ai * HALF + m * 16; f16* rowp = base + (size_t)row * ldo + col0;
                    const float rinv = __builtin_amdgcn_rsqf(ss[row] * (1.0f / 1024.0f) + 1e-6f);
#pragma unroll
                    for (int bj = 0; bj < 2; ++bj) { const f32x4 v0 = acc[ai][bj][m][0] * rinv + bv[bj][0], v1 = acc[ai][bj][m][1] * rinv + bv[bj][1];
                        u32x4 w; w.x = pk2h(v0[0], v0[1]); w.y = pk2h(v0[2], v0[3]); w.z = pk2h(v1[0], v1[1]); w.w = pk2h(v1[2], v1[3]);
                        *(u32x4*)(rowp + bj * HALF) = w; } }
        } else if (mode == 1) {
            const int col0 = u.pn * HALF + wc * 32 + 8 * fq;
            const float* bp = bias + mi * 5632 + u.pn * BM + wc * 32 + 8 * fq;
            f32x4 bv[2][2];
#pragma unroll
            for (int bj = 0; bj < 2; ++bj)
#pragma unroll
                for (int n = 0; n < 2; ++n) bv[bj][n] = *(const f32x4*)(bp + bj * HALF + 4 * n);
#pragma unroll
            for (int ai = 0; ai < 2; ++ai)
#pragma unroll
                for (int m = 0; m < 4; ++m) { const int row = row0 + ai * HALF + m * 16; f16* rowp = O16 + (size_t)row * ldo + col0;
                    const float rinv = __builtin_amdgcn_rsqf(ss[row] * (1.0f / 1024.0f) + 1e-6f);
                    float h[8];
#pragma unroll
                    for (int n = 0; n < 2; ++n)
#pragma unroll
                        for (int e = 0; e < 4; ++e) { const float g = acc[ai][0][m][n][e] * rinv + bv[0][n][e], up = acc[ai][1][m][n][e] * rinv + bv[1][n][e]; h[n * 4 + e] = g * sigmoidf_(g) * up; }
                    u32x4 w; w.x = pk2h(h[0], h[1]); w.y = pk2h(h[2], h[3]); w.z = pk2h(h[4], h[5]); w.w = pk2h(h[6], h[7]);
                    *(u32x4*)rowp = w; }
        } else {
            const float* gp = gate + mi * 9216;
            if (mode == 2) {
                const int col0 = u.pn * BM + wc * 32 + 8 * fq;
                f32x4 gv[2][2], gs[2][2];
#pragma unroll
                for (int bj = 0; bj < 2; ++bj)
#pragma unroll
                    for (int n = 0; n < 2; ++n) { gv[bj][n] = *(const f32x4*)(gp + col0 + bj * HALF + 4 * n) * coef;
                        gs[bj][n] = *(const f32x4*)(gsn + mi * 1024 + col0 + bj * HALF + 4 * n); }
#pragma unroll
                for (int ai = 0; ai < 2; ++ai)
#pragma unroll
                    for (int m = 0; m < 4; ++m) { const int row = row0 + ai * HALF + m * 16; const size_t off = (size_t)row * D + col0; float sq = 0.f;
#pragma unroll
                        for (int bj = 0; bj < 2; ++bj) { f32x4 xn[2];
#pragma unroll
                            for (int n = 0; n < 2; ++n) { const f32x4 xs = *(const f32x4*)(Xs + off + bj * HALF + 4 * n);
                                xn[n] = xs + gv[bj][n] * acc[ai][bj][m][n];
                                *(f32x4*)(Xd + off + bj * HALF + 4 * n) = xn[n];
                                sq += (xn[n][0] * xn[n][0] + xn[n][1] * xn[n][1]) + (xn[n][2] * xn[n][2] + xn[n][3] * xn[n][3]); }
                            if (An) { const f32x4 a0 = xn[0] * gs[bj][0], a1 = xn[1] * gs[bj][1];
                                u32x4 w; w.x = pk2h(a0[0], a0[1]); w.y = pk2h(a0[2], a0[3]); w.z = pk2h(a1[0], a1[1]); w.w = pk2h(a1[2], a1[3]);
                                *(u32x4*)(An + off + bj * HALF) = w; } }
                        if (An) { sq += __shfl_xor(sq, 16); sq += __shfl_xor(sq, 32); if (fq == 0) atomicAdd(ssn + row, sq); } }
            } else {
                const int col0 = u.pn * HALF + wc * 32 + 8 * fq;
                f32x4 gv[2], gs[2];
#pragma unroll
                for (int n = 0; n < 2; ++n) { gv[n] = *(const f32x4*)(gp + col0 + 4 * n); gs[n] = *(const f32x4*)(gsn + mi * 1024 + col0 + 4 * n); }
#pragma unroll
                for (int ai = 0; ai < 2; ++ai)
#pragma unroll
                    for (int m = 0; m < 4; ++m) { const int row = row0 + ai * HALF + m * 16; const size_t off = (size_t)row * D + col0; float sq = 0.f; f32x4 xn[2];
#pragma unroll
                        for (int n = 0; n < 2; ++n) { const f32x4 xs = *(const f32x4*)(Xs + off + 4 * n); const f32x4 a = acc[ai][0][m][n], b = acc[ai][1][m][n];
#pragma unroll
                            for (int e = 0; e < 4; ++e) xn[n][e] = xs[e] + gv[n][e] * a[e] * sigmoidf_(b[e]);
                            *(f32x4*)(Xd + off + 4 * n) = xn[n];
                            sq += (xn[n][0] * xn[n][0] + xn[n][1] * xn[n][1]) + (xn[n][2] * xn[n][2] + xn[n][3] * xn[n][3]); }
                        const f32x4 a0 = xn[0] * gs[0], a1 = xn[1] * gs[1];
                        u32x4 w; w.x = pk2h(a0[0], a0[1]); w.y = pk2h(a0[2], a0[3]); w.z = pk2h(a1[0], a1[1]); w.w = pk2h(a1[2], a1[3]);
                        *(u32x4*)(An + off) = w;
                        sq += __shfl_xor(sq, 16); sq += __shfl_xor(sq, 32); if (fq == 0) atomicAdd(ssn + row, sq); }
            }
        }
    }
};

__device__ __forceinline__ void gemm_phase(LAS unsigned char* lds, const Gemm g, const StaticOrder& S, const Epi& E) {
    int tid_ = threadIdx.x; asm volatile("" : "+v"(tid_));
    const int tid = tid_, wid = __builtin_amdgcn_readfirstlane(tid >> 6), lane = tid & 63, wr = wid >> 2, wc = wid & 3, fr = lane & 15, fq = lane >> 4;
    const int K = g.K, nt = K / BK;
    unsigned voffA[2], voffB[2];
#pragma unroll
    for (int i = 0; i < 2; ++i) { int R, C; stage_rc(tid * 16 + i * 8192, R, C); const int Rb = Epi::PERM ? ((R & ~31) + perm32(R & 31)) : R;
        voffA[i] = (unsigned)(R * K + C) * 2u; voffB[i] = (unsigned)(Rb * K + C) * 2u; }
    const size_t kstep = (size_t)(BK * 2);
    const size_t hstep = (size_t)HALF * K * 2;
    const size_t tstep = 2 * hstep;
    const unsigned ldsw = (unsigned)wid * 1024u;
    const int aoff = lds_byte(wr * 64 + fr, fq * 8), boff = lds_byte(wc * 32 + fr, fq * 8);
#define PG8_SA(b, h) (((b) * 2 + (h)) * HTB)
#define PG8_SB(b, h) ((4 + (b) * 2 + (h)) * HTB)
#define PG8_STAGE(bufoff, gbase, voff) do { _Pragma("unroll") for (int _i = 0; _i < 2; ++_i) \
        __builtin_amdgcn_global_load_lds((const unsigned*)((const char*)(gbase) + (voff)[_i]), (LAS unsigned*)(lds + (bufoff) + ldsw + _i * 8192), 16, 0, 0); } while (0)
#define PG8_LDA(dst, b, h) do { _Pragma("unroll") for (int m = 0; m < 4; ++m) _Pragma("unroll") for (int k = 0; k < 2; ++k) dst[m][k] = *(const LAS f16x8*)(lds + PG8_SA(b, h) + aoff + m * 2048 + k * 1024); } while (0)
#define PG8_LDB(dst, b, h) do { _Pragma("unroll") for (int n = 0; n < 2; ++n) _Pragma("unroll") for (int k = 0; k < 2; ++k) dst[n][k] = *(const LAS f16x8*)(lds + PG8_SB(b, h) + boff + n * 2048 + k * 1024); } while (0)
#define PG8_MMA(ai, bj, At, Bt) do { __builtin_amdgcn_s_setprio(1); _Pragma("unroll") for (int m = 0; m < 4; ++m) _Pragma("unroll") for (int n = 0; n < 2; ++n) _Pragma("unroll") for (int k = 0; k < 2; ++k) \
        acc[ai][bj][m][n] = __builtin_amdgcn_mfma_f32_16x16x32_f16(Bt[n][k], At[m][k], acc[ai][bj][m][n], 0, 0, 0); __builtin_amdgcn_s_setprio(0); } while (0)
#define PG8_WAIT_V(n) asm volatile("s_waitcnt vmcnt(" #n ")" ::: "memory")
#define PG8_WAIT_L(n) asm volatile("s_waitcnt lgkmcnt(" #n ")" ::: "memory")
#define PG8_BAR __builtin_amdgcn_s_barrier()
#define PG8_SCHED __builtin_amdgcn_sched_barrier(0)
    Unit cur, nxt; int ui = 0;
    if (!S.next(0, cur)) return;
    f32x4 acc[2][2][4][2];
#pragma unroll
    for (int a = 0; a < 2; ++a)
#pragma unroll
        for (int b = 0; b < 2; ++b)
#pragma unroll
            for (int m = 0; m < 4; ++m)
#pragma unroll
                for (int n = 0; n < 2; ++n) acc[a][b][m][n] = (f32x4){0.f, 0.f, 0.f, 0.f};
    f16x8 At[4][2], B0[2][2], B1[2][2];
    const char* cA = (const char*)g.A + (size_t)cur.pm * tstep; const char* cB = (const char*)g.Bt + (size_t)cur.pn * tstep;
    PG8_STAGE(PG8_SB(0, 0), cB, voffB); PG8_STAGE(PG8_SB(0, 1), cB + hstep, voffB); PG8_STAGE(PG8_SA(0, 0), cA, voffA); PG8_STAGE(PG8_SA(0, 1), cA + hstep, voffA);
    if (wr == 1) PG8_BAR;
    PG8_WAIT_V(2); PG8_BAR;
    PG8_STAGE(PG8_SB(1, 0), cB + kstep, voffB); PG8_STAGE(PG8_SA(1, 0), cA + kstep, voffA); PG8_STAGE(PG8_SB(1, 1), cB + hstep + kstep, voffB);
    PG8_WAIT_V(6); PG8_BAR;
    for (;;) {
        const bool has_next = S.next(ui + 1, nxt);
        const char* nA = has_next ? (const char*)g.A + (size_t)nxt.pm * tstep : cA; const char* nB = has_next ? (const char*)g.Bt + (size_t)nxt.pn * tstep : cB;
        for (int t = 0; t < nt; t += 2) {
            const bool last = (t == nt - 2);
            const char* a1 = cA + (size_t)(t + 1) * kstep;
            const char* a2 = last ? nA : cA + (size_t)(t + 2) * kstep; const char* b2 = last ? nB : cB + (size_t)(t + 2) * kstep;
            const char* a3 = a2 + kstep; const char* b3 = b2 + kstep;
            PG8_LDB(B0, 0, 0); PG8_LDB(B1, 0, 1); PG8_SCHED; PG8_LDA(At, 0, 0); PG8_STAGE(PG8_SA(1, 1), a1 + hstep, voffA);
            PG8_WAIT_V(8); PG8_WAIT_L(0); PG8_BAR; PG8_MMA(0, 0, At, B0); PG8_MMA(0, 1, At, B1); PG8_BAR; PG8_SCHED;
            PG8_LDA(At, 0, 1); PG8_STAGE(PG8_SB(0, 0), b2, voffB); PG8_STAGE(PG8_SB(0, 1), b2 + hstep, voffB); PG8_STAGE(PG8_SA(0, 0), a2, voffA);
            PG8_WAIT_V(8); PG8_WAIT_L(0); PG8_BAR; PG8_MMA(1, 0, At, B0); PG8_MMA(1, 1, At, B1); PG8_BAR; PG8_SCHED;
            PG8_LDB(B0, 1, 0); PG8_LDB(B1, 1, 1); PG8_SCHED; PG8_LDA(At, 1, 0); PG8_STAGE(PG8_SA(0, 1), a2 + hstep, voffA);
            PG8_WAIT_V(8); PG8_WAIT_L(0); PG8_BAR; PG8_MMA(0, 0, At, B0); PG8_MMA(0, 1, At, B1); PG8_BAR; PG8_SCHED;
            PG8_LDA(At, 1, 1); PG8_STAGE(PG8_SB(1, 0), b3, voffB); PG8_STAGE(PG8_SB(1, 1), b3 + hstep, voffB); PG8_STAGE(PG8_SA(1, 0), a3, voffA);
            PG8_WAIT_V(8); PG8_WAIT_L(0); PG8_BAR; PG8_MMA(1, 0, At, B0); PG8_MMA(1, 1, At, B1); PG8_BAR; PG8_SCHED;
        }
        if (wr == 0) PG8_BAR;
        E(acc, cur, wr, wc, fr, fq);
        if (!has_next) break;
#pragma unroll
        for (int a = 0; a < 2; ++a)
#pragma unroll
            for (int b = 0; b < 2; ++b)
#pragma unroll
                for (int m = 0; m < 4; ++m)
#pragma unroll
                    for (int n = 0; n < 2; ++n) acc[a][b][m][n] = (f32x4){0.f, 0.f, 0.f, 0.f};
        cur = nxt; cA = nA; cB = nB; ++ui;
        if (wr == 1) PG8_BAR;
    }
    PG8_WAIT_V(0);
    PG8_BAR;
#undef PG8_SA
#undef PG8_SB
#undef PG8_STAGE
#undef PG8_LDA
#undef PG8_LDB
#undef PG8_MMA
#undef PG8_WAIT_V
#undef PG8_WAIT_L
#undef PG8_BAR
#undef PG8_SCHED
}
}
using pg8::pk2h;
using pg8::sigmoidf_;

#define LDS_WAIT() asm volatile("s_waitcnt lgkmcnt(0)" ::: "memory")
#define CFENCE() asm volatile("" ::: "memory")

struct Args {
    const float* in[24]; float* out; unsigned char* ws; int ph_lo, ph_hi;
};

struct Frame {
    LAS unsigned char* lds; int tid, lane, wave, vcu, G;
};

__device__ __forceinline__ float wave_sum(float v) {
#pragma unroll
    for (int o = 1; o < 64; o <<= 1) v += __shfl_xor(v, o);
    return v;
}

__device__ __forceinline__ void p0_transpose_item(const float* W, int K, int N, int half_n, f16* WT, LAS float* scr, int item, int lane) {
    const int nblk = N / 32, kb = item / nblk, nb = item % nblk, k0 = 64 * kb, n0 = 32 * nb;
    int d0 = n0;
    if (half_n) { const int j = n0 < half_n ? n0 : n0 - half_n; d0 = (j >> 7) * 256 + (n0 < half_n ? 0 : 128) + (j & 127); }
#pragma unroll 8
    for (int i = 0; i < 32; ++i) { const int kk = 2 * i + (lane >> 5); scr[kk * 33 + (lane & 31)] = W[(size_t)(k0 + kk) * N + n0 + (lane & 31)]; }
    LDS_WAIT();
    const int c = lane & 7;
#pragma unroll
    for (int j = 0; j < 4; ++j) { const int n = (lane >> 3) + 8 * j; const LAS float* s = scr + (8 * c) * 33 + n;
        u32x4 o; o.x = pk2h(s[0 * 33], s[1 * 33]); o.y = pk2h(s[2 * 33], s[3 * 33]); o.z = pk2h(s[4 * 33], s[5 * 33]); o.w = pk2h(s[6 * 33], s[7 * 33]);
        *(u32x4*)(WT + (size_t)(d0 + n) * K + k0 + 8 * c) = o; }
    LDS_WAIT();
}

__device__ __forceinline__ void dsincos(double r, double& s, double& c) {
    const double r2 = r * r; double ts = r, tc = 1.0; s = r; c = 1.0;
#pragma unroll
    for (int i = 1; i <= 14; ++i) { tc = -tc * r2 / (double)((2 * i - 1) * (2 * i)); c += tc; ts = -ts * r2 / (double)((2 * i) * (2 * i + 1)); s += ts; }
}
__device__ __forceinline__ double dexp_small(double x) {
    double t = 1.0, s = 1.0;
#pragma unroll
    for (int i = 1; i <= 14; ++i) { t = t * x / (double)i; s += t; }
    return s;
}

__device__ __forceinline__ void conv_job(Frame& F, const Args& a, int job, int worker, int nworkers) {
    unsigned char* ws = a.ws;
    LAS float* scr = (LAS float*)(F.lds + 8192 + F.wave * 16384);
    constexpr int I_FI = (1024 / 64) * (5632 / 32), I_FO = (2816 / 64) * (1024 / 32), I_SQ = 16 * 32, I_GLU = 16 * 64, I_QKV = 16 * 96;
    const int q = job == 0 ? 0 : (job == 1 ? 1 : (job == 2 ? 2 : 3));
    const int nextra = job == 1 ? I_SQ + I_GLU : (job == 2 ? I_QKV + I_SQ : 0);
    const int nitems = I_FI + I_FO + nextra;
    for (int it = worker; it < nitems; it += nworkers) {
        int r = it;
        if (r < I_FI) { p0_transpose_item(a.in[7] + (size_t)q * 1024 * 5632, 1024, 5632, 2816, (f16*)(ws + WS_WFI + q * WFI_SZ), scr, r, F.lane); continue; } r -= I_FI;
        if (r < I_FO) { p0_transpose_item(a.in[8] + (size_t)q * 2816 * 1024, 2816, 1024, 0, (f16*)(ws + WS_WFO + q * WFO_SZ), scr, r, F.lane); continue; } r -= I_FO;
        if (job == 1) {
            if (r < I_SQ) { p0_transpose_item(a.in[9], 1024, 1024, 0, (f16*)(ws + WS_WSI), scr, r, F.lane); continue; } r -= I_SQ;
            p0_transpose_item(a.in[18], 1024, 2048, 1024, (f16*)(ws + WS_WGLU), scr, r, F.lane);
        } else {
            if (r < I_QKV) { p0_transpose_item(a.in[19], 1024, 3072, 0, (f16*)(ws + WS_WQKV), scr, r, F.lane); continue; } r -= I_QKV;
            p0_transpose_item(a.in[23], 1024, 1024, 0, (f16*)(ws + WS_WO), scr, r, F.lane);
        }
    }
}
__device__ __forceinline__ void bias_rows(Frame& F, const Args& a, int sl_lo, int sl_hi) {
    unsigned char* ws = a.ws;
    const float* MOD = (const float*)(ws + WS_MOD); float* BIAS = (float*)(ws + WS_BIAS);
    const int gw = F.vcu * 8 + F.wave, NGW = F.G * 8;
    for (int sl = sl_lo; sl <= sl_hi; ++sl) {
        const int nrows = sl == 1 ? 1024 : (sl == 4 ? 3072 : 5632);
        const f16* Wt = sl == 0 ? (const f16*)(ws + WS_WFI) : sl == 1 ? (const f16*)(ws + WS_WSI) : sl == 2 ? (const f16*)(ws + WS_WFI + 1 * WFI_SZ)
                      : sl == 3 ? (const f16*)(ws + WS_WFI + 2 * WFI_SZ) : sl == 4 ? (const f16*)(ws + WS_WQKV) : (const f16*)(ws + WS_WFI + 3 * WFI_SZ);
        const int l = sl / 3, sb = sl % 3;
        for (int n = gw; n < nrows; n += NGW) {
            const f16x8 w0 = *(const f16x8*)(Wt + (size_t)n * D + 16 * F.lane), w1 = *(const f16x8*)(Wt + (size_t)n * D + 16 * F.lane + 8);
            float d[3];
#pragma unroll
            for (int mi = 0; mi < 3; ++mi) { const float* sh = MOD + (l * 3 + mi) * 9216 + sb * 3072 + 16 * F.lane; float acc = 0.f;
#pragma unroll
                for (int q = 0; q < 4; ++q) { const f32x4 sv = *(const f32x4*)(sh + 4 * q);
#pragma unroll
                    for (int e = 0; e < 4; ++e) { const int k = 4 * q + e; acc += sv[e] * (float)(k < 8 ? w0[k & 7] : w1[k & 7]); } }
                d[mi] = wave_sum(acc); }
            if (F.lane == 0) { BIAS[(sl * 3 + 0) * 5632 + n] = d[0]; BIAS[(sl * 3 + 1) * 5632 + n] = d[1]; BIAS[(sl * 3 + 2) * 5632 + n] = d[2]; }
        }
    }
}
__device__ __forceinline__ void p0_phase(Frame& F, const Args& a) {
    unsigned char* ws = a.ws;
    float* MOD = (float*)(ws + WS_MOD);
    {
        const float* cin = a.in[1]; const float* cctx = a.in[3]; const float* ada_w = a.in[5]; const float* ada_b = a.in[6];
        LAS float* red = (LAS float*)F.lds;
        const int c4 = F.lane & 15, ko = F.lane >> 4;
        for (int u = blockIdx.x; u < 576; u += F.G) {
            const int kh = u & 1, cgl = u >> 1, l = cgl / 144, cg = cgl % 144;
            const float* Wl = ada_w + (size_t)l * 1024 * 9216 + cg * 64 + c4 * 4;
            const int kbase = kh * 512 + F.wave * 64 + ko;
            float acc[3][4];
#pragma unroll
            for (int m = 0; m < 3; ++m)
#pragma unroll
                for (int e = 0; e < 4; ++e) acc[m][e] = 0.f;
#pragma unroll 4
            for (int i = 0; i < 16; ++i) { const int k = kbase + 4 * i; const f32x4 w = *(const f32x4*)(Wl + (size_t)k * 9216);
                const float c0 = cin[k], c1 = cin[1024 + k], c2 = cctx[k];
                const float s0 = c0 * sigmoidf_(c0), s1 = c1 * sigmoidf_(c1), s2 = c2 * sigmoidf_(c2);
#pragma unroll
                for (int e = 0; e < 4; ++e) { acc[0][e] += s0 * w[e]; acc[1][e] += s1 * w[e]; acc[2][e] += s2 * w[e]; } }
#pragma unroll
            for (int m = 0; m < 3; ++m)
#pragma unroll
                for (int e = 0; e < 4; ++e) { float v = acc[m][e]; v += __shfl_xor(v, 16); v += __shfl_xor(v, 32); acc[m][e] = v; }
            if (F.lane < 16) {
#pragma unroll
                for (int m = 0; m < 3; ++m)
#pragma unroll
                    for (int e = 0; e < 4; ++e) red[(F.wave * 3 + m) * 64 + c4 * 4 + e] = acc[m][e];
            }
            __syncthreads();
            if (F.tid < 192) { const int m = F.tid >> 6, col = F.tid & 63; float s = 0.f;
#pragma unroll
                for (int w = 0; w < 8; ++w) s += red[(w * 3 + m) * 64 + col];
                if (kh == 0) s += ada_b[l * 9216 + cg * 64 + col];
                atomicAdd(MOD + (size_t)(l * 3 + m) * 9216 + cg * 64 + col, s); }
            __syncthreads();
        }
    }
    conv_job(F, a, 0, F.vcu * 8 + F.wave, F.G * 8);
    { float* SS = (float*)(ws + WS_SS); for (int i = blockIdx.x * 512 + F.tid; i < 5 * MALL; i += F.G * 512) SS[MALL + i] = 0.f; }
    {
        const float* lam_re = a.in[10]; const float* lam_im = a.in[11]; const float* lstep = a.in[12];
        const float* b_re = a.in[13]; const float* b_im = a.in[14]; const float* c_re = a.in[15]; const float* c_im = a.in[16];
        float* Lam = (float*)(ws + WS_LAM); float* LamT = (float*)(ws + WS_LAMT); f16* Bm = (f16*)(ws + WS_BMAT); f16* Cm = (f16*)(ws + WS_CMAT);
        for (int idx = blockIdx.x * 512 + F.tid; idx < 8192; idx += F.G * 512) {
            const int p = idx & 63, g = (idx >> 6) & 63, dir = idx >> 12;
            const double lr = fmin((double)lam_re[idx], -1e-4), li = (double)lam_im[idx];
            const double dt = (double)expf(lstep[dir * 64 + g]);
            const double mag = dexp_small(lr * dt);
            double th = li * dt; const double twopi = 6.283185307179586476925287;
            th -= twopi * rint(th / twopi);
            double sn, cs; dsincos(th, sn, cs);
            const double ar = mag * cs, ai = mag * sn;
            const double den = lr * lr + li * li;
            const double cr = ((ar - 1.0) * lr + ai * li) / den, ci = (ai * lr - (ar - 1.0) * li) / den;
            Lam[idx * 2] = (float)ar; Lam[idx * 2 + 1] = (float)ai;
            double pr = ar, pi = ai;
#pragma unroll
            for (int q = 0; q < 6; ++q) { const double nr = pr * pr - pi * pi, ni = 2.0 * pr * pi; pr = nr; pi = ni; }
            LamT[idx * 2] = (float)pr; LamT[idx * 2 + 1] = (float)pi;
            const float* br = b_re + (size_t)idx * 16; const float* bi = b_im + (size_t)idx * 16;
            f16* bo = Bm + ((size_t)(g * 2 + dir) * 128 + 2 * p) * 16;
#pragma unroll
            for (int h = 0; h < 16; ++h) { bo[h] = (f16)br[h]; bo[16 + h] = (f16)bi[h]; }
#pragma unroll
            for (int h = 0; h < 16; ++h) {
                const double Cr = (double)c_re[((size_t)(dir * 64 + g) * 16 + h) * 64 + p], Ci = (double)c_im[((size_t)(dir * 64 + g) * 16 + h) * 64 + p];
                const double er = Cr * cr - Ci * ci, ei = Cr * ci + Ci * cr;
                f16* co = Cm + ((size_t)(g * 2 + dir) * 16 + h) * 128 + 2 * p;
                co[0] = (f16)(float)(er * 1024.0); co[1] = (f16)(float)(-ei * 1024.0);
            }
        }
    }
}

__device__ __forceinline__ void p1_phase(Frame& F, const Args& a) {
    unsigned char* ws = a.ws;
    const float* MOD = (const float*)(ws + WS_MOD); const float* norm_g = a.in[4];
    float* X = (float*)(ws + WS_X); f16* H16 = (f16*)(ws + WS_H16); float* SS = (float*)(ws + WS_SS); float* GS = (float*)(ws + WS_GS); float* BIAS = (float*)(ws + WS_BIAS);
    const int gw = F.vcu * 8 + F.wave, NGW = F.G * 8;
    for (int row = gw; row < MALL; row += NGW) {
        const float* xr = row < MLAT ? a.in[0] + (size_t)row * D : a.in[2] + (size_t)(row - MLAT) * D;
        const int mi = row < SEQ ? 0 : (row < MLAT ? 1 : 2);
        const float* sc = MOD + mi * 9216 + 1024;
        f32x4 v[4]; float sq = 0.f;
#pragma unroll
        for (int j = 0; j < 4; ++j) { v[j] = *((const f32x4*)xr + F.lane + 64 * j); sq += (v[j].x * v[j].x + v[j].y * v[j].y) + (v[j].z * v[j].z + v[j].w * v[j].w); }
        sq = wave_sum(sq);
        if (F.lane == 0) SS[row] = sq;
#pragma unroll
        for (int j = 0; j < 4; ++j) { const int col = 4 * (F.lane + 64 * j);
            const f32x4 gg = *(const f32x4*)(norm_g + col), s1 = *(const f32x4*)(sc + col);
            const f32x4 h = v[j] * gg * (s1 + 1.0f);
            u32x2 w; w.x = pk2h(h.x, h.y); w.y = pk2h(h.z, h.w);
            *(u32x2*)(H16 + (size_t)row * D + col) = w;
            *(f32x4*)(X + (size_t)row * D + col) = v[j]; }
    }
    for (int i = blockIdx.x * 512 + F.tid; i < 6 * 3 * 1024; i += F.G * 512) { const int col = i & 1023, mi = (i >> 10) % 3, sl = i / 3072, l = sl / 3, sb = sl % 3;
        GS[i] = norm_g[sl * 1024 + col] * (1.0f + MOD[(l * 3 + mi) * 9216 + sb * 3072 + 1024 + col]); }
    bias_rows(F, a, 0, 0);
}

__device__ __forceinline__ void s5_unit_decode(int unit, int w, int& gq, int& c, int& b, int& g, int& rowbase) {
    gq = unit & 15; c = (unit >> 4) % NCH; b = unit / (16 * NCH); g = gq * 4 + (w >> 1);
    rowbase = c < 4 ? MLAT + b * CTX + 64 * c : b * SEQ + 64 * (c - 4);
}
template <bool P2>
__device__ __forceinline__ void s5_load_unit(int unit, int w, int dir, int l, const f16* U16, const f32x2* Cin, f16x4 (&af)[4], f32x2& st) {
    int gq, c, b, g, rowbase; s5_unit_decode(unit, w, gq, c, b, g, rowbase);
    const int fq = l >> 4, fr = l & 15;
#pragma unroll
    for (int s = 0; s < 4; ++s) af[s] = *(const f16x4*)(U16 + (size_t)(rowbase + 16 * (dir ? 3 - s : s) + fr) * D + 16 * g + 4 * fq);
    if (P2) st = Cin[((size_t)((dir * 2 + b) * NCH + c) * 64 + g) * 64 + l];
}
__device__ __forceinline__ float fma_s(float a, float b, float c) { float r; asm("v_fma_f32 %0, %1, %2, %3" : "=v"(r) : "v"(a), "v"(b), "v"(c)); return r; }
template <bool P2>
__device__ __forceinline__ void s5_pass(Frame& F, unsigned char* ws, const float* ssm_d) {
    int l_ = F.lane; asm volatile("" : "+v"(l_));
    const int w = F.wave, l = l_, fq = l >> 4, fr = l & 15;
    LAS float* W = (LAS float*)(F.lds + w * 8448);
    LAS f16* XS = (LAS f16*)(F.lds + 67584 + w * 4352);
    LAS float* YBall = (LAS float*)(F.lds + 67584 + 34816);
    LAS float* YB = YBall + w * 1024;
    const float* Lam = (const float*)(ws + WS_LAM); const f16* Bm = (const f16*)(ws + WS_BMAT); const f16* Cm = (const f16*)(ws + WS_CMAT);
    const f16* U16 = (const f16*)(ws + WS_U16); f16* G16 = (f16*)(ws + WS_G16);
    f32x2* Eb = (f32x2*)(ws + WS_E); const f32x2* Cin = (const f32x2*)(ws + WS_CIN);
    const int dir = w & 1;
    int wstep = dir ? -132 : 132, xstep = dir ? -136 : 136, w0 = dir ? 15 * 132 : 0, x0 = dir ? 15 * 136 : 0;
    asm volatile("" : "+s"(wstep), "+s"(xstep), "+s"(w0), "+s"(x0));
    const LAS float* Wl = W + w0 + 2 * l; LAS f16* XSl = XS + x0 + 2 * l;
    constexpr int NU = NB * NCH * 16;
    int gcur = -1; float ar = 0.f, ai = 0.f;
    f16x4 bf[8]; f16x8 cfr[4];
    f16x4 af[4], afn[4]; f32x2 st = (f32x2){0.f, 0.f}, stn = (f32x2){0.f, 0.f};
    int unit = blockIdx.x;
    if (unit < NU) s5_load_unit<P2>(unit, w, dir, l, U16, Cin, af, st);
    for (; unit < NU; unit += F.G) {
        int gq, c, b, g, rowbase; s5_unit_decode(unit, w, gq, c, b, g, rowbase);
        if (g != gcur) {
            gcur = g;
            ar = Lam[((dir * 64 + g) * 64 + l) * 2]; ai = Lam[((dir * 64 + g) * 64 + l) * 2 + 1];
#pragma unroll
            for (int j = 0; j < 8; ++j) bf[j] = *(const f16x4*)(Bm + ((size_t)(g * 2 + dir) * 128 + 16 * j + fr) * 16 + 4 * fq);
            if (P2) {
#pragma unroll
                for (int kk = 0; kk < 4; ++kk) cfr[kk] = *(const f16x8*)(Cm + ((size_t)(g * 2 + dir) * 16 + fr) * 128 + 32 * kk + 8 * fq);
            }
        }
        if (unit + F.G < NU) s5_load_unit<P2>(unit + F.G, w, dir, l, U16, Cin, afn, stn);
        const size_t sidx = ((size_t)((dir * 2 + b) * NCH + c) * 64 + g) * 64 + l;
        float xr = st.x, xi = st.y; const float nai = -ai;
        const int cgl = F.tid >> 7, ct = (F.tid >> 1) & 63, chb = F.tid & 1, cgg = gq * 4 + cgl;
        const size_t co = (size_t)(rowbase + ct) * D + 16 * cgg + 8 * chb;
        f16x8 uu; f32x4 dv0, dv1;
        if (P2) { uu = *(const f16x8*)(U16 + co); dv0 = *(const f32x4*)(ssm_d + 16 * cgg + 8 * chb); dv1 = *(const f32x4*)(ssm_d + 16 * cgg + 8 * chb + 4); }
#pragma unroll
        for (int s = 0; s < 4; ++s) {
            const int sc = dir ? 3 - s : s;
            const f16x4 a4 = af[s];
#pragma unroll
            for (int j = 0; j < 8; ++j) { const f32x4 dd = __builtin_amdgcn_mfma_f32_16x16x16f16(bf[j], a4, (f32x4){0.f, 0.f, 0.f, 0.f}, 0, 0, 0);
                *(LAS f32x4*)(W + fr * 132 + 16 * j + 4 * fq) = dd; }
            CFENCE();
#pragma unroll
            for (int k = 0; k < 16; ++k) {
                const f32x2 bu = *(const LAS f32x2*)(Wl + k * wstep);
                const float nr = fma_s(nai, xi, fma_s(ar, xr, bu.x)), ni = fma_s(ai, xr, fma_s(ar, xi, bu.y)); xr = nr; xi = ni;
                if (P2) { f16x2 hv; hv.x = (f16)xr; hv.y = (f16)xi; *(LAS f16x2*)(XSl + k * xstep) = hv; } }
            if (P2) {
                CFENCE();
                f32x4 Y = (f32x4){0.f, 0.f, 0.f, 0.f};
#pragma unroll
                for (int kk = 0; kk < 4; ++kk) { const f16x8 xa = *(const LAS f16x8*)(XS + fr * 136 + 32 * kk + 8 * fq); Y = __builtin_amdgcn_mfma_f32_16x16x32_f16(cfr[kk], xa, Y, 0, 0, 0); }
                *(LAS f32x4*)(YB + (16 * sc + fr) * 16 + 4 * fq) = Y;
            }
            CFENCE();
        }
        if (!P2) { Eb[sidx] = (f32x2){xr, xi}; }
        else {
            __syncthreads();
            const LAS float* y0 = YBall + (cgl * 2) * 1024 + ct * 16 + 8 * chb; const LAS float* y1 = y0 + 1024;
            const size_t o = co;
            float hv[8];
#pragma unroll
            for (int e = 0; e < 8; ++e) { const float dd = e < 4 ? dv0[e & 3] : dv1[e & 3];
                const float y = (y0[e] + y1[e]) * (1.0f / 1024.0f) + (float)uu[e] * dd;
                const float z = 1.5957691216057308f * (y + 0.044715f * y * y * y);
                hv[e] = y * sigmoidf_(z); }
            u32x4 wv; wv.x = pk2h(hv[0], hv[1]); wv.y = pk2h(hv[2], hv[3]); wv.z = pk2h(hv[4], hv[5]); wv.w = pk2h(hv[6], hv[7]);
            *(u32x4*)(G16 + o) = wv;
            __syncthreads();
        }
#pragma unroll
        for (int s = 0; s < 4; ++s) af[s] = afn[s];
        st = stn;
    }
}

__device__ __forceinline__ void s5_carry(Frame& F, unsigned char* ws) {
    const float* LamT = (const float*)(ws + WS_LAMT); const f32x2* Eb = (const f32x2*)(ws + WS_E); f32x2* Cin = (f32x2*)(ws + WS_CIN);
    for (int wv = F.wave * F.G + blockIdx.x; wv < 256; wv += F.G * 8) {
        const int idx = wv * 64 + F.lane;
        const int p = idx & 63, g = (idx >> 6) & 63, b = (idx >> 12) & 1, dir = idx >> 13;
        const float lr = LamT[((dir * 64 + g) * 64 + p) * 2], li = LamT[((dir * 64 + g) * 64 + p) * 2 + 1];
        float sr = 0.f, si = 0.f;
        for (int k0 = 0; k0 < NCH; k0 += 12) {
            f32x2 e[12]; size_t ad[12];
#pragma unroll
            for (int j = 0; j < 12; ++j) { const int k = k0 + j; const int c = dir ? (k < 4 ? 3 - k : 135 - k) : k;
                ad[j] = ((size_t)((dir * 2 + b) * NCH + c) * 64 + g) * 64 + p; e[j] = Eb[ad[j]]; }
#pragma unroll
            for (int j = 0; j < 12; ++j) { Cin[ad[j]] = (f32x2){sr, si};
                const float nr = lr * sr - li * si + e[j].x, ni = lr * si + li * sr + e[j].y; sr = nr; si = ni; }
        }
    }
}

__device__ __forceinline__ void qknorm_phase(Frame& F, unsigned char* ws, const float* qg, const float* kg) {
    f16* Q = (f16*)(ws + WS_Q16); f16* Kp = (f16*)(ws + WS_K16); const f16* V = (const f16*)(ws + WS_V16); f16* VT = (f16*)(ws + WS_VT); f16* VTC = (f16*)(ws + WS_VTC);
    LAS f16* T = (LAS f16*)(F.lds + F.wave * 9216);
    const int gw = F.vcu * 8 + F.wave, NGW = F.G * 8, l = F.lane;
    const int dchunk = (l & 7) * 8;
    float qgv[8], kgv[8];
#pragma unroll
    for (int e = 0; e < 8; ++e) { qgv[e] = qg[dchunk + e] * 0.125f; kgv[e] = kg[dchunk + e]; }
    for (int u = gw; u < 264 * 16; u += NGW) {
        const int h = u & 15, tb = u >> 4, R0 = tb * 64;
#pragma unroll
        for (int which = 0; which < 2; ++which) {
            if (which == 0 && tb >= 256) continue;
            f16* P = which ? Kp : Q;
#pragma unroll 2
            for (int it = 0; it < 8; ++it) { f16* p = P + (size_t)(R0 + it * 8 + (l >> 3)) * D + h * 64 + dchunk;
                const f16x8 v = *(const f16x8*)p; float f[8], ss = 0.f;
#pragma unroll
                for (int e = 0; e < 8; ++e) { f[e] = (float)v[e]; ss += f[e] * f[e]; }
                ss += __shfl_xor(ss, 1); ss += __shfl_xor(ss, 2); ss += __shfl_xor(ss, 4);
                const float rinv = __builtin_amdgcn_rsqf(ss * (1.0f / 64.0f) + EPS);
                u32x4 o;
                if (which) { o.x = pk2h(f[0] * rinv * kgv[0], f[1] * rinv * kgv[1]); o.y = pk2h(f[2] * rinv * kgv[2], f[3] * rinv * kgv[3]); o.z = pk2h(f[4] * rinv * kgv[4], f[5] * rinv * kgv[5]); o.w = pk2h(f[6] * rinv * kgv[6], f[7] * rinv * kgv[7]); }
                else { o.x = pk2h(f[0] * rinv * qgv[0], f[1] * rinv * qgv[1]); o.y = pk2h(f[2] * rinv * qgv[2], f[3] * rinv * qgv[3]); o.z = pk2h(f[4] * rinv * qgv[4], f[5] * rinv * qgv[5]); o.w = pk2h(f[6] * rinv * qgv[6], f[7] * rinv * qgv[7]); }
                *(u32x4*)p = o; }
        }
#pragma unroll 2
        for (int it = 0; it < 8; ++it) { const int tok = it * 8 + (l >> 3);
            *(LAS u32x4*)(T + tok * 72 + dchunk) = *(const u32x4*)(V + (size_t)(R0 + tok) * D + h * 64 + dchunk); }
        LDS_WAIT();
        f16* dst; int ldt;
        if (tb < 256) { const int b = tb >> 7, t0 = (tb & 127) * 64; dst = VT + ((size_t)(b * 16 + h) * 64) * SEQ + t0; ldt = SEQ; }
        else { const int b = (tb - 256) >> 2, t0 = ((tb - 256) & 3) * 64; dst = VTC + ((size_t)(b * 16 + h) * 64) * CTX + t0; ldt = CTX; }
#pragma unroll 2
        for (int it = 0; it < 8; ++it) { const int d = it * 8 + (l >> 3), tc = (l & 7) * 8; f16x8 o;
#pragma unroll
            for (int e = 0; e < 8; ++e) o[e] = T[(tc + e) * 72 + d];
            *(f16x8*)(dst + (size_t)d * ldt + tc) = o; }
        LDS_WAIT();
    }
}

constexpr int AT_KROW = 144, AT_KC = 82944, AT_VC = 119808, AT_TAB = 156672;
#define AT_BAR() do { asm volatile("s_waitcnt lgkmcnt(0)" ::: "memory"); __builtin_amdgcn_s_barrier(); asm volatile("" ::: "memory"); } while (0)
typedef short v4i16_t __attribute__((ext_vector_type(4)));
__device__ __forceinline__ f16x4 at_vtr(const LAS unsigned char* p) { return __builtin_bit_cast(f16x4, __builtin_amdgcn_ds_read_tr16_b64_v4i16((LAS v4i16_t*)p)); }
__device__ __forceinline__ void attn_decode(int up, int G, int& rp, int& bh, int& rs0) {
    if (G == 256) { const int i = up & 255, k = up >> 8; bh = i >> 3; rp = (i & 7) * 8 + k; } else { rp = up & 63; bh = up >> 6; }
    rs0 = min(max(2 * rp - 4, 0), 120);
}
constexpr int AT_NPF = 5;
template <int I0, int I1, int NT>
__device__ __forceinline__ void attn_load_band(const f16* Src, int bh, int rs0, int tid, u32x4 (&tk)[NT]) {
    const int b = bh >> 4, h = bh & 15;
#pragma unroll
    for (int it = I0; it < I1; ++it) { const int q = it * 512 + tid, row = q >> 3, c16 = q & 7;
        const int gr = min(rs0 + (row >> 6), 127);
        tk[it - I0] = *(const u32x4*)(Src + (size_t)(b * SEQ + gr * 64 + (row & 63)) * D + h * 64 + c16 * 8); }
}
__device__ __forceinline__ u32x4 at_knorm(u32x4 raw, const float (&kgv)[8]) {
    const f16x8 v = __builtin_bit_cast(f16x8, raw); float f[8], ss = 0.f;
#pragma unroll
    for (int e = 0; e < 8; ++e) { f[e] = (float)v[e]; ss += f[e] * f[e]; }
    ss += __builtin_bit_cast(float, __builtin_amdgcn_update_dpp(0, __builtin_bit_cast(int, ss), 0xB1, 0xf, 0xf, true));
    ss += __builtin_bit_cast(float, __builtin_amdgcn_update_dpp(0, __builtin_bit_cast(int, ss), 0x4E, 0xf, 0xf, true));
    ss += __builtin_bit_cast(float, __builtin_amdgcn_update_dpp(0, __builtin_bit_cast(int, ss), 0x141, 0xf, 0xf, true));
    const float rinv = __builtin_amdgcn_rsqf(ss * (1.0f / 64.0f) + EPS);
    u32x4 o; o.x = pk2h(f[0] * rinv * kgv[0], f[1] * rinv * kgv[1]); o.y = pk2h(f[2] * rinv * kgv[2], f[3] * rinv * kgv[3]);
    o.z = pk2h(f[4] * rinv * kgv[4], f[5] * rinv * kgv[5]); o.w = pk2h(f[6] * rinv * kgv[6], f[7] * rinv * kgv[7]); return o;
}
__device__ __forceinline__ void attn_phase(Frame& F, unsigned char* ws, const float* rpb, const float* qg, const float* kg) {
    f16* Q = (f16*)(ws + WS_Q16); const f16* Kp = (const f16*)(ws + WS_K16); const f16* Vp = (const f16*)(ws + WS_V16);
    const int w = F.wave;
    LAS unsigned char* SM = F.lds;
    constexpr int NUP = NB * 16 * 64;
    u32x4 tk[AT_NPF];
    int bh_cur = -1;
    { int rp, bh, rs0; if ((int)blockIdx.x < NUP) { attn_decode(blockIdx.x, F.G, rp, bh, rs0); attn_load_band<0, AT_NPF, AT_NPF>(Kp, bh, rs0, F.tid, tk); } }
    for (int up = blockIdx.x; up < NUP; up += F.G) {
        int l_ = F.lane; asm volatile("" : "+v"(l_));
        const int l = l_, fr = l & 15, fq = l >> 4, tid = w * 64 + l;
        int rp, bh, rs0; attn_decode(up, F.G, rp, bh, rs0);
        const int b = bh >> 4, h = bh & 15;
        const int r0 = 2 * rp;
        const int r = r0 + (w >> 2), qt = w & 3;
        const int rs = min(max(r - 4, 0), 120), i0 = rs - rs0;
        const int cw = qt == 0 ? 0 : (qt == 1 ? 8 : (qt == 2 ? 24 : 32));
        const int qc = 16 * qt + fr, cs = min(max(qc - 8, 0), 48);
        const size_t qrow = (size_t)(b * SEQ + r * 64 + qc) * D + h * 64;
        float kgv[8];
#pragma unroll
        for (int e = 0; e < 8; ++e) kgv[e] = kg[(tid & 7) * 8 + e];
        f16x8 q0, q1;
        { const f16x8 r0v = *(const f16x8*)(Q + qrow + 8 * fq), r1v = *(const f16x8*)(Q + qrow + 32 + 8 * fq); float f0[8], f1[8], ss = 0.f;
#pragma unroll
            for (int e = 0; e < 8; ++e) { f0[e] = (float)r0v[e]; f1[e] = (float)r1v[e]; ss += f0[e] * f0[e] + f1[e] * f1[e]; }
            ss += __shfl_xor(ss, 16); ss += __shfl_xor(ss, 32);
            const float rinv = __builtin_amdgcn_rsqf(ss * (1.0f / 64.0f) + EPS) * (0.125f * 1.4426950408889634f);
#pragma unroll
            for (int e = 0; e < 8; ++e) { q0[e] = (f16)(f0[e] * rinv * qg[8 * fq + e]); q1[e] = (f16)(f1[e] * rinv * qg[32 + 8 * fq + e]); } }
        { u32x4 tr[9 - AT_NPF]; attn_load_band<AT_NPF, 9, 9 - AT_NPF>(Kp, bh, rs0, tid, tr);
#pragma unroll
        for (int it = 0; it < 9; ++it) { const int q = it * 512 + tid, row = q >> 3, c16 = q & 7; *(LAS u32x4*)(SM + row * AT_KROW + c16 * 16) = at_knorm(it < AT_NPF ? tk[it < AT_NPF ? it : 0] : tr[it >= AT_NPF ? it - AT_NPF : 0], kgv); } }
        if (bh != bh_cur) {
            bh_cur = bh;
#pragma unroll
            for (int it = 0; it < 4; ++it) { const int q = it * 512 + tid, row = q >> 3, c16 = q & 7; const size_t go = (size_t)(MLAT + b * CTX + row) * D + h * 64 + c16 * 8;
                *(LAS u32x4*)(SM + AT_KC + row * AT_KROW + c16 * 16) = at_knorm(*(const u32x4*)(Kp + go), kgv);
                *(LAS u32x4*)(SM + AT_VC + row * AT_KROW + c16 * 16) = *(const u32x4*)(Vp + go); }
            if (tid < 465) ((LAS float*)(SM + AT_TAB))[tid] = rpb[h * 465 + tid] * 1.4426950408889634f;
        }
        const LAS float* rp_ = (const LAS float*)(SM + AT_TAB);
        AT_BAR();
        f32x4 S[32];
        float mx = -INFINITY;
#pragma unroll
        for (int i = 0; i < 8; ++i)
#pragma unroll
            for (int hf = 0; hf < 2; ++hf) {
                const LAS unsigned char* kr = SM + ((i0 + i) * 64 + cw + 16 * hf + fr) * AT_KROW + 16 * fq;
                const f16x8 k0 = *(const LAS f16x8*)kr, k1 = *(const LAS f16x8*)(kr + 64);
                f32x4 sv = __builtin_amdgcn_mfma_f32_16x16x32_f16(k0, q0, (f32x4){0.f, 0.f, 0.f, 0.f}, 0, 0, 0);
                sv = __builtin_amdgcn_mfma_f32_16x16x32_f16(k1, q1, sv, 0, 0, 0);
                const int ri = rs + i - r + 7;
#pragma unroll
                for (int e = 0; e < 4; ++e) { const int kc = cw + 16 * hf + 4 * fq + e; const bool valid = (kc >= cs) && (kc < cs + 16);
                    const int ci = min(max(kc - qc + 15, 0), 30);
                    const float bz = rp_[ri * 31 + ci];
                    const float z = (sv[e] + bz) + (valid ? 0.f : -INFINITY); sv[e] = z; mx = fmaxf(mx, z); }
                S[i * 2 + hf] = sv;
            }
#pragma unroll
        for (int j = 0; j < 16; ++j) {
            const LAS unsigned char* kr = SM + AT_KC + (16 * j + fr) * AT_KROW + 16 * fq;
            const f16x8 k0 = *(const LAS f16x8*)kr, k1 = *(const LAS f16x8*)(kr + 64);
            f32x4 sv = __builtin_amdgcn_mfma_f32_16x16x32_f16(k0, q0, (f32x4){0.f, 0.f, 0.f, 0.f}, 0, 0, 0);
            sv = __builtin_amdgcn_mfma_f32_16x16x32_f16(k1, q1, sv, 0, 0, 0);
#pragma unroll
            for (int e = 0; e < 4; ++e) mx = fmaxf(mx, sv[e]);
            S[16 + j] = sv;
        }
        mx = fmaxf(mx, __shfl_xor(mx, 16)); mx = fmaxf(mx, __shfl_xor(mx, 32));
        float sum = 0.f;
        f16x4 P[32];
#pragma unroll
        for (int t = 0; t < 32; ++t) {
#pragma unroll
            for (int e = 0; e < 4; ++e) { const float p = __builtin_amdgcn_exp2f(S[t][e] - mx); sum += p; P[t][e] = (f16)p; } }
        sum += __shfl_xor(sum, 16); sum += __shfl_xor(sum, 32);
        const float rsum = __builtin_amdgcn_rcpf(sum);
        __builtin_amdgcn_sched_barrier(0);
        u32x4 tv[9];
        attn_load_band<0, 9, 9>(Vp, bh, rs0, tid, tv);
        __builtin_amdgcn_sched_barrier(0);
        AT_BAR();
#pragma unroll
        for (int it = 0; it < 9; ++it) { const int q = it * 512 + tid, row = q >> 3, c16 = q & 7; *(LAS u32x4*)(SM + row * AT_KROW + c16 * 16) = tv[it]; }
        AT_BAR();
        if (up + F.G < NUP) { int rp2, bh2, rs2; attn_decode(up + F.G, F.G, rp2, bh2, rs2); attn_load_band<0, AT_NPF, AT_NPF>(Kp, bh2, rs2, tid, tk); }
        __builtin_amdgcn_sched_barrier(0);
        f32x4 O[4];
#pragma unroll
        for (int dt = 0; dt < 4; ++dt) O[dt] = (f32x4){0.f, 0.f, 0.f, 0.f};
        const int trq = fr >> 2, trp = fr & 3;
#pragma unroll
        for (int i = 0; i < 8; ++i) {
            f16x8 pf;
#pragma unroll
            for (int e = 0; e < 4; ++e) { pf[e] = P[2 * i][e]; pf[4 + e] = P[2 * i + 1][e]; }
            const LAS unsigned char* vb_ = SM + ((i0 + i) * 64 + cw + 4 * fq + trq) * AT_KROW + 8 * trp;
#pragma unroll
            for (int dt = 0; dt < 4; ++dt) { const f16x4 va = at_vtr(vb_ + 32 * dt), vb = at_vtr(vb_ + 16 * AT_KROW + 32 * dt); f16x8 vf;
#pragma unroll
                for (int e = 0; e < 4; ++e) { vf[e] = va[e]; vf[4 + e] = vb[e]; }
                O[dt] = __builtin_amdgcn_mfma_f32_16x16x32_f16(vf, pf, O[dt], 0, 0, 0); }
        }
#pragma unroll
        for (int jp = 0; jp < 8; ++jp) {
            f16x8 pf;
#pragma unroll
            for (int e = 0; e < 4; ++e) { pf[e] = P[16 + 2 * jp][e]; pf[4 + e] = P[17 + 2 * jp][e]; }
            const LAS unsigned char* vb_ = SM + AT_VC + (32 * jp + 4 * fq + trq) * AT_KROW + 8 * trp;
#pragma unroll
            for (int dt = 0; dt < 4; ++dt) { const f16x4 va = at_vtr(vb_ + 32 * dt), vb = at_vtr(vb_ + 16 * AT_KROW + 32 * dt); f16x8 vf;
#pragma unroll
                for (int e = 0; e < 4; ++e) { vf[e] = va[e]; vf[4 + e] = vb[e]; }
                O[dt] = __builtin_amdgcn_mfma_f32_16x16x32_f16(vf, pf, O[dt], 0, 0, 0); }
        }
#pragma unroll
        for (int dt = 0; dt < 4; ++dt) { u32x2 o; o.x = pk2h(O[dt][0] * rsum, O[dt][1] * rsum); o.y = pk2h(O[dt][2] * rsum, O[dt][3] * rsum);
            *(u32x2*)(Q + qrow + 16 * dt + 4 * fq) = o; }
        AT_BAR();
    }
}

template <int NT, int MODE, int CB = 0, int NCHK = 4>
__device__ __forceinline__ void ctx_gemm(Frame& F, const f16* A, int lda, const f16* Bt, int K, const pg8::Epi& E) {
    constexpr int KC = 256, PITCH = KC * 2 + 16, NROWS = 32 + 16 * NT, NLD = NROWS / 16;
    LAS unsigned char* SM = F.lds;
    const int w = F.wave, rt = w >> 2, kq = w & 3;
    for (int tile = blockIdx.x; tile < 256; tile += F.G) {
        int l_ = F.lane; asm volatile("" : "+v"(l_));
        const int l = l_, fr = l & 15, fq = l >> 4, tid = w * 64 + l;
        const int rb = tile & 15, cb = tile >> 4;
        const int row = MLAT + rb * 32 + 16 * rt + fr;
        const f16* src[NLD];
#pragma unroll
        for (int it = 0; it < NLD; ++it) { const int q = it * 512 + tid, srow = q >> 5, c16 = q & 31;
            if (srow < 32) src[it] = A + (size_t)(MLAT + rb * 32 + srow) * lda + c16 * 8;
            else { const int j = srow - 32; int brow;
                if (MODE == 3) { const int jj = cb * 64 + 16 * ((j >> 4) & 3) + (j & 15); brow = (jj >> 7) * 256 + (jj & 127) + ((j >> 4) >= 4 ? 128 : 0); }
                else brow = CB + cb * (16 * NT) + j;
                src[it] = Bt + (size_t)brow * K + c16 * 8; } }
        f32x4 fin[NT / 4];
#pragma unroll
        for (int i = 0; i < NT / 4; ++i) fin[i] = (f32x4){0.f, 0.f, 0.f, 0.f};
        constexpr int DEPTH = 3;
        u32x4 tr[DEPTH][NLD];
#pragma unroll
        for (int d = 0; d < DEPTH - 1; ++d) if (d < NCHK) {
#pragma unroll
            for (int it = 0; it < NLD; ++it) tr[d][it] = *(const u32x4*)(src[it] + d * KC); }
#pragma unroll
        for (int c = 0; c < NCHK; ++c) {
            if (c + DEPTH - 1 < NCHK) {
#pragma unroll
                for (int it = 0; it < NLD; ++it) tr[(c + DEPTH - 1) % DEPTH][it] = *(const u32x4*)(src[it] + (c + DEPTH - 1) * KC); }
            AT_BAR();
#pragma unroll
            for (int it = 0; it < NLD; ++it) { const int q = it * 512 + tid; *(LAS u32x4*)(SM + (q >> 5) * PITCH + (q & 31) * 16) = tr[c % DEPTH][it]; }
            AT_BAR();
#pragma unroll
            for (int ks = 0; ks < KC / 32; ++ks) { const f16x8 av = *(const LAS f16x8*)(SM + (16 * rt + fr) * PITCH + ks * 64 + 16 * fq);
#pragma unroll
                for (int i = 0; i < NT / 4; ++i) { const f16x8 bv = *(const LAS f16x8*)(SM + (32 + 16 * (kq + 4 * i) + fr) * PITCH + ks * 64 + 16 * fq);
                    fin[i] = __builtin_amdgcn_mfma_f32_16x16x32_f16(bv, av, fin[i], 0, 0, 0); } }
        }
        if (MODE == 0) {
            const float rinv = __builtin_amdgcn_rsqf(E.ss[row] * (1.0f / 1024.0f) + 1e-6f);
#pragma unroll
            for (int i = 0; i < NT / 4; ++i) { int col = CB + cb * (16 * NT) + 16 * (kq + 4 * i) + 4 * fq; f16* base = E.O16;
                const f32x4 v = fin[i] * rinv + *(const f32x4*)(E.bias + 2 * 5632 + col);
                if (E.split_cols) { const int t = col / E.split_cols; base += (size_t)t * E.split_stride; col -= t * E.split_cols; }
                u32x2 o; o.x = pk2h(v[0], v[1]); o.y = pk2h(v[2], v[3]);
                *(u32x2*)(base + (size_t)row * E.ldo + col) = o; }
        } else {
            const int col = cb * 64 + 16 * kq + 4 * fq; const size_t off = (size_t)row * D + col;
            const f32x4 xs = *(const f32x4*)(E.Xs + off); f32x4 xn;
            if (MODE == 2) { const f32x4 gv = *(const f32x4*)(E.gate + 2 * 9216 + col) * E.coef; xn = xs + gv * fin[0]; }
            else { const f32x4 gv = *(const f32x4*)(E.gate + 2 * 9216 + col);
#pragma unroll
                for (int e = 0; e < 4; ++e) xn[e] = xs[e] + gv[e] * fin[0][e] * sigmoidf_(fin[NT / 4 - 1][e]); }
            *(f32x4*)(E.Xd + off) = xn;
            if (E.An) { const f32x4 a0 = xn * *(const f32x4*)(E.gsn + 2 * 1024 + col);
                u32x2 o; o.x = pk2h(a0[0], a0[1]); o.y = pk2h(a0[2], a0[3]);
                *(u32x2*)(E.An + off) = o;
                float sq = (xn[0] * xn[0] + xn[1] * xn[1]) + (xn[2] * xn[2] + xn[3] * xn[3]);
                sq += __shfl_xor(sq, 16); sq += __shfl_xor(sq, 32); if (fq == 0) atomicAdd(E.ssn + row, sq); }
        }
        __syncthreads();
    }
}

#define XB_TMO      128
#define XB_XCNT(j)  (256  + 64 * (j))
#define XB_XSUB(j)  (1280 + 64 * (j))
#define XB_XGEN(j)  (2304 + 64 * (j))
#define XB_TOP      3328
#define XB_TOPGEN   3392
#define XCD_BAR_WORDS 3456
#define XB_SPIN_CAP (1u << 18)

__device__ __forceinline__ unsigned xb_ld(unsigned* p)              { return __hip_atomic_load(p, __ATOMIC_RELAXED, __HIP_MEMORY_SCOPE_AGENT); }
__device__ __forceinline__ unsigned xb_add(unsigned* p, unsigned v) { return __hip_atomic_fetch_add(p, v, __ATOMIC_RELAXED, __HIP_MEMORY_SCOPE_AGENT); }
__device__ __forceinline__ unsigned xb_xcc_id() { return (unsigned)__builtin_amdgcn_s_getreg((3 << 11) | 20) & 0xFu; }
#define XB_SPIN(cond, bar) do { unsigned _sp = 0; while (cond) { __builtin_amdgcn_s_sleep(1); \
    if ((++_sp & 255u) == 0u) { if (xb_ld(&(bar)[XB_TMO])) break; if (_sp > XB_SPIN_CAP) { atomicAdd(&(bar)[XB_TMO], 1u); break; } } } } while (0)

struct XcdBarrier {
    unsigned* bar; unsigned x;
    volatile LAS unsigned* st;
};

__device__ __forceinline__ XcdBarrier xcd_barrier_post(unsigned* bar, volatile LAS unsigned* st) {
    XcdBarrier b; b.bar = bar; b.x = xb_xcc_id(); b.st = st;
    if (threadIdx.x == 0) (void)xb_add(&bar[XB_XCNT(b.x)], 1u);
    return b;
}
__device__ __forceinline__ void xcd_barrier_complete(unsigned* bar, unsigned x, unsigned& nloc, unsigned& nx) {
    const unsigned G = gridDim.x * gridDim.y * gridDim.z;
    unsigned sum, cnt, mine, sp = 0u;
    for (;;) {
        sum = 0u; cnt = 0u; mine = 0u;
#pragma unroll
        for (unsigned j = 0; j < 16; ++j) { const unsigned c = xb_ld(&bar[XB_XCNT(j)]); sum += c; cnt += (c > 0u) ? 1u : 0u; mine = (j == x) ? c : mine; }
        if (sum == G) break;
        __builtin_amdgcn_s_sleep(1);
        if ((++sp & 255u) == 0u) { if (xb_ld(&bar[XB_TMO])) break; if (sp > XB_SPIN_CAP) { atomicAdd(&bar[XB_TMO], 1u); break; } }
    }
    nloc = mine > 0u ? mine : 1u; nx = cnt > 0u ? cnt : 1u;
}

__device__ __forceinline__ void xcd_barrier(const XcdBarrier& b) {
    asm volatile("s_waitcnt vmcnt(0)" ::: "memory");
    __syncthreads();
    if (threadIdx.x == 0) {
        unsigned* bar = b.bar;
        __builtin_amdgcn_s_waitcnt(0);
        unsigned nloc = b.st[0], nx = b.st[1];
        if (nloc == 0u) { xcd_barrier_complete(bar, b.x, nloc, nx); b.st[0] = nloc; b.st[1] = nx; }
        const unsigned old = xb_add(&bar[XB_XSUB(b.x)], 1u);
        const unsigned gen = old / nloc;
        if (old + 1u == (gen + 1u) * nloc) {
            __builtin_amdgcn_fence(__ATOMIC_RELEASE, "agent");
            asm volatile("s_waitcnt vmcnt(0)" ::: "memory");
            const unsigned og = xb_add(&bar[XB_TOP], 1u);
            const unsigned tg = og / nx;
            if (og + 1u == (tg + 1u) * nx) xb_add(&bar[XB_TOPGEN], 1u);
            else XB_SPIN(xb_ld(&bar[XB_TOPGEN]) == tg, bar);
            __builtin_amdgcn_fence(__ATOMIC_ACQUIRE, "agent");
            xb_add(&bar[XB_XGEN(b.x)], 1u);
            asm volatile("s_waitcnt vmcnt(0)" ::: "memory");
        } else {
            XB_SPIN(xb_ld(&bar[XB_XGEN(b.x)]) == gen, bar);
            __builtin_amdgcn_fence(__ATOMIC_ACQUIRE, "agent");
            asm volatile("s_waitcnt vmcnt(0)" ::: "memory");
        }
    }
    __syncthreads();
}

__global__ void __launch_bounds__(512, 2) fwd_megakernel(Args args) {
    extern __shared__ __attribute__((aligned(16))) unsigned char lds_raw[];
    Frame F;
    F.lds = (LAS unsigned char*)lds_raw;
    F.tid = threadIdx.x; F.lane = F.tid & 63; F.wave = __builtin_amdgcn_readfirstlane(F.tid >> 6);
    F.G = gridDim.x; { const int bx = blockIdx.x; F.vcu = (F.G % 8 == 0) ? (bx % 8) * (F.G / 8) + bx / 8 : bx; }
    unsigned char* ws = args.ws;
    float* MOD = (float*)(ws + WS_MOD); float* X = (float*)(ws + WS_X); f16* H16 = (f16*)(ws + WS_H16); f16* HID = (f16*)(ws + WS_HID);
    const float* norm_g = args.in[4];
    cg::grid_group grid = cg::this_grid();
    volatile LAS unsigned* bst = (volatile LAS unsigned*)(F.lds + LDS_BYTES - 16);
    if (F.tid < 4) bst[F.tid] = 0u;
    __syncthreads();
    XcdBarrier xbar = xcd_barrier_post((unsigned*)(ws + WS_BAR), bst);

    const int lo = args.ph_lo, hi = args.ph_hi;
    if (hi > (1 << 20)) grid.sync();
#define IN(k) (lo <= (k) && (k) < hi)
#define SEAM(k) do { if (IN(k) && IN((k) + 1)) xcd_barrier(xbar); asm volatile("" : "+v"(F.tid), "+v"(F.lane)); } while (0)
#define RUN_GEMM(Ap, Bp, Mr, Nc, Kc) do { pg8::Gemm g{(const u16*)(Ap), (const u16*)(Bp), (Mr), (Nc), (Kc)}; pg8::StaticOrder S; S.init(g.M, g.N, F.G, (int)blockIdx.x); pg8::gemm_phase(F.lds, g, S, E); } while (0)
#define CONV_TAIL(job) do { const int rem_ = (66 * 22) % F.G; \
        if (rem_ == 0) conv_job(F, args, (job), F.vcu * 8 + F.wave, F.G * 8); \
        else if ((int)blockIdx.x >= rem_) conv_job(F, args, (job), ((int)blockIdx.x - rem_) * 8 + F.wave, (F.G - rem_) * 8); } while (0)
#define SSP(sl) ((float*)(ws + WS_SS) + (size_t)(sl) * MALL)
#define GSP(sl) ((const float*)(ws + WS_GS) + (sl) * 3072)
#define BIASP(sl) ((const float*)(ws + WS_BIAS) + (sl) * 3 * 5632)
#define EPI_F16(dst, ld, sc, sst, sl) pg8::Epi E{(dst), (sst), nullptr, nullptr, nullptr, SSP(sl), BIASP(sl), nullptr, nullptr, nullptr, 0, (ld), (sc), 0.f}
#define EPI_SWIGLU(sl) pg8::Epi E{HID, 0, nullptr, nullptr, nullptr, SSP(sl), BIASP(sl), nullptr, nullptr, nullptr, 1, FH, 0, 0.f}
#define EPI_RES(md, dst, gt, cf, nsl) pg8::Epi E{nullptr, 0, X, (dst), (gt), nullptr, nullptr, (nsl) >= 0 ? H16 : nullptr, GSP((nsl) >= 0 ? (nsl) : 0), SSP((nsl) >= 0 ? (nsl) : 0), (md), 0, 0, (cf)}
    if (IN(0)) { p0_phase(F, args); } SEAM(0);
    if (IN(1)) { p1_phase(F, args); } SEAM(1);
    if (IN(2)) { EPI_SWIGLU(0); RUN_GEMM(H16, ws + WS_WFI + 0 * WFI_SZ, MALL, 5632, 1024); CONV_TAIL(1); } SEAM(2);
#if REP_FFNIN > 1
    if (IN(2)) { EPI_SWIGLU(0); RUN_GEMM(H16, ws + WS_WFI + 0 * WFI_SZ, MALL, 5632, 1024); } SEAM(2);
#endif
    if (IN(3)) { EPI_RES(2, X, MOD + 0 * 3072 + 2048, 0.5f, 1); RUN_GEMM(HID, ws + WS_WFO + 0 * WFO_SZ, MLAT, 1024, FH); ctx_gemm<4, 2, 0, 11>(F, HID, FH, (const f16*)(ws + WS_WFO + 0 * WFO_SZ), FH, E); bias_rows(F, args, 1, 2); } SEAM(3);
    if (IN(5)) { EPI_F16((f16*)(ws + WS_U16), D, 0, 0, 1); RUN_GEMM(H16, ws + WS_WSI, MLAT, 1024, 1024); ctx_gemm<4, 0>(F, H16, D, (const f16*)(ws + WS_WSI), 1024, E); } SEAM(5);
    if (IN(6)) { s5_pass<false>(F, ws, args.in[17]); } SEAM(6);
#if REP_S5 == 2
    if (IN(6)) { s5_pass<false>(F, ws, args.in[17]); } SEAM(6);
#endif
    if (IN(7)) { s5_carry(F, ws); } SEAM(7);
    if (IN(8)) { s5_pass<true>(F, ws, args.in[17]); } SEAM(8);
#if REP_S5 == 4
    if (IN(8)) { s5_pass<true>(F, ws, args.in[17]); } SEAM(8);
#endif
    if (IN(9)) { EPI_RES(3, X, MOD + 1 * 3072 + 2048, 1.f, 2); RUN_GEMM(ws + WS_G16, ws + WS_WGLU, MLAT, 2048, 1024); ctx_gemm<8, 3>(F, (const f16*)(ws + WS_G16), D, (const f16*)(ws + WS_WGLU), 1024, E); } SEAM(9);
    if (IN(11)) { EPI_SWIGLU(2); RUN_GEMM(H16, ws + WS_WFI + 1 * WFI_SZ, MALL, 5632, 1024); CONV_TAIL(2); } SEAM(11);
    if (IN(12)) { EPI_RES(2, X, MOD + 2 * 3072 + 2048, 0.5f, 3); RUN_GEMM(HID, ws + WS_WFO + 1 * WFO_SZ, MLAT, 1024, FH); ctx_gemm<4, 2, 0, 11>(F, HID, FH, (const f16*)(ws + WS_WFO + 1 * WFO_SZ), FH, E); bias_rows(F, args, 3, 4); } SEAM(12);
    if (IN(14)) { EPI_SWIGLU(3); RUN_GEMM(H16, ws + WS_WFI + 2 * WFI_SZ, MALL, 5632, 1024); CONV_TAIL(3); } SEAM(14);
    if (IN(15)) { EPI_RES(2, X, MOD + 3 * 9216 + 0 * 3072 + 2048, 0.5f, 4); RUN_GEMM(HID, ws + WS_WFO + 2 * WFO_SZ, MLAT, 1024, FH); ctx_gemm<4, 2, 0, 11>(F, HID, FH, (const f16*)(ws + WS_WFO + 2 * WFO_SZ), FH, E); bias_rows(F, args, 5, 5); } SEAM(15);
    if (IN(17)) { EPI_F16((f16*)(ws + WS_Q16), D, 1024, (size_t)MALL * D, 4); RUN_GEMM(H16, ws + WS_WQKV, MLAT, 3072, 1024); ctx_gemm<8, 0, 1024>(F, H16, D, (const f16*)(ws + WS_WQKV), 1024, E); } SEAM(17);
    if (IN(19)) { attn_phase(F, ws, args.in[22], args.in[20], args.in[21]); } SEAM(19);
#if REP_ATTN > 1
    if (IN(19)) { attn_phase(F, ws, args.in[22], args.in[20], args.in[21]); } SEAM(19);
#endif
    if (IN(20)) { EPI_RES(2, X, MOD + 3 * 9216 + 1 * 3072 + 2048, 1.f, 5); RUN_GEMM(ws + WS_Q16, ws + WS_WO, MLAT, 1024, 1024); } SEAM(20);
    if (IN(22)) { EPI_SWIGLU(5); RUN_GEMM(H16, ws + WS_WFI + 3 * WFI_SZ, MLAT, 5632, 1024); } SEAM(22);
    if (IN(23)) { EPI_RES(2, args.out, MOD + 3 * 9216 + 2 * 3072 + 2048, 0.5f, -1); RUN_GEMM(HID, ws + WS_WFO + 3 * WFO_SZ, MLAT, 1024, FH); }
}

extern "C" void kernel_launch(void* const* d_in, const int* in_sizes, int n_in, void* d_out, int out_size, void* d_ws, size_t ws_size, hipStream_t stream) {
    static int grid = 0;
    if (grid == 0) {
        if (n_in != 24 || ws_size < WS_END) { fprintf(stderr, "kernel_launch: unexpected n_in %d or ws_size %zu (< %zu)\n", n_in, ws_size, (size_t)WS_END); grid = -1; return; }
        int dev = 0, cus = 0, per_cu = 0;
        hipGetDevice(&dev); hipDeviceGetAttribute(&cus, hipDeviceAttributeMultiprocessorCount, dev);
        if (hipFuncSetAttribute((const void*)fwd_megakernel, hipFuncAttributeMaxDynamicSharedMemorySize, LDS_BYTES) != hipSuccess) { fprintf(stderr, "kernel_launch: hipFuncSetAttribute failed\n"); }
        if (hipOccupancyMaxActiveBlocksPerMultiprocessor(&per_cu, (const void*)fwd_megakernel, 512, LDS_BYTES) != hipSuccess || per_cu < 1) { fprintf(stderr, "kernel_launch: occupancy query says %d\n", per_cu); per_cu = 1; }
        (void)hipGetLastError();
        grid = cus * 1;
        if (grid <= 0) grid = 256;
    }
    if (grid < 0) return;
    hipMemsetAsync((char*)d_ws + WS_MOD, 0, MOD_BYTES, stream);
    Args a{};
    for (int i = 0; i < 24; ++i) a.in[i] = (const float*)d_in[i];
    a.out = (float*)d_out; a.ws = (unsigned char*)d_ws;
#if MK_COOP
    a.ph_lo = 0; a.ph_hi = NPHASE;
    void* kargs[] = {&a};
    hipError_t e = hipLaunchCooperativeKernel((const void*)fwd_megakernel, dim3(grid), dim3(512), kargs, LDS_BYTES, stream);
    if (e != hipSuccess) fprintf(stderr, "cooperative launch failed: %s (grid %d)\n", hipGetErrorString(e), grid);
#else
    for (int ph = 0; ph < NPHASE; ++ph) {
        a.ph_lo = ph; a.ph_hi = ph + 1;
        hipLaunchKernelGGL(fwd_megakernel, dim3(grid), dim3(512), LDS_BYTES, stream, a);
    }
#endif
}
```

```cpp
#include <hip/hip_runtime.h>
#include <hip/hip_cooperative_groups.h>
#include <cstdio>
#include <cstdint>
namespace cg = cooperative_groups;

#ifndef REP_S5
#define REP_S5 1
#endif
#ifndef REP_ATTN
#define REP_ATTN 1
#endif
#ifndef REP_FFNIN
#define REP_FFNIN 1
#endif
#ifndef REP_NORM
#define REP_NORM 1
#endif
#ifndef REP_CONV
#define REP_CONV 1
#endif
#ifndef MK_COOP
#define MK_COOP 1
#endif

#define LAS __attribute__((address_space(3)))
typedef _Float16 f16;
typedef f16 f16x8 __attribute__((ext_vector_type(8)));
typedef f16 f16x4 __attribute__((ext_vector_type(4)));
typedef f16 f16x2 __attribute__((ext_vector_type(2)));
typedef float f32x4 __attribute__((ext_vector_type(4)));
typedef float f32x2 __attribute__((ext_vector_type(2)));
typedef unsigned u32x4 __attribute__((ext_vector_type(4)));
typedef unsigned u32x2 __attribute__((ext_vector_type(2)));
typedef unsigned short u16;

constexpr int D = 1024, SEQ = 8192, NB = 2, CTX = 256, FH = 2816;
constexpr int MLAT = NB * SEQ;
constexpr int MALL = MLAT + NB * CTX;
constexpr int NCH = 132;
constexpr float EPS = 1e-6f;

constexpr size_t MiB = 1u << 20;
constexpr size_t WS_MOD = 0;
constexpr size_t MOD_BYTES = 262144;
constexpr size_t WS_BAR = 229376;
constexpr size_t WS_LAM = 262144;
constexpr size_t WS_LAMT = WS_LAM + 65536;
constexpr size_t WS_BMAT = WS_LAMT + 65536;
constexpr size_t WS_CMAT = WS_BMAT + 524288;
constexpr size_t WS_WFI = 2 * MiB;
constexpr size_t WFI_SZ = (size_t)5632 * 1024 * 2;
constexpr size_t WS_WFO = WS_WFI + 4 * WFI_SZ;
constexpr size_t WFO_SZ = (size_t)1024 * 2816 * 2;
constexpr size_t WS_WSI = WS_WFO + 4 * WFO_SZ;
constexpr size_t WS_WGLU = WS_WSI + 2 * MiB;
constexpr size_t WS_WQKV = WS_WGLU + 4 * MiB;
constexpr size_t WS_WO = WS_WQKV + 6 * MiB;
constexpr size_t WS_X = 82 * MiB;
constexpr size_t WS_H16 = 148 * MiB;
constexpr size_t WS_R = 181 * MiB;
constexpr size_t WS_HID = WS_R;
constexpr size_t WS_U16 = WS_R;
constexpr size_t WS_G16 = WS_R + 33 * MiB;
constexpr size_t WS_E = WS_R + 66 * MiB;
constexpr size_t WS_CIN = WS_R + 83 * MiB;
constexpr size_t WS_Q16 = WS_R;
constexpr size_t WS_K16 = WS_R + 33 * MiB;
constexpr size_t WS_V16 = WS_R + 66 * MiB;
constexpr size_t WS_VT = WS_R + 99 * MiB;
constexpr size_t WS_VTC = WS_R + 131 * MiB;
constexpr size_t WS_SS = WS_CMAT + 524288;
constexpr size_t WS_GS = WS_SS + (size_t)6 * 16896 * 4;
constexpr size_t WS_BIAS = 313 * MiB;
constexpr size_t WS_END = 314 * MiB;
static_assert(WS_GS + 6 * 3 * 1024 * 4 <= 2 * MiB, "small tables below the weights");
static_assert(WS_WO + 2 * MiB == WS_X, "weights end at X");

constexpr int LDS_BYTES = 163840;
constexpr int NPHASE = 24;

namespace pg8 {
constexpr int BM = 256, BK = 64, HALF = 128, HTB = HALF * BK * 2, STAGE_BYTES = 8 * HTB, NXCD = 8, WGM = 8;
__host__ __device__ __forceinline__ int lds_byte(int r, int c) { const int st = (r >> 4) * 2 + (c >> 5), rr = r & 15, cc = c & 31, ob = rr * 64 + cc * 2; return st * 1024 + (ob ^ (((ob >> 9) & 1) << 5)); }
__host__ __device__ __forceinline__ void stage_rc(int b, int& R, int& C) { const int st = b / 1024, sb = b % 1024, swz = sb ^ (((sb >> 9) & 1) << 5); R = (st >> 1) * 16 + swz / 64; C = (st & 1) * 32 + (swz % 64) / 2; }
__host__ __device__ __forceinline__ int perm32(int rho) { const int n = rho >> 4, i = rho & 15; return 8 * (i >> 2) + 4 * n + (i & 3); }

struct Unit { int pm, pn; };
struct Gemm { const u16* A; const u16* Bt; int M, N, K; };

struct StaticOrder {
    int nM, nN, nwg, G, c;
    __device__ void init(int M, int N, int G_, int c_) { nM = M / BM; nN = N / BM; nwg = nM * nN; G = G_; c = c_; }
    __device__ bool next(int i, Unit& u) const {
        const long L = (long)i * G + c; if (L >= nwg) return false;
        int wgid = (int)L; { const int q = nwg / NXCD, r = nwg % NXCD, xcd = wgid % NXCD, off = wgid / NXCD; wgid = (xcd < r ? xcd * (q + 1) : r * (q + 1) + (xcd - r) * q) + off; }
        const int nig = WGM * nN, gid = wgid / nig, fm = gid * WGM, gsz = (nM - fm) < WGM ? (nM - fm) : WGM;
        u.pm = fm + ((wgid % nig) % gsz); u.pn = (wgid % nig) / gsz; return true;
    }
};

__device__ __forceinline__ unsigned pk2h(float a, float b) { f16x2 v; v.x = (f16)a; v.y = (f16)b; return __builtin_bit_cast(unsigned, v); }
__device__ __forceinline__ float sigmoidf_(float x) { return __builtin_amdgcn_rcpf(1.0f + __expf(-x)); }

struct Epi {
    static constexpr bool PERM = true;
    f16* O16; size_t split_stride;
    const float* Xs; float* Xd; const float* gate;
    const float* ss; const float* bias;
    f16* An; const float* gsn; float* ssn;
    int mode;
    int ldo; int split_cols; float coef;
    __device__ __forceinline__ void operator()(const f32x4 (&acc)[2][2][4][2], const Unit& u, int wr, int wc, int fr, int fq) const {
        const int row0 = u.pm * BM + wr * 64 + fr;
        const int rowt = u.pm * BM; const int mi = rowt < SEQ ? 0 : (rowt < MLAT ? 1 : 2);
        if (mode == 0) {
            int colt = u.pn * BM; f16* base = O16;
            const float* bp = bias + mi * 5632 + colt + wc * 32 + 8 * fq;
            if (split_cols) { const int t = colt / split_cols; base += (size_t)t * split_stride; colt -= t * split_cols; }
            const int col0 = colt + wc * 32 + 8 * fq;
            f32x4 bv[2][2];
#pragma unroll
            for (int bj = 0; bj < 2; ++bj)
#pragma unroll
                for (int n = 0; n < 2; ++n) bv[bj][n] = *(const f32x4*)(bp + bj * HALF + 4 * n);
#pragma unroll
            for (int ai = 0; ai < 2; ++ai)
#pragma unroll
                for (int m = 0; m < 4; ++m) { const int row = row0 + ai * HALF + m * 16; f16* rowp = base + (size_t)row * ldo + col0;
                    const float rinv = __builtin_amdgcn_rsqf(ss[row] * (1.0f / 1024.0f) + 1e-6f);
#pragma unroll
                    for (int bj = 0; bj < 2; ++bj) { const f32x4 v0 = acc[ai][bj][m][0] * rinv + bv[bj][0], v1 = acc[ai][bj][m][1] * rinv + bv[bj][1];
                        u32x4 w; w.x = pk2h(v0[0], v0[1]); w.y = pk2h(v0[2], v0[3]); w.z = pk2h(v1[0], v1[1]); w.w = pk2h(v1[2], v1[3]);
                        *(u32x4*)(rowp + bj * HALF) = w; } }
        } else if (mode == 1) {
            const int col0 = u.pn * HALF + wc * 32 + 8 * fq;
            const float* bp = bias + mi * 5632 + u.pn * BM + wc * 32 + 8 * fq;
            f32x4 bv[2][2];
#pragma unroll
            for (int bj = 0; bj < 2; ++bj)
#pragma unroll
                for (int n = 0; n < 2; ++n) bv[bj][n] = *(const f32x4*)(bp + bj * HALF + 4 * n);
#pragma unroll
            for (int ai = 0; ai < 2; ++ai)
#pragma unroll
                for (int m = 0; m < 4; ++m) { const int row = row0 + ai * HALF + m * 16; f16* rowp = O16 + (size_t)row * ldo + col0;
                    const float rinv = __builtin_amdgcn_rsqf(ss[row] * (1.0f / 1024.0f) + 1e-6f);
                    float h[8];
#pragma unroll
                    for (int n = 0; n < 2; ++n)
#pragma unroll
                        for (int e = 0; e < 4; ++e) { const float g = acc[ai][0][m][n][e] * rinv + bv[0][n][e], up = acc[ai][1][m][n][e] * rinv + bv[1][n][e]; h[n * 4 + e] = g * sigmoidf_(g) * up; }
                    u32x4 w; w.x = pk2h(h[0], h[1]); w.y = pk2h(h[2], h[3]); w.z = pk2h(h[4], h[5]); w.w = pk2h(h[6], h[7]);
                    *(u32x4*)rowp = w; }
        } else {
            const float* gp = gate + mi * 9216;
            if (mode == 2) {
                const int col0 = u.pn * BM + wc * 32 + 8 * fq;
                f32x4 gv[2][2], gs[2][2];
#pragma unroll
                for (int bj = 0; bj < 2; ++bj)
#pragma unroll
                    for (int n = 0; n < 2; ++n) { gv[bj][n] = *(const f32x4*)(gp + col0 + bj * HALF + 4 * n) * coef;
                        gs[bj][n] = *(const f32x4*)(gsn + mi * 1024 + col0 + bj * HALF + 4 * n); }
#pragma unroll
                for (int ai = 0; ai < 2; ++ai)
#pragma unroll
                    for (int m = 0; m < 4; ++m) { const int row = row0 + ai * HALF + m * 16; const size_t off = (size_t)row * D + col0; float sq = 0.f;
#pragma unroll
                        for (int bj = 0; bj < 2; ++bj) { f32x4 xn[2];
#pragma unroll
                            for (int n = 0; n < 2; ++n) { const f32x4 xs = *(const f32x4*)(Xs + off + bj * HALF + 4 * n);
                                xn[n] = xs + gv[bj][n] * acc[ai][bj][m][n];
                                *(f32x4*)(Xd + off + bj * HALF + 4 * n) = xn[n];
                                sq += (xn[n][0] * xn[n][0] + xn[n][1] * xn[n][1]) + (xn[n][2] * xn[n][2] + xn[n][3] * xn[n][3]); }
                            if (An) { const f32x4 a0 = xn[0] * gs[bj][0], a1 = xn[1] * gs[bj][1];
                                u32x4 w; w.x = pk2h(a0[0], a0[1]); w.y = pk2h(a0[2], a0[3]); w.z = pk2h(a1[0], a1[1]); w.w = pk2h(a1[2], a1[3]);
                                *(u32x4*)(An + off + bj * HALF) = w; } }
                        if (An) { sq += __shfl_xor(sq, 16); sq += __shfl_xor(sq, 32); if (fq == 0) atomicAdd(ssn + row, sq); } }
            } else {
                const int col0 = u.pn * HALF + wc * 32 + 8 * fq;
                f32x4 gv[2], gs[2];
#pragma unroll
                for (int n = 0; n < 2; ++n) { gv[n] = *(const f32x4*)(gp + col0 + 4 * n); gs[n] = *(const f32x4*)(gsn + mi * 1024 + col0 + 4 * n); }
#pragma unroll
                for (int ai = 0; ai < 2; ++ai)
#pragma unroll
                    for (int m = 0; m < 4; ++m) { const int row = row0 + ai * HALF + m * 16; const size_t off = (size_t)row * D + col0; float sq = 0.f; f32x4 xn[2];
#pragma unroll
                        for (int n = 0; n < 2; ++n) { const f32x4 xs = *(const f32x4*)(Xs + off + 4 * n); const f32x4 a = acc[ai][0][m][n], b = acc[ai][1][m][n];
#pragma unroll
                            for (int e = 0; e < 4; ++e) xn[n][e] = xs[e] + gv[n][e] * a[e] * sigmoidf_(b[e]);
                            *(f32x4*)(Xd + off + 4 * n) = xn[n];
                            sq += (xn[n][0] * xn[n][0] + xn[n][1] * xn[n][1]) + (xn[n][2] * xn[n][2] + xn[n][3] * xn[n][3]); }
                        const f32x4 a0 = xn[0] * gs[0], a1 = xn[1] * gs[1];
                        u32x4 w; w.x = pk2h(a0[0], a0[1]); w.y = pk2h(a0[2], a0[3]); w.z = pk2h(a1[0], a1[1]); w.w = pk2h(a1[2], a1[3]);
                        *(u32x4*)(An + off) = w;
                        sq += __shfl_xor(sq, 16); sq += __shfl_xor(sq, 32); if (fq == 0) atomicAdd(ssn + row, sq); }
            }
        }
    }
};

__device__ __forceinline__ void gemm_phase(LAS unsigned char* lds, const Gemm g, const StaticOrder& S, const Epi& E) {
    int tid_ = threadIdx.x; asm volatile("" : "+v"(tid_));
    const int tid = tid_, wid = __builtin_amdgcn_readfirstlane(tid >> 6), lane = tid & 63, wr = wid >> 2, wc = wid & 3, fr = lane & 15, fq = lane >> 4;
    const int K = g.K, nt = K / BK;
    unsigned voffA[2], voffB[2];
#pragma unroll
    for (int i = 0; i < 2; ++i) { int R, C; stage_rc(tid * 16 + i * 8192, R, C); const int Rb = Epi::PERM ? ((R & ~31) + perm32(R & 31)) : R;
        voffA[i] = (unsigned)(R * K + C) * 2u; voffB[i] = (unsigned)(Rb * K + C) * 2u; }
    const size_t kstep = (size_t)(BK * 2);
    const size_t hstep = (size_t)HALF * K * 2;
    const size_t tstep = 2 * hstep;
    const unsigned ldsw = (unsigned)wid * 1024u;
    const int aoff = lds_byte(wr * 64 + fr, fq * 8), boff = lds_byte(wc * 32 + fr, fq * 8);
#define PG8_SA(b, h) (((b) * 2 + (h)) * HTB)
#define PG8_SB(b, h) ((4 + (b) * 2 + (h)) * HTB)
#define PG8_STAGE(bufoff, gbase, voff) do { _Pragma("unroll") for (int _i = 0; _i < 2; ++_i) \
        __builtin_amdgcn_global_load_lds((const unsigned*)((const char*)(gbase) + (voff)[_i]), (LAS unsigned*)(lds + (bufoff) + ldsw + _i * 8192), 16, 0, 0); } while (0)
#define PG8_LDA(dst, b, h) do { _Pragma("unroll") for (int m = 0; m < 4; ++m) _Pragma("unroll") for (int k = 0; k < 2; ++k) dst[m][k] = *(const LAS f16x8*)(lds + PG8_SA(b, h) + aoff + m * 2048 + k * 1024); } while (0)
#define PG8_LDB(dst, b, h) do { _Pragma("unroll") for (int n = 0; n < 2; ++n) _Pragma("unroll") for (int k = 0; k < 2; ++k) dst[n][k] = *(const LAS f16x8*)(lds + PG8_SB(b, h) + boff + n * 2048 + k * 1024); } while (0)
#define PG8_MMA(ai, bj, At, Bt) do { __builtin_amdgcn_s_setprio(1); _Pragma("unroll") for (int m = 0; m < 4; ++m) _Pragma("unroll") for (int n = 0; n < 2; ++n) _Pragma("unroll") for (int k = 0; k < 2; ++k) \
        acc[ai][bj][m][n] = __builtin_amdgcn_mfma_f32_16x16x32_f16(Bt[n][k], At[m][k], acc[ai][bj][m][n], 0, 0, 0); __builtin_amdgcn_s_setprio(0); } while (0)
#define PG8_WAIT_V(n) asm volatile("s_waitcnt vmcnt(" #n ")" ::: "memory")
#define PG8_WAIT_L(n) asm volatile("s_waitcnt lgkmcnt(" #n ")" ::: "memory")
#define PG8_BAR __builtin_amdgcn_s_barrier()
#define PG8_SCHED __builtin_amdgcn_sched_barrier(0)
    Unit cur, nxt; int ui = 0;
    if (!S.next(0, cur)) return;
    f32x4 acc[2][2][4][2];
#pragma unroll
    for (int a = 0; a < 2; ++a)
#pragma unroll
        for (int b = 0; b < 2; ++b)
#pragma unroll
            for (int m = 0; m < 4; ++m)
#pragma unroll
                for (int n = 0; n < 2; ++n) acc[a][b][m][n] = (f32x4){0.f, 0.f, 0.f, 0.f};
    f16x8 At[4][2], B0[2][2], B1[2][2];
    const char* cA = (const char*)g.A + (size_t)cur.pm * tstep; const char* cB = (const char*)g.Bt + (size_t)cur.pn * tstep;
    PG8_STAGE(PG8_SB(0, 0), cB, voffB); PG8_STAGE(PG8_SB(0, 1), cB + hstep, voffB); PG8_STAGE(PG8_SA(0, 0), cA, voffA); PG8_STAGE(PG8_SA(0, 1), cA + hstep, voffA);
    if (wr == 1) PG8_BAR;
    PG8_WAIT_V(2); PG8_BAR;
    PG8_STAGE(PG8_SB(1, 0), cB + kstep, voffB); PG8_STAGE(PG8_SA(1, 0), cA + kstep, voffA); PG8_STAGE(PG8_SB(1, 1), cB + hstep + kstep, voffB);
    PG8_WAIT_V(6); PG8_BAR;
    for (;;) {
        const bool has_next = S.next(ui + 1, nxt);
        const char* nA = has_next ? (const char*)g.A + (size_t)nxt.pm * tstep : cA; const char* nB = has_next ? (const char*)g.Bt + (size_t)nxt.pn * tstep : cB;
        for (int t = 0; t < nt; t += 2) {
            const bool last = (t == nt - 2);
            const char* a1 = cA + (size_t)(t + 1) * kstep;
            const char* a2 = last ? nA : cA + (size_t)(t + 2) * kstep; const char* b2 = last ? nB : cB + (size_t)(t + 2) * kstep;
            const char* a3 = a2 + kstep; const char* b3 = b2 + kstep;
            PG8_LDB(B0, 0, 0); PG8_LDB(B1, 0, 1); PG8_SCHED; PG8_LDA(At, 0, 0); PG8_STAGE(PG8_SA(1, 1), a1 + hstep, voffA);
            PG8_WAIT_V(8); PG8_WAIT_L(0); PG8_BAR; PG8_MMA(0, 0, At, B0); PG8_MMA(0, 1, At, B1); PG8_BAR; PG8_SCHED;
            PG8_LDA(At, 0, 1); PG8_STAGE(PG8_SB(0, 0), b2, voffB); PG8_STAGE(PG8_SB(0, 1), b2 + hstep, voffB); PG8_STAGE(PG8_SA(0, 0), a2, voffA);
            PG8_WAIT_V(8); PG8_WAIT_L(0); PG8_BAR; PG8_MMA(1, 0, At, B0); PG8_MMA(1, 1, At, B1); PG8_BAR; PG8_SCHED;
            PG8_LDB(B0, 1, 0); PG8_LDB(B1, 1, 1); PG8_SCHED; PG8_LDA(At, 1, 0); PG8_STAGE(PG8_SA(0, 1), a2 + hstep, voffA);
            PG8_WAIT_V(8); PG8_WAIT_L(0); PG8_BAR; PG8_MMA(0, 0, At, B0); PG8_MMA(0, 1, At, B1); PG8_BAR; PG8_SCHED;
            PG8_LDA(At, 1, 1); PG8_STAGE(PG8_SB(1, 0), b3, voffB); PG8_STAGE(PG8_SB(1, 1), b3 + hstep, voffB); PG8_STAGE(PG8_SA(1, 0), a3, voffA);
            PG8_WAIT_V(8); PG8_WAIT_L(0); PG8_BAR; PG8_MMA(1, 0, At, B0); PG8_MMA(1, 1, At, B1); PG8_BAR; PG8_SCHED;
        }
        if (wr == 0) PG8_BAR;
        E(acc, cur, wr, wc, fr, fq);
        if (!has_next) break;
#pragma unroll
        for (int a = 0; a < 2; ++a)
#pragma unroll
            for (int b = 0; b < 2; ++b)
#pragma unroll
                for (int m = 0; m < 4; ++m)
#pragma unroll
                    for (int n = 0; n < 2; ++n) acc[a][b][m][n] = (f32x4){0.f, 0.f, 0.f, 0.f};
        cur = nxt; cA = nA; cB = nB; ++ui;
        if (wr == 1) PG8_BAR;
    }
    PG8_WAIT_V(0);
    PG8_BAR;
#undef PG8_SA
#undef PG8_SB
#undef PG8_STAGE
#undef PG8_LDA
#undef PG8_LDB
#undef PG8_MMA
#undef PG8_WAIT_V
#undef PG8_WAIT_L
#undef PG8_BAR
#undef PG8_SCHED
}
}
using pg8::pk2h;
using pg8::sigmoidf_;

#define LDS_WAIT() asm volatile("s_waitcnt lgkmcnt(0)" ::: "memory")
#define CFENCE() asm volatile("" ::: "memory")

struct Args {
    const float* in[24]; float* out; unsigned char* ws; int ph_lo, ph_hi;
};

struct Frame {
    LAS unsigned char* lds; int tid, lane, wave, vcu, G;
};

__device__ __forceinline__ float wave_sum(float v) {
#pragma unroll
    for (int o = 1; o < 64; o <<= 1) v += __shfl_xor(v, o);
    return v;
}

__device__ __forceinline__ void p0_transpose_item(const float* W, int K, int N, int half_n, f16* WT, LAS float* scr, int item, int lane) {
    const int nblk = N / 32, kb = item / nblk, nb = item % nblk, k0 = 64 * kb, n0 = 32 * nb;
    int d0 = n0;
    if (half_n) { const int j = n0 < half_n ? n0 : n0 - half_n; d0 = (j >> 7) * 256 + (n0 < half_n ? 0 : 128) + (j & 127); }
#pragma unroll 8
    for (int i = 0; i < 32; ++i) { const int kk = 2 * i + (lane >> 5); scr[kk * 33 + (lane & 31)] = W[(size_t)(k0 + kk) * N + n0 + (lane & 31)]; }
    LDS_WAIT();
    const int c = lane & 7;
#pragma unroll
    for (int j = 0; j < 4; ++j) { const int n = (lane >> 3) + 8 * j; const LAS float* s = scr + (8 * c) * 33 + n;
        u32x4 o; o.x = pk2h(s[0 * 33], s[1 * 33]); o.y = pk2h(s[2 * 33], s[3 * 33]); o.z = pk2h(s[4 * 33], s[5 * 33]); o.w = pk2h(s[6 * 33], s[7 * 33]);
        *(u32x4*)(WT + (size_t)(d0 + n) * K + k0 + 8 * c) = o; }
    LDS_WAIT();
}

__device__ __forceinline__ void dsincos(double r, double& s, double& c) {
    const double r2 = r * r; double ts = r, tc = 1.0; s = r; c = 1.0;
#pragma unroll
    for (int i = 1; i <= 14; ++i) { tc = -tc * r2 / (double)((2 * i - 1) * (2 * i)); c += tc; ts = -ts * r2 / (double)((2 * i) * (2 * i + 1)); s += ts; }
}
__device__ __forceinline__ double dexp_small(double x) {
    double t = 1.0, s = 1.0;
#pragma unroll
    for (int i = 1; i <= 14; ++i) { t = t * x / (double)i; s += t; }
    return s;
}

__device__ __forceinline__ void conv_job(Frame& F, const Args& a, int job, int worker, int nworkers) {
    unsigned char* ws = a.ws;
    LAS float* scr = (LAS float*)(F.lds + 8192 + F.wave * 16384);
    constexpr int I_FI = (1024 / 64) * (5632 / 32), I_FO = (2816 / 64) * (1024 / 32), I_SQ = 16 * 32, I_GLU = 16 * 64, I_QKV = 16 * 96;
    const int q = job == 0 ? 0 : (job == 1 ? 1 : (job == 2 ? 2 : 3));
    const int nextra = job == 1 ? I_SQ + I_GLU : (job == 2 ? I_QKV + I_SQ : 0);
    const int nitems = I_FI + I_FO + nextra;
    for (int it = worker; it < nitems; it += nworkers) {
        int r = it;
        if (r < I_FI) { p0_transpose_item(a.in[7] + (size_t)q * 1024 * 5632, 1024, 5632, 2816, (f16*)(ws + WS_WFI + q * WFI_SZ), scr, r, F.lane); continue; } r -= I_FI;
        if (r < I_FO) { p0_transpose_item(a.in[8] + (size_t)q * 2816 * 1024, 2816, 1024, 0, (f16*)(ws + WS_WFO + q * WFO_SZ), scr, r, F.lane); continue; } r -= I_FO;
        if (job == 1) {
            if (r < I_SQ) { p0_transpose_item(a.in[9], 1024, 1024, 0, (f16*)(ws + WS_WSI), scr, r, F.lane); continue; } r -= I_SQ;
            p0_transpose_item(a.in[18], 1024, 2048, 1024, (f16*)(ws + WS_WGLU), scr, r, F.lane);
        } else {
            if (r < I_QKV) { p0_transpose_item(a.in[19], 1024, 3072, 0, (f16*)(ws + WS_WQKV), scr, r, F.lane); continue; } r -= I_QKV;
            p0_transpose_item(a.in[23], 1024, 1024, 0, (f16*)(ws + WS_WO), scr, r, F.lane);
        }
    }
}
__device__ __forceinline__ void bias_rows(Frame& F, const Args& a, int sl_lo, int sl_hi) {
    unsigned char* ws = a.ws;
    const float* MOD = (const float*)(ws + WS_MOD); float* BIAS = (float*)(ws + WS_BIAS);
    const int gw = F.vcu * 8 + F.wave, NGW = F.G * 8;
    for (int sl = sl_lo; sl <= sl_hi; ++sl) {
        const int nrows = sl == 1 ? 1024 : (sl == 4 ? 3072 : 5632);
        const f16* Wt = sl == 0 ? (const f16*)(ws + WS_WFI) : sl == 1 ? (const f16*)(ws + WS_WSI) : sl == 2 ? (const f16*)(ws + WS_WFI + 1 * WFI_SZ)
                      : sl == 3 ? (const f16*)(ws + WS_WFI + 2 * WFI_SZ) : sl == 4 ? (const f16*)(ws + WS_WQKV) : (const f16*)(ws + WS_WFI + 3 * WFI_SZ);
        const int l = sl / 3, sb = sl % 3;
        for (int n = gw; n < nrows; n += NGW) {
            const f16x8 w0 = *(const f16x8*)(Wt + (size_t)n * D + 16 * F.lane), w1 = *(const f16x8*)(Wt + (size_t)n * D + 16 * F.lane + 8);
            float d[3];
#pragma unroll
            for (int mi = 0; mi < 3; ++mi) { const float* sh = MOD + (l * 3 + mi) * 9216 + sb * 3072 + 16 * F.lane; float acc = 0.f;
#pragma unroll
                for (int q = 0; q < 4; ++q) { const f32x4 sv = *(const f32x4*)(sh + 4 * q);
#pragma unroll
                    for (int e = 0; e < 4; ++e) { const int k = 4 * q + e; acc += sv[e] * (float)(k < 8 ? w0[k & 7] : w1[k & 7]); } }
                d[mi] = wave_sum(acc); }
            if (F.lane == 0) { BIAS[(sl * 3 + 0) * 5632 + n] = d[0]; BIAS[(sl * 3 + 1) * 5632 + n] = d[1]; BIAS[(sl * 3 + 2) * 5632 + n] = d[2]; }
        }
    }
}
__device__ __forceinline__ void p0_phase(Frame& F, const Args& a) {
    unsigned char* ws = a.ws;
    float* MOD = (float*)(ws + WS_MOD);
    {
        const float* cin = a.in[1]; const float* cctx = a.in[3]; const float* ada_w = a.in[5]; const float* ada_b = a.in[6];
        LAS float* red = (LAS float*)F.lds;
        const int c4 = F.lane & 15, ko = F.lane >> 4;
        for (int u = blockIdx.x; u < 576; u += F.G) {
            const int kh = u & 1, cgl = u >> 1, l = cgl / 144, cg = cgl % 144;
            const float* Wl = ada_w + (size_t)l * 1024 * 9216 + cg * 64 + c4 * 4;
            const int kbase = kh * 512 + F.wave * 64 + ko;
            float acc[3][4];
#pragma unroll
            for (int m = 0; m < 3; ++m)
#pragma unroll
                for (int e = 0; e < 4; ++e) acc[m][e] = 0.f;
#pragma unroll 4
            for (int i = 0; i < 16; ++i) { const int k = kbase + 4 * i; const f32x4 w = *(const f32x4*)(Wl + (size_t)k * 9216);
                const float c0 = cin[k], c1 = cin[1024 + k], c2 = cctx[k];
                const float s0 = c0 * sigmoidf_(c0), s1 = c1 * sigmoidf_(c1), s2 = c2 * sigmoidf_(c2);
#pragma unroll
                for (int e = 0; e < 4; ++e) { acc[0][e] += s0 * w[e]; acc[1][e] += s1 * w[e]; acc[2][e] += s2 * w[e]; } }
#pragma unroll
            for (int m = 0; m < 3; ++m)
#pragma unroll
                for (int e = 0; e < 4; ++e) { float v = acc[m][e]; v += __shfl_xor(v, 16); v += __shfl_xor(v, 32); acc[m][e] = v; }
            if (F.lane < 16) {
#pragma unroll
                for (int m = 0; m < 3; ++m)
#pragma unroll
                    for (int e = 0; e < 4; ++e) red[(F.wave * 3 + m) * 64 + c4 * 4 + e] = acc[m][e];
            }
            __syncthreads();
            if (F.tid < 192) { const int m = F.tid >> 6, col = F.tid & 63; float s = 0.f;
#pragma unroll
                for (int w = 0; w < 8; ++w) s += red[(w * 3 + m) * 64 + col];
                if (kh == 0) s += ada_b[l * 9216 + cg * 64 + col];
                atomicAdd(MOD + (size_t)(l * 3 + m) * 9216 + cg * 64 + col, s); }
            __syncthreads();
        }
    }
    conv_job(F, a, 0, F.vcu * 8 + F.wave, F.G * 8);
    { float* SS = (float*)(ws + WS_SS); for (int i = blockIdx.x * 512 + F.tid; i < 5 * MALL; i += F.G * 512) SS[MALL + i] = 0.f; }
    {
        const float* lam_re = a.in[10]; const float* lam_im = a.in[11]; const float* lstep = a.in[12];
        const float* b_re = a.in[13]; const float* b_im = a.in[14]; const float* c_re = a.in[15]; const float* c_im = a.in[16];
        float* Lam = (float*)(ws + WS_LAM); float* LamT = (float*)(ws + WS_LAMT); f16* Bm = (f16*)(ws + WS_BMAT); f16* Cm = (f16*)(ws + WS_CMAT);
        for (int idx = blockIdx.x * 512 + F.tid; idx < 8192; idx += F.G * 512) {
            const int p = idx & 63, g = (idx >> 6) & 63, dir = idx >> 12;
            const double lr = fmin((double)lam_re[idx], -1e-4), li = (double)lam_im[idx];
            const double dt = (double)expf(lstep[dir * 64 + g]);
            const double mag = dexp_small(lr * dt);
            double th = li * dt; const double twopi = 6.283185307179586476925287;
            th -= twopi * rint(th / twopi);
            double sn, cs; dsincos(th, sn, cs);
            const double ar = mag * cs, ai = mag * sn;
            const double den = lr * lr + li * li;
            const double cr = ((ar - 1.0) * lr + ai * li) / den, ci = (ai * lr - (ar - 1.0) * li) / den;
            Lam[idx * 2] = (float)ar; Lam[idx * 2 + 1] = (float)ai;
            double pr = ar, pi = ai;
#pragma unroll
            for (int q = 0; q < 6; ++q) { const double nr = pr * pr - pi * pi, ni = 2.0 * pr * pi; pr = nr; pi = ni; }
            LamT[idx * 2] = (float)pr; LamT[idx * 2 + 1] = (float)pi;
            const float* br = b_re + (size_t)idx * 16; const float* bi = b_im + (size_t)idx * 16;
            f16* bo = Bm + ((size_t)(g * 2 + dir) * 128 + 2 * p) * 16;
#pragma unroll
            for (int h = 0; h < 16; ++h) { bo[h] = (f16)br[h]; bo[16 + h] = (f16)bi[h]; }
#pragma unroll
            for (int h = 0; h < 16; ++h) {
                const double Cr = (double)c_re[((size_t)(dir * 64 + g) * 16 + h) * 64 + p], Ci = (double)c_im[((size_t)(dir * 64 + g) * 16 + h) * 64 + p];
                const double er = Cr * cr - Ci * ci, ei = Cr * ci + Ci * cr;
                f16* co = Cm + ((size_t)(g * 2 + dir) * 16 + h) * 128 + 2 * p;
                co[0] = (f16)(float)(er * 1024.0); co[1] = (f16)(float)(-ei * 1024.0);
            }
        }
    }
}

__device__ __forceinline__ void p1_phase(Frame& F, const Args& a) {
    unsigned char* ws = a.ws;
    const float* MOD = (const float*)(ws + WS_MOD); const float* norm_g = a.in[4];
    float* X = (float*)(ws + WS_X); f16* H16 = (f16*)(ws + WS_H16); float* SS = (float*)(ws + WS_SS); float* GS = (float*)(ws + WS_GS); float* BIAS = (float*)(ws + WS_BIAS);
    const int gw = F.vcu * 8 + F.wave, NGW = F.G * 8;
    for (int row = gw; row < MALL; row += NGW) {
        const float* xr = row < MLAT ? a.in[0] + (size_t)row * D : a.in[2] + (size_t)(row - MLAT) * D;
        const int mi = row < SEQ ? 0 : (row < MLAT ? 1 : 2);
        const float* sc = MOD + mi * 9216 + 1024;
        f32x4 v[4]; float sq = 0.f;
#pragma unroll
        for (int j = 0; j < 4; ++j) { v[j] = *((const f32x4*)xr + F.lane + 64 * j); sq += (v[j].x * v[j].x + v[j].y * v[j].y) + (v[j].z * v[j].z + v[j].w * v[j].w); }
        sq = wave_sum(sq);
        if (F.lane == 0) SS[row] = sq;
#pragma unroll
        for (int j = 0; j < 4; ++j) { const int col = 4 * (F.lane + 64 * j);
            const f32x4 gg = *(const f32x4*)(norm_g + col), s1 = *(const f32x4*)(sc + col);
            const f32x4 h = v[j] * gg * (s1 + 1.0f);
            u32x2 w; w.x = pk2h(h.x, h.y); w.y = pk2h(h.z, h.w);
            *(u32x2*)(H16 + (size_t)row * D + col) = w;
            *(f32x4*)(X + (size_t)row * D + col) = v[j]; }
    }
    for (int i = blockIdx.x * 512 + F.tid; i < 6 * 3 * 1024; i += F.G * 512) { const int col = i & 1023, mi = (i >> 10) % 3, sl = i / 3072, l = sl / 3, sb = sl % 3;
        GS[i] = norm_g[sl * 1024 + col] * (1.0f + MOD[(l * 3 + mi) * 9216 + sb * 3072 + 1024 + col]); }
    bias_rows(F, a, 0, 0);
}

__device__ __forceinline__ void s5_unit_decode(int unit, int w, int& gq, int& c, int& b, int& g, int& rowbase) {
    gq = unit & 15; c = (unit >> 4) % NCH; b = unit / (16 * NCH); g = gq * 4 + (w >> 1);
    rowbase = c < 4 ? MLAT + b * CTX + 64 * c : b * SEQ + 64 * (c - 4);
}
template <bool P2>
__device__ __forceinline__ void s5_load_unit(int unit, int w, int dir, int l, const f16* U16, const f32x2* Cin, f16x4 (&af)[4], f32x2& st) {
    int gq, c, b, g, rowbase; s5_unit_decode(unit, w, gq, c, b, g, rowbase);
    const int fq = l >> 4, fr = l & 15;
#pragma unroll
    for (int s = 0; s < 4; ++s) af[s] = *(const f16x4*)(U16 + (size_t)(rowbase + 16 * (dir ? 3 - s : s) + fr) * D + 16 * g + 4 * fq);
    if (P2) st = Cin[((size_t)((dir * 2 + b) * NCH + c) * 64 + g) * 64 + l];
}
__device__ __forceinline__ float fma_s(float a, float b, float c) { float r; asm("v_fma_f32 %0, %1, %2, %3" : "=v"(r) : "v"(a), "v"(b), "v"(c)); return r; }
template <bool P2>
__device__ __forceinline__ void s5_pass(Frame& F, unsigned char* ws, const float* ssm_d) {
    int l_ = F.lane; asm volatile("" : "+v"(l_));
    const int w = F.wave, l = l_, fq = l >> 4, fr = l & 15;
    LAS float* W = (LAS float*)(F.lds + w * 8448);
    LAS f16* XS = (LAS f16*)(F.lds + 67584 + w * 4352);
    LAS float* YBall = (LAS float*)(F.lds + 67584 + 34816);
    LAS float* YB = YBall + w * 1024;
    const float* Lam = (const float*)(ws + WS_LAM); const f16* Bm = (const f16*)(ws + WS_BMAT); const f16* Cm = (const f16*)(ws + WS_CMAT);
    const f16* U16 = (const f16*)(ws + WS_U16); f16* G16 = (f16*)(ws + WS_G16);
    f32x2* Eb = (f32x2*)(ws + WS_E); const f32x2* Cin = (const f32x2*)(ws + WS_CIN);
    const int dir = w & 1;
    int wstep = dir ? -132 : 132, xstep = dir ? -136 : 136, w0 = dir ? 15 * 132 : 0, x0 = dir ? 15 * 136 : 0;
    asm volatile("" : "+s"(wstep), "+s"(xstep), "+s"(w0), "+s"(x0));
    const LAS float* Wl = W + w0 + 2 * l; LAS f16* XSl = XS + x0 + 2 * l;
    constexpr int NU = NB * NCH * 16;
    int gcur = -1; float ar = 0.f, ai = 0.f;
    f16x4 bf[8]; f16x8 cfr[4];
    f16x4 af[4], afn[4]; f32x2 st = (f32x2){0.f, 0.f}, stn = (f32x2){0.f, 0.f};
    int unit = blockIdx.x;
    if (unit < NU) s5_load_unit<P2>(unit, w, dir, l, U16, Cin, af, st);
    for (; unit < NU; unit += F.G) {
        int gq, c, b, g, rowbase; s5_unit_decode(unit, w, gq, c, b, g, rowbase);
        if (g != gcur) {
            gcur = g;
            ar = Lam[((dir * 64 + g) * 64 + l) * 2]; ai = Lam[((dir * 64 + g) * 64 + l) * 2 + 1];
#pragma unroll
            for (int j = 0; j < 8; ++j) bf[j] = *(const f16x4*)(Bm + ((size_t)(g * 2 + dir) * 128 + 16 * j + fr) * 16 + 4 * fq);
            if (P2) {
#pragma unroll
                for (int kk = 0; kk < 4; ++kk) cfr[kk] = *(const f16x8*)(Cm + ((size_t)(g * 2 + dir) * 16 + fr) * 128 + 32 * kk + 8 * fq);
            }
        }
        if (unit + F.G < NU) s5_load_unit<P2>(unit + F.G, w, dir, l, U16, Cin, afn, stn);
        const size_t sidx = ((size_t)((dir * 2 + b) * NCH + c) * 64 + g) * 64 + l;
        float xr = st.x, xi = st.y; const float nai = -ai;
        const int cgl = F.tid >> 7, ct = (F.tid >> 1) & 63, chb = F.tid & 1, cgg = gq * 4 + cgl;
        const size_t co = (size_t)(rowbase + ct) * D + 16 * cgg + 8 * chb;
        f16x8 uu; f32x4 dv0, dv1;
        if (P2) { uu = *(const f16x8*)(U16 + co); dv0 = *(const f32x4*)(ssm_d + 16 * cgg + 8 * chb); dv1 = *(const f32x4*)(ssm_d + 16 * cgg + 8 * chb + 4); }
#pragma unroll
        for (int s = 0; s < 4; ++s) {
            const int sc = dir ? 3 - s : s;
            const f16x4 a4 = af[s];
#pragma unroll
            for (int j = 0; j < 8; ++j) { const f32x4 dd = __builtin_amdgcn_mfma_f32_16x16x16f16(bf[j], a4, (f32x4){0.f, 0.f, 0.f, 0.f}, 0, 0, 0);
                *(LAS f32x4*)(W + fr * 132 + 16 * j + 4 * fq) = dd; }
            CFENCE();
#pragma unroll
            for (int k = 0; k < 16; ++k) {
                const f32x2 bu = *(const LAS f32x2*)(Wl + k * wstep);
                const float nr = fma_s(nai, xi, fma_s(ar, xr, bu.x)), ni = fma_s(ai, xr, fma_s(ar, xi, bu.y)); xr = nr; xi = ni;
                if (P2) { f16x2 hv; hv.x = (f16)xr; hv.y = (f16)xi; *(LAS f16x2*)(XSl + k * xstep) = hv; } }
            if (P2) {
                CFENCE();
                f32x4 Y = (f32x4){0.f, 0.f, 0.f, 0.f};
#pragma unroll
                for (int kk = 0; kk < 4; ++kk) { const f16x8 xa = *(const LAS f16x8*)(XS + fr * 136 + 32 * kk + 8 * fq); Y = __builtin_amdgcn_mfma_f32_16x16x32_f16(cfr[kk], xa, Y, 0, 0, 0); }
                *(LAS f32x4*)(YB + (16 * sc + fr) * 16 + 4 * fq) = Y;
            }
            CFENCE();
        }
        if (!P2) { Eb[sidx] = (f32x2){xr, xi}; }
        else {
            __syncthreads();
            const LAS float* y0 = YBall + (cgl * 2) * 1024 + ct * 16 + 8 * chb; const LAS float* y1 = y0 + 1024;
            const size_t o = co;
            float hv[8];
#pragma unroll
            for (int e = 0; e < 8; ++e) { const float dd = e < 4 ? dv0[e & 3] : dv1[e & 3];
                const float y = (y0[e] + y1[e]) * (1.0f / 1024.0f) + (float)uu[e] * dd;
                const float z = 1.5957691216057308f * (y + 0.044715f * y * y * y);
                hv[e] = y * sigmoidf_(z); }
            u32x4 wv; wv.x = pk2h(hv[0], hv[1]); wv.y = pk2h(hv[2], hv[3]); wv.z = pk2h(hv[4], hv[5]); wv.w = pk2h(hv[6], hv[7]);
            *(u32x4*)(G16 + o) = wv;
            __syncthreads();
        }
#pragma unroll
        for (int s = 0; s < 4; ++s) af[s] = afn[s];
        st = stn;
    }
}

__device__ __forceinline__ void s5_carry(Frame& F, unsigned char* ws) {
    const float* LamT = (const float*)(ws + WS_LAMT); const f32x2* Eb = (const f32x2*)(ws + WS_E); f32x2* Cin = (f32x2*)(ws + WS_CIN);
    for (int wv = F.wave * F.G + blockIdx.x; wv < 256; wv += F.G * 8) {
        const int idx = wv * 64 + F.lane;
        const int p = idx & 63, g = (idx >> 6) & 63, b = (idx >> 12) & 1, dir = idx >> 13;
        const float lr = LamT[((dir * 64 + g) * 64 + p) * 2], li = LamT[((dir * 64 + g) * 64 + p) * 2 + 1];
        float sr = 0.f, si = 0.f;
        for (int k0 = 0; k0 < NCH; k0 += 12) {
            f32x2 e[12]; size_t ad[12];
#pragma unroll
            for (int j = 0; j < 12; ++j) { const int k = k0 + j; const int c = dir ? (k < 4 ? 3 - k : 135 - k) : k;
                ad[j] = ((size_t)((dir * 2 + b) * NCH + c) * 64 + g) * 64 + p; e[j] = Eb[ad[j]]; }
#pragma unroll
            for (int j = 0; j < 12; ++j) { Cin[ad[j]] = (f32x2){sr, si};
                const float nr = lr * sr - li * si + e[j].x, ni = lr * si + li * sr + e[j].y; sr = nr; si = ni; }
        }
    }
}

__device__ __forceinline__ void qknorm_phase(Frame& F, unsigned char* ws, const float* qg, const float* kg) {
    f16* Q = (f16*)(ws + WS_Q16); f16* Kp = (f16*)(ws + WS_K16); const f16* V = (const f16*)(ws + WS_V16); f16* VT = (f16*)(ws + WS_VT); f16* VTC = (f16*)(ws + WS_VTC);
    LAS f16* T = (LAS f16*)(F.lds + F.wave * 9216);
    const int gw = F.vcu * 8 + F.wave, NGW = F.G * 8, l = F.lane;
    const int dchunk = (l & 7) * 8;
    float qgv[8], kgv[8];
#pragma unroll
    for (int e = 0; e < 8; ++e) { qgv[e] = qg[dchunk + e] * 0.125f; kgv[e] = kg[dchunk + e]; }
    for (int u = gw; u < 264 * 16; u += NGW) {
        const int h = u & 15, tb = u >> 4, R0 = tb * 64;
#pragma unroll
        for (int which = 0; which < 2; ++which) {
            if (which == 0 && tb >= 256) continue;
            f16* P = which ? Kp : Q;
#pragma unroll 2
            for (int it = 0; it < 8; ++it) { f16* p = P + (size_t)(R0 + it * 8 + (l >> 3)) * D + h * 64 + dchunk;
                const f16x8 v = *(const f16x8*)p; float f[8], ss = 0.f;
#pragma unroll
                for (int e = 0; e < 8; ++e) { f[e] = (float)v[e]; ss += f[e] * f[e]; }
                ss += __shfl_xor(ss, 1); ss += __shfl_xor(ss, 2); ss += __shfl_xor(ss, 4);
                const float rinv = __builtin_amdgcn_rsqf(ss * (1.0f / 64.0f) + EPS);
                u32x4 o;
                if (which) { o.x = pk2h(f[0] * rinv * kgv[0], f[1] * rinv * kgv[1]); o.y = pk2h(f[2] * rinv * kgv[2], f[3] * rinv * kgv[3]); o.z = pk2h(f[4] * rinv * kgv[4], f[5] * rinv * kgv[5]); o.w = pk2h(f[6] * rinv * kgv[6], f[7] * rinv * kgv[7]); }
                else { o.x = pk2h(f[0] * rinv * qgv[0], f[1] * rinv * qgv[1]); o.y = pk2h(f[2] * rinv * qgv[2], f[3] * rinv * qgv[3]); o.z = pk2h(f[4] * rinv * qgv[4], f[5] * rinv * qgv[5]); o.w = pk2h(f[6] * rinv * qgv[6], f[7] * rinv * qgv[7]); }
                *(u32x4*)p = o; }
        }
#pragma unroll 2
        for (int it = 0; it < 8; ++it) { const int tok = it * 8 + (l >> 3);
            *(LAS u32x4*)(T + tok * 72 + dchunk) = *(const u32x4*)(V + (size_t)(R0 + tok) * D + h * 64 + dchunk); }
        LDS_WAIT();
        f16* dst; int ldt;
        if (tb < 256) { const int b = tb >> 7, t0 = (tb & 127) * 64; dst = VT + ((size_t)(b * 16 + h) * 64) * SEQ + t0; ldt = SEQ; }
        else { const int b = (tb - 256) >> 2, t0 = ((tb - 256) & 3) * 64; dst = VTC + ((size_t)(b * 16 + h) * 64) * CTX + t0; ldt = CTX; }
#pragma unroll 2
        for (int it = 0; it < 8; ++it) { const int d = it * 8 + (l >> 3), tc = (l & 7) * 8; f16x8 o;
#pragma unroll
            for (int e = 0; e < 8; ++e) o[e] = T[(tc + e) * 72 + d];
            *(f16x8*)(dst + (size_t)d * ldt + tc) = o; }
        LDS_WAIT();
    }
}

constexpr int AT_KROW = 144, AT_KC = 82944, AT_VC = 119808, AT_TAB = 156672;
#define AT_BAR() do { asm volatile("s_waitcnt lgkmcnt(0)" ::: "memory"); __builtin_amdgcn_s_barrier(); asm volatile("" ::: "memory"); } while (0)
typedef short v4i16_t __attribute__((ext_vector_type(4)));
__device__ __forceinline__ f16x4 at_vtr(const LAS unsigned char* p) { return __builtin_bit_cast(f16x4, __builtin_amdgcn_ds_read_tr16_b64_v4i16((LAS v4i16_t*)p)); }
__device__ __forceinline__ void attn_decode(int up, int G, int& rp, int& bh, int& rs0) {
    if (G == 256) { const int i = up & 255, k = up >> 8; bh = i >> 3; rp = (i & 7) * 8 + k; } else { rp = up & 63; bh = up >> 6; }
    rs0 = min(max(2 * rp - 4, 0), 120);
}
constexpr int AT_NPF = 5;
template <int I0, int I1, int NT>
__device__ __forceinline__ void attn_load_band(const f16* Src, int bh, int rs0, int tid, u32x4 (&tk)[NT]) {
    const int b = bh >> 4, h = bh & 15;
#pragma unroll
    for (int it = I0; it < I1; ++it) { const int q = it * 512 + tid, row = q >> 3, c16 = q & 7;
        const int gr = min(rs0 + (row >> 6), 127);
        tk[it - I0] = *(const u32x4*)(Src + (size_t)(b * SEQ + gr * 64 + (row & 63)) * D + h * 64 + c16 * 8); }
}
__device__ __forceinline__ u32x4 at_knorm(u32x4 raw, const float (&kgv)[8]) {
    const f16x8 v = __builtin_bit_cast(f16x8, raw); float f[8], ss = 0.f;
#pragma unroll
    for (int e = 0; e < 8; ++e) { f[e] = (float)v[e]; ss += f[e] * f[e]; }
    ss += __builtin_bit_cast(float, __builtin_amdgcn_update_dpp(0, __builtin_bit_cast(int, ss), 0xB1, 0xf, 0xf, true));
    ss += __builtin_bit_cast(float, __builtin_amdgcn_update_dpp(0, __builtin_bit_cast(int, ss), 0x4E, 0xf, 0xf, true));
    ss += __builtin_bit_cast(float, __builtin_amdgcn_update_dpp(0, __builtin_bit_cast(int, ss), 0x141, 0xf, 0xf, true));
    const float rinv = __builtin_amdgcn_rsqf(ss * (1.0f / 64.0f) + EPS);
    u32x4 o; o.x = pk2h(f[0] * rinv * kgv[0], f[1] * rinv * kgv[1]); o.y = pk2h(f[2] * rinv * kgv[2], f[3] * rinv * kgv[3]);
    o.z = pk2h(f[4] * rinv * kgv[4], f[5] * rinv * kgv[5]); o.w = pk2h(f[6] * rinv * kgv[6], f[7] * rinv * kgv[7]); return o;
}
__device__ __forceinline__ void attn_phase(Frame& F, unsigned char* ws, const float* rpb, const float* qg, const float* kg) {
    f16* Q = (f16*)(ws + WS_Q16); const f16* Kp = (const f16*)(ws + WS_K16); const f16* Vp = (const f16*)(ws + WS_V16);
    const int w = F.wave;
    LAS unsigned char* SM = F.lds;
    constexpr int NUP = NB * 16 * 64;
    u32x4 tk[AT_NPF];
    int bh_cur = -1;
    { int rp, bh, rs0; if ((int)blockIdx.x < NUP) { attn_decode(blockIdx.x, F.G, rp, bh, rs0); attn_load_band<0, AT_NPF, AT_NPF>(Kp, bh, rs0, F.tid, tk); } }
    for (int up = blockIdx.x; up < NUP; up += F.G) {
        int l_ = F.lane; asm volatile("" : "+v"(l_));
        const int l = l_, fr = l & 15, fq = l >> 4, tid = w * 64 + l;
        int rp, bh, rs0; attn_decode(up, F.G, rp, bh, rs0);
        const int b = bh >> 4, h = bh & 15;
        const int r0 = 2 * rp;
        const int r = r0 + (w >> 2), qt = w & 3;
        const int rs = min(max(r - 4, 0), 120), i0 = rs - rs0;
        const int cw = qt == 0 ? 0 : (qt == 1 ? 8 : (qt == 2 ? 24 : 32));
        const int qc = 16 * qt + fr, cs = min(max(qc - 8, 0), 48);
        const size_t qrow = (size_t)(b * SEQ + r * 64 + qc) * D + h * 64;
        float kgv[8];
#pragma unroll
        for (int e = 0; e < 8; ++e) kgv[e] = kg[(tid & 7) * 8 + e];
        f16x8 q0, q1;
        { const f16x8 r0v = *(const f16x8*)(Q + qrow + 8 * fq), r1v = *(const f16x8*)(Q + qrow + 32 + 8 * fq); float f0[8], f1[8], ss = 0.f;
#pragma unroll
            for (int e = 0; e < 8; ++e) { f0[e] = (float)r0v[e]; f1[e] = (float)r1v[e]; ss += f0[e] * f0[e] + f1[e] * f1[e]; }
            ss += __shfl_xor(ss, 16); ss += __shfl_xor(ss, 32);
            const float rinv = __builtin_amdgcn_rsqf(ss * (1.0f / 64.0f) + EPS) * (0.125f * 1.4426950408889634f);
#pragma unroll
            for (int e = 0; e < 8; ++e) { q0[e] = (f16)(f0[e] * rinv * qg[8 * fq + e]); q1[e] = (f16)(f1[e] * rinv * qg[32 + 8 * fq + e]); } }
        { u32x4 tr[9 - AT_NPF]; attn_load_band<AT_NPF, 9, 9 - AT_NPF>(Kp, bh, rs0, tid, tr);
#pragma unroll
        for (int it = 0; it < 9; ++it) { const int q = it * 512 + tid, row = q >> 3, c16 = q & 7; *(LAS u32x4*)(SM + row * AT_KROW + c16 * 16) = at_knorm(it < AT_NPF ? tk[it < AT_NPF ? it : 0] : tr[it >= AT_NPF ? it - AT_NPF : 0], kgv); } }
        if (bh != bh_cur) {
            bh_cur = bh;
#pragma unroll
            for (int it = 0; it < 4; ++it) { const int q = it * 512 + tid, row = q >> 3, c16 = q & 7; const size_t go = (size_t)(MLAT + b * CTX + row) * D + h * 64 + c16 * 8;
                *(LAS u32x4*)(SM + AT_KC + row * AT_KROW + c16 * 16) = at_knorm(*(const u32x4*)(Kp + go), kgv);
                *(LAS u32x4*)(SM + AT_VC + row * AT_KROW + c16 * 16) = *(const u32x4*)(Vp + go); }
            if (tid < 465) ((LAS float*)(SM + AT_TAB))[tid] = rpb[h * 465 + tid] * 1.4426950408889634f;
        }
        const LAS float* rp_ = (const LAS float*)(SM + AT_TAB);
        AT_BAR();
        f32x4 S[32];
        float mx = -INFINITY;
#pragma unroll
        for (int i = 0; i < 8; ++i)
#pragma unroll
            for (int hf = 0; hf < 2; ++hf) {
                const LAS unsigned char* kr = SM + ((i0 + i) * 64 + cw + 16 * hf + fr) * AT_KROW + 16 * fq;
                const f16x8 k0 = *(const LAS f16x8*)kr, k1 = *(const LAS f16x8*)(kr + 64);
                f32x4 sv = __builtin_amdgcn_mfma_f32_16x16x32_f16(k0, q0, (f32x4){0.f, 0.f, 0.f, 0.f}, 0, 0, 0);
                sv = __builtin_amdgcn_mfma_f32_16x16x32_f16(k1, q1, sv, 0, 0, 0);
                const int ri = rs + i - r + 7;
#pragma unroll
                for (int e = 0; e < 4; ++e) { const int kc = cw + 16 * hf + 4 * fq + e; const bool valid = (kc >= cs) && (kc < cs + 16);
                    const int ci = min(max(kc - qc + 15, 0), 30);
                    const float bz = rp_[ri * 31 + ci];
                    const float z = (sv[e] + bz) + (valid ? 0.f : -INFINITY); sv[e] = z; mx = fmaxf(mx, z); }
                S[i * 2 + hf] = sv;
            }
#pragma unroll
        for (int j = 0; j < 16; ++j) {
            const LAS unsigned char* kr = SM + AT_KC + (16 * j + fr) * AT_KROW + 16 * fq;
            const f16x8 k0 = *(const LAS f16x8*)kr, k1 = *(const LAS f16x8*)(kr + 64);
            f32x4 sv = __builtin_amdgcn_mfma_f32_16x16x32_f16(k0, q0, (f32x4){0.f, 0.f, 0.f, 0.f}, 0, 0, 0);
            sv = __builtin_amdgcn_mfma_f32_16x16x32_f16(k1, q1, sv, 0, 0, 0);
#pragma unroll
            for (int e = 0; e < 4; ++e) mx = fmaxf(mx, sv[e]);
            S[16 + j] = sv;
        }
        mx = fmaxf(mx, __shfl_xor(mx, 16)); mx = fmaxf(mx, __shfl_xor(mx, 32));
        float sum = 0.f;
        f16x4 P[32];
#pragma unroll
        for (int t = 0; t < 32; ++t) {
#pragma unroll
            for (int e = 0; e < 4; ++e) { const float p = __builtin_amdgcn_exp2f(S[t][e] - mx); sum += p; P[t][e] = (f16)p; } }
        sum += __shfl_xor(sum, 16); sum += __shfl_xor(sum, 32);
        const float rsum = __builtin_amdgcn_rcpf(sum);
        __builtin_amdgcn_sched_barrier(0);
        u32x4 tv[9];
        attn_load_band<0, 9, 9>(Vp, bh, rs0, tid, tv);
        __builtin_amdgcn_sched_barrier(0);
        AT_BAR();
#pragma unroll
        for (int it = 0; it < 9; ++it) { const int q = it * 512 + tid, row = q >> 3, c16 = q & 7; *(LAS u32x4*)(SM + row * AT_KROW + c16 * 16) = tv[it]; }
        AT_BAR();
        if (up + F.G < NUP) { int rp2, bh2, rs2; attn_decode(up + F.G, F.G, rp2, bh2, rs2); attn_load_band<0, AT_NPF, AT_NPF>(Kp, bh2, rs2, tid, tk); }
        __builtin_amdgcn_sched_barrier(0);
        f32x4 O[4];
#pragma unroll
        for (int dt = 0; dt < 4; ++dt) O[dt] = (f32x4){0.f, 0.f, 0.f, 0.f};
        const int trq = fr >> 2, trp = fr & 3;
#pragma unroll
        for (int i = 0; i < 8; ++i) {
            f16x8 pf;
#pragma unroll
            for (int e = 0; e < 4; ++e) { pf[e] = P[2 * i][e]; pf[4 + e] = P[2 * i + 1][e]; }
            const LAS unsigned char* vb_ = SM + ((i0 + i) * 64 + cw + 4 * fq + trq) * AT_KROW + 8 * trp;
#pragma unroll
            for (int dt = 0; dt < 4; ++dt) { const f16x4 va = at_vtr(vb_ + 32 * dt), vb = at_vtr(vb_ + 16 * AT_KROW + 32 * dt); f16x8 vf;
#pragma unroll
                for (int e = 0; e < 4; ++e) { vf[e] = va[e]; vf[4 + e] = vb[e]; }
                O[dt] = __builtin_amdgcn_mfma_f32_16x16x32_f16(vf, pf, O[dt], 0, 0, 0); }
        }
#pragma unroll
        for (int jp = 0; jp < 8; ++jp) {
            f16x8 pf;
#pragma unroll
            for (int e = 0; e < 4; ++e) { pf[e] = P[16 + 2 * jp][e]; pf[4 + e] = P[17 + 2 * jp][e]; }
            const LAS unsigned char* vb_ = SM + AT_VC + (32 * jp + 4 * fq + trq) * AT_KROW + 8 * trp;
#pragma unroll
            for (int dt = 0; dt < 4; ++dt) { const f16x4 va = at_vtr(vb_ + 32 * dt), vb = at_vtr(vb_ + 16 * AT_KROW + 32 * dt); f16x8 vf;
#pragma unroll
                for (int e = 0; e < 4; ++e) { vf[e] = va[e]; vf[4 + e] = vb[e]; }
                O[dt] = __builtin_amdgcn_mfma_f32_16x16x32_f16(vf, pf, O[dt], 0, 0, 0); }
        }
#pragma unroll
        for (int dt = 0; dt < 4; ++dt) { u32x2 o; o.x = pk2h(O[dt][0] * rsum, O[dt][1] * rsum); o.y = pk2h(O[dt][2] * rsum, O[dt][3] * rsum);
            *(u32x2*)(Q + qrow + 16 * dt + 4 * fq) = o; }
        AT_BAR();
    }
}

template <int NT, int MODE, int CB = 0>
__device__ __forceinline__ void ctx_gemm(Frame& F, const f16* A, int lda, const f16* Bt, int K, const pg8::Epi& E) {
    constexpr int KC = 256, PITCH = KC * 2 + 16, NROWS = 32 + 16 * NT, NLD = NROWS / 16;
    LAS unsigned char* SM = F.lds;
    const int w = F.wave, rt = w >> 2, kq = w & 3;
    for (int tile = blockIdx.x; tile < 256; tile += F.G) {
        int l_ = F.lane; asm volatile("" : "+v"(l_));
        const int l = l_, fr = l & 15, fq = l >> 4, tid = w * 64 + l;
        const int cb = (tile & 7) * 2 + ((tile >> 3) & 1), rb = tile >> 4;
        const int row = MLAT + rb * 32 + 16 * rt + fr;
        const f16* src[NLD];
#pragma unroll
        for (int it = 0; it < NLD; ++it) { const int q = it * 512 + tid, srow = q >> 5, c16 = q & 31;
            if (srow < 32) src[it] = A + (size_t)(MLAT + rb * 32 + srow) * lda + c16 * 8;
            else { const int j = srow - 32; int brow;
                if (MODE == 3) { const int jj = cb * 64 + 16 * ((j >> 4) & 3) + (j & 15); brow = (jj >> 7) * 256 + (jj & 127) + ((j >> 4) >= 4 ? 128 : 0); }
                else brow = CB + cb * (16 * NT) + j;
                src[it] = Bt + (size_t)brow * K + c16 * 8; } }
        f32x4 fin[NT / 4];
#pragma unroll
        for (int i = 0; i < NT / 4; ++i) fin[i] = (f32x4){0.f, 0.f, 0.f, 0.f};
        u32x4 tr[NLD];
#pragma unroll
        for (int it = 0; it < NLD; ++it) tr[it] = *(const u32x4*)src[it];
        for (int kc = 0; kc < K; kc += KC) {
            __syncthreads();
#pragma unroll
            for (int it = 0; it < NLD; ++it) { const int q = it * 512 + tid; *(LAS u32x4*)(SM + (q >> 5) * PITCH + (q & 31) * 16) = tr[it]; }
            __syncthreads();
            if (kc + KC < K) {
#pragma unroll
                for (int it = 0; it < NLD; ++it) tr[it] = *(const u32x4*)(src[it] + kc + KC);
            }
#pragma unroll
            for (int ks = 0; ks < KC / 32; ++ks) { const f16x8 av = *(const LAS f16x8*)(SM + (16 * rt + fr) * PITCH + ks * 64 + 16 * fq);
#pragma unroll
                for (int i = 0; i < NT / 4; ++i) { const f16x8 bv = *(const LAS f16x8*)(SM + (32 + 16 * (kq + 4 * i) + fr) * PITCH + ks * 64 + 16 * fq);
                    fin[i] = __builtin_amdgcn_mfma_f32_16x16x32_f16(bv, av, fin[i], 0, 0, 0); } }
        }
        if (MODE == 0) {
            const float rinv = __builtin_amdgcn_rsqf(E.ss[row] * (1.0f / 1024.0f) + 1e-6f);
#pragma unroll
            for (int i = 0; i < NT / 4; ++i) { int col = CB + cb * (16 * NT) + 16 * (kq + 4 * i) + 4 * fq; f16* base = E.O16;
                const f32x4 v = fin[i] * rinv + *(const f32x4*)(E.bias + 2 * 5632 + col);
                if (E.split_cols) { const int t = col / E.split_cols; base += (size_t)t * E.split_stride; col -= t * E.split_cols; }
                u32x2 o; o.x = pk2h(v[0], v[1]); o.y = pk2h(v[2], v[3]);
                *(u32x2*)(base + (size_t)row * E.ldo + col) = o; }
        } else {
            const int col = cb * 64 + 16 * kq + 4 * fq; const size_t off = (size_t)row * D + col;
            const f32x4 xs = *(const f32x4*)(E.Xs + off); f32x4 xn;
            if (MODE == 2) { const f32x4 gv = *(const f32x4*)(E.gate + 2 * 9216 + col) * E.coef; xn = xs + gv * fin[0]; }
            else { const f32x4 gv = *(const f32x4*)(E.gate + 2 * 9216 + col);
#pragma unroll
                for (int e = 0; e < 4; ++e) xn[e] = xs[e] + gv[e] * fin[0][e] * sigmoidf_(fin[NT / 4 - 1][e]); }
            *(f32x4*)(E.Xd + off) = xn;
            if (E.An) { const f32x4 a0 = xn * *(const f32x4*)(E.gsn + 2 * 1024 + col);
                u32x2 o; o.x = pk2h(a0[0], a0[1]); o.y = pk2h(a0[2], a0[3]);
                *(u32x2*)(E.An + off) = o;
                float sq = (xn[0] * xn[0] + xn[1] * xn[1]) + (xn[2] * xn[2] + xn[3] * xn[3]);
                sq += __shfl_xor(sq, 16); sq += __shfl_xor(sq, 32); if (fq == 0) atomicAdd(E.ssn + row, sq); }
        }
        __syncthreads();
    }
}

#define XB_TMO      128
#define XB_XCNT(j)  (256  + 64 * (j))
#define XB_XSUB(j)  (1280 + 64 * (j))
#define XB_XGEN(j)  (2304 + 64 * (j))
#define XB_TOP      3328
#define XB_TOPGEN   3392
#define XCD_BAR_WORDS 3456
#define XB_SPIN_CAP (1u << 18)

__device__ __forceinline__ unsigned xb_ld(unsigned* p)              { return __hip_atomic_load(p, __ATOMIC_RELAXED, __HIP_MEMORY_SCOPE_AGENT); }
__device__ __forceinline__ unsigned xb_add(unsigned* p, unsigned v) { return __hip_atomic_fetch_add(p, v, __ATOMIC_RELAXED, __HIP_MEMORY_SCOPE_AGENT); }
__device__ __forceinline__ unsigned xb_xcc_id() { return (unsigned)__builtin_amdgcn_s_getreg((3 << 11) | 20) & 0xFu; }
#define XB_SPIN(cond, bar) do { unsigned _sp = 0; while (cond) { __builtin_amdgcn_s_sleep(1); \
    if ((++_sp & 255u) == 0u) { if (xb_ld(&(bar)[XB_TMO])) break; if (_sp > XB_SPIN_CAP) { atomicAdd(&(bar)[XB_TMO], 1u); break; } } } } while (0)

struct XcdBarrier {
    unsigned* bar; unsigned x;
    volatile LAS unsigned* st;
};

__device__ __forceinline__ XcdBarrier xcd_barrier_post(unsigned* bar, volatile LAS unsigned* st) {
    XcdBarrier b; b.bar = bar; b.x = xb_xcc_id(); b.st = st;
    if (threadIdx.x == 0) (void)xb_add(&bar[XB_XCNT(b.x)], 1u);
    return b;
}
__device__ __forceinline__ void xcd_barrier_complete(unsigned* bar, unsigned x, unsigned& nloc, unsigned& nx) {
    const unsigned G = gridDim.x * gridDim.y * gridDim.z;
    unsigned sum, cnt, mine, sp = 0u;
    for (;;) {
        sum = 0u; cnt = 0u; mine = 0u;
#pragma unroll
        for (unsigned j = 0; j < 16; ++j) { const unsigned c = xb_ld(&bar[XB_XCNT(j)]); sum += c; cnt += (c > 0u) ? 1u : 0u; mine = (j == x) ? c : mine; }
        if (sum == G) break;
        __builtin_amdgcn_s_sleep(1);
        if ((++sp & 255u) == 0u) { if (xb_ld(&bar[XB_TMO])) break; if (sp > XB_SPIN_CAP) { atomicAdd(&bar[XB_TMO], 1u); break; } }
    }
    nloc = mine > 0u ? mine : 1u; nx = cnt > 0u ? cnt : 1u;
}

__device__ __forceinline__ void xcd_barrier(const XcdBarrier& b) {
    asm volatile("s_waitcnt vmcnt(0)" ::: "memory");
    __syncthreads();
    if (threadIdx.x == 0) {
        unsigned* bar = b.bar;
        __builtin_amdgcn_s_waitcnt(0);
        unsigned nloc = b.st[0], nx = b.st[1];
        if (nloc == 0u) { xcd_barrier_complete(bar, b.x, nloc, nx); b.st[0] = nloc; b.st[1] = nx; }
        const unsigned old = xb_add(&bar[XB_XSUB(b.x)], 1u);
        const unsigned gen = old / nloc;
        if (old + 1u == (gen + 1u) * nloc) {
            __builtin_amdgcn_fence(__ATOMIC_RELEASE, "agent");
            asm volatile("s_waitcnt vmcnt(0)" ::: "memory");
            const unsigned og = xb_add(&bar[XB_TOP], 1u);
            const unsigned tg = og / nx;
            if (og + 1u == (tg + 1u) * nx) xb_add(&bar[XB_TOPGEN], 1u);
            else XB_SPIN(xb_ld(&bar[XB_TOPGEN]) == tg, bar);
            __builtin_amdgcn_fence(__ATOMIC_ACQUIRE, "agent");
            xb_add(&bar[XB_XGEN(b.x)], 1u);
            asm volatile("s_waitcnt vmcnt(0)" ::: "memory");
        } else {
            XB_SPIN(xb_ld(&bar[XB_XGEN(b.x)]) == gen, bar);
            __builtin_amdgcn_fence(__ATOMIC_ACQUIRE, "agent");
            asm volatile("s_waitcnt vmcnt(0)" ::: "memory");
        }
    }
    __syncthreads();
}

__global__ void __launch_bounds__(512, 2) fwd_megakernel(Args args) {
    extern __shared__ __attribute__((aligned(16))) unsigned char lds_raw[];
    Frame F;
    F.lds = (LAS unsigned char*)lds_raw;
    F.tid = threadIdx.x; F.lane = F.tid & 63; F.wave = __builtin_amdgcn_readfirstlane(F.tid >> 6);
    F.G = gridDim.x; { const int bx = blockIdx.x; F.vcu = (F.G % 8 == 0) ? (bx % 8) * (F.G / 8) + bx / 8 : bx; }
    unsigned char* ws = args.ws;
    float* MOD = (float*)(ws + WS_MOD); float* X = (float*)(ws + WS_X); f16* H16 = (f16*)(ws + WS_H16); f16* HID = (f16*)(ws + WS_HID);
    const float* norm_g = args.in[4];
    cg::grid_group grid = cg::this_grid();
    volatile LAS unsigned* bst = (volatile LAS unsigned*)(F.lds + LDS_BYTES - 16);
    if (F.tid < 4) bst[F.tid] = 0u;
    __syncthreads();
    XcdBarrier xbar = xcd_barrier_post((unsigned*)(ws + WS_BAR), bst);

    const int lo = args.ph_lo, hi = args.ph_hi;
    if (hi > (1 << 20)) grid.sync();
#define IN(k) (lo <= (k) && (k) < hi)
#define SEAM(k) do { if (IN(k) && IN((k) + 1)) xcd_barrier(xbar); asm volatile("" : "+v"(F.tid), "+v"(F.lane)); } while (0)
#define RUN_GEMM(Ap, Bp, Mr, Nc, Kc) do { pg8::Gemm g{(const u16*)(Ap), (const u16*)(Bp), (Mr), (Nc), (Kc)}; pg8::StaticOrder S; S.init(g.M, g.N, F.G, (int)blockIdx.x); pg8::gemm_phase(F.lds, g, S, E); } while (0)
#define CONV_TAIL(job) do { const int rem_ = (66 * 22) % F.G; \
        if (rem_ == 0) conv_job(F, args, (job), F.vcu * 8 + F.wave, F.G * 8); \
        else if ((int)blockIdx.x >= rem_) conv_job(F, args, (job), ((int)blockIdx.x - rem_) * 8 + F.wave, (F.G - rem_) * 8); } while (0)
#define SSP(sl) ((float*)(ws + WS_SS) + (size_t)(sl) * MALL)
#define GSP(sl) ((const float*)(ws + WS_GS) + (sl) * 3072)
#define BIASP(sl) ((const float*)(ws + WS_BIAS) + (sl) * 3 * 5632)
#define EPI_F16(dst, ld, sc, sst, sl) pg8::Epi E{(dst), (sst), nullptr, nullptr, nullptr, SSP(sl), BIASP(sl), nullptr, nullptr, nullptr, 0, (ld), (sc), 0.f}
#define EPI_SWIGLU(sl) pg8::Epi E{HID, 0, nullptr, nullptr, nullptr, SSP(sl), BIASP(sl), nullptr, nullptr, nullptr, 1, FH, 0, 0.f}
#define EPI_RES(md, dst, gt, cf, nsl) pg8::Epi E{nullptr, 0, X, (dst), (gt), nullptr, nullptr, (nsl) >= 0 ? H16 : nullptr, GSP((nsl) >= 0 ? (nsl) : 0), SSP((nsl) >= 0 ? (nsl) : 0), (md), 0, 0, (cf)}
    if (IN(0)) { p0_phase(F, args); } SEAM(0);
    if (IN(1)) { p1_phase(F, args); } SEAM(1);
    if (IN(2)) { EPI_SWIGLU(0); RUN_GEMM(H16, ws + WS_WFI + 0 * WFI_SZ, MALL, 5632, 1024); CONV_TAIL(1); } SEAM(2);
#if REP_FFNIN > 1
    if (IN(2)) { EPI_SWIGLU(0); RUN_GEMM(H16, ws + WS_WFI + 0 * WFI_SZ, MALL, 5632, 1024); } SEAM(2);
#endif
    if (IN(3)) { EPI_RES(2, X, MOD + 0 * 3072 + 2048, 0.5f, 1); RUN_GEMM(HID, ws + WS_WFO + 0 * WFO_SZ, MLAT, 1024, FH); ctx_gemm<4, 2>(F, HID, FH, (const f16*)(ws + WS_WFO + 0 * WFO_SZ), FH, E); bias_rows(F, args, 1, 2); } SEAM(3);
    if (IN(5)) { EPI_F16((f16*)(ws + WS_U16), D, 0, 0, 1); RUN_GEMM(H16, ws + WS_WSI, MLAT, 1024, 1024); ctx_gemm<4, 0>(F, H16, D, (const f16*)(ws + WS_WSI), 1024, E); } SEAM(5);
    if (IN(6)) { s5_pass<false>(F, ws, args.in[17]); } SEAM(6);
#if REP_S5 == 2
    if (IN(6)) { s5_pass<false>(F, ws, args.in[17]); } SEAM(6);
#endif
    if (IN(7)) { s5_carry(F, ws); } SEAM(7);
    if (IN(8)) { s5_pass<true>(F, ws, args.in[17]); } SEAM(8);
#if REP_S5 == 4
    if (IN(8)) { s5_pass<true>(F, ws, args.in[17]); } SEAM(8);
#endif
    if (IN(9)) { EPI_RES(3, X, MOD + 1 * 3072 + 2048, 1.f, 2); RUN_GEMM(ws + WS_G16, ws + WS_WGLU, MLAT, 2048, 1024); ctx_gemm<8, 3>(F, (const f16*)(ws + WS_G16), D, (const f16*)(ws + WS_WGLU), 1024, E); } SEAM(9);
    if (IN(11)) { EPI_SWIGLU(2); RUN_GEMM(H16, ws + WS_WFI + 1 * WFI_SZ, MALL, 5632, 1024); CONV_TAIL(2); } SEAM(11);
    if (IN(12)) { EPI_RES(2, X, MOD + 2 * 3072 + 2048, 0.5f, 3); RUN_GEMM(HID, ws + WS_WFO + 1 * WFO_SZ, MLAT, 1024, FH); ctx_gemm<4, 2>(F, HID, FH, (const f16*)(ws + WS_WFO + 1 * WFO_SZ), FH, E); bias_rows(F, args, 3, 4); } SEAM(12);
    if (IN(14)) { EPI_SWIGLU(3); RUN_GEMM(H16, ws + WS_WFI + 2 * WFI_SZ, MALL, 5632, 1024); CONV_TAIL(3); } SEAM(14);
    if (IN(15)) { EPI_RES(2, X, MOD + 3 * 9216 + 0 * 3072 + 2048, 0.5f, 4); RUN_GEMM(HID, ws + WS_WFO + 2 * WFO_SZ, MLAT, 1024, FH); ctx_gemm<4, 2>(F, HID, FH, (const f16*)(ws + WS_WFO + 2 * WFO_SZ), FH, E); bias_rows(F, args, 5, 5); } SEAM(15);
    if (IN(17)) { EPI_F16((f16*)(ws + WS_Q16), D, 1024, (size_t)MALL * D, 4); RUN_GEMM(H16, ws + WS_WQKV, MLAT, 3072, 1024); ctx_gemm<8, 0, 1024>(F, H16, D, (const f16*)(ws + WS_WQKV), 1024, E); } SEAM(17);
    if (IN(19)) { attn_phase(F, ws, args.in[22], args.in[20], args.in[21]); } SEAM(19);
#if REP_ATTN > 1
    if (IN(19)) { attn_phase(F, ws, args.in[22], args.in[20], args.in[21]); } SEAM(19);
#endif
    if (IN(20)) { EPI_RES(2, X, MOD + 3 * 9216 + 1 * 3072 + 2048, 1.f, 5); RUN_GEMM(ws + WS_Q16, ws + WS_WO, MLAT, 1024, 1024); } SEAM(20);
    if (IN(22)) { EPI_SWIGLU(5); RUN_GEMM(H16, ws + WS_WFI + 3 * WFI_SZ, MLAT, 5632, 1024); } SEAM(22);
    if (IN(23)) { EPI_RES(2, args.out, MOD + 3 * 9216 + 2 * 3072 + 2048, 0.5f, -1); RUN_GEMM(HID, ws + WS_WFO + 3 * WFO_SZ, MLAT, 1024, FH); }
}

extern "C" void kernel_launch(void* const* d_in, const int* in_sizes, int n_in, void* d_out, int out_size, void* d_ws, size_t ws_size, hipStream_t stream) {
    static int grid = 0;
    if (grid == 0) {
        if (n_in != 24 || ws_size < WS_END) { fprintf(stderr, "kernel_launch: unexpected n_in %d or ws_size %zu (< %zu)\n", n_in, ws_size, (size_t)WS_END); grid = -1; return; }
        int dev = 0, cus = 0, per_cu = 0;
        hipGetDevice(&dev); hipDeviceGetAttribute(&cus, hipDeviceAttributeMultiprocessorCount, dev);
        if (hipFuncSetAttribute((const void*)fwd_megakernel, hipFuncAttributeMaxDynamicSharedMemorySize, LDS_BYTES) != hipSuccess) { fprintf(stderr, "kernel_launch: hipFuncSetAttribute failed\n"); }
        if (hipOccupancyMaxActiveBlocksPerMultiprocessor(&per_cu, (const void*)fwd_megakernel, 512, LDS_BYTES) != hipSuccess || per_cu < 1) { fprintf(stderr, "kernel_launch: occupancy query says %d\n", per_cu); per_cu = 1; }
        (void)hipGetLastError();
        grid = cus * 1;
        if (grid <= 0) grid = 256;
    }
    if (grid < 0) return;
    hipMemsetAsync((char*)d_ws + WS_MOD, 0, MOD_BYTES, stream);
    Args a{};
    for (int i = 0; i < 24; ++i) a.in[i] = (const float*)d_in[i];
    a.out = (float*)d_out; a.ws = (unsigned char*)d_ws;
#if MK_COOP
    a.ph_lo = 0; a.ph_hi = NPHASE;
    void* kargs[] = {&a};
    hipError_t e = hipLaunchCooperativeKernel((const void*)fwd_megakernel, dim3(grid), dim3(512), kargs, LDS_BYTES, stream);
    if (e != hipSuccess) fprintf(stderr, "cooperative launch failed: %s (grid %d)\n", hipGetErrorString(e), grid);
#else
    for (int ph = 0; ph < NPHASE; ++ph) {
        a.ph_lo = ph; a.ph_hi = ph + 1;
        hipLaunchKernelGGL(fwd_megakernel, dim3(grid), dim3(512), LDS_BYTES, stream, a);
    }
#endif
}
```

```cpp
#include <hip/hip_runtime.h>
#include <hip/hip_cooperative_groups.h>
#include <cstdio>
#include <cstdint>
namespace cg = cooperative_groups;

#ifndef REP_S5
#define REP_S5 1
#endif
#ifndef REP_ATTN
#define REP_ATTN 1
#endif
#ifndef REP_FFNIN
#define REP_FFNIN 1
#endif
#ifndef REP_NORM
#define REP_NORM 1
#endif
#ifndef REP_CONV
#define REP_CONV 1
#endif
#ifndef MK_COOP
#define MK_COOP 1
#endif

#define LAS __attribute__((address_space(3)))
typedef _Float16 f16;
typedef f16 f16x8 __attribute__((ext_vector_type(8)));
typedef f16 f16x4 __attribute__((ext_vector_type(4)));
typedef f16 f16x2 __attribute__((ext_vector_type(2)));
typedef float f32x4 __attribute__((ext_vector_type(4)));
typedef float f32x2 __attribute__((ext_vector_type(2)));
typedef unsigned u32x4 __attribute__((ext_vector_type(4)));
typedef unsigned u32x2 __attribute__((ext_vector_type(2)));
typedef unsigned short u16;

constexpr int D = 1024, SEQ = 8192, NB = 2, CTX = 256, FH = 2816;
constexpr int MLAT = NB * SEQ;
constexpr int MALL = MLAT + NB * CTX;
constexpr int NCH = 132;
constexpr float EPS = 1e-6f;

constexpr size_t MiB = 1u << 20;
constexpr size_t WS_MOD = 0;
constexpr size_t MOD_BYTES = 262144;
constexpr size_t WS_BAR = 229376;
constexpr size_t WS_LAM = 262144;
constexpr size_t WS_LAMT = WS_LAM + 65536;
constexpr size_t WS_BMAT = WS_LAMT + 65536;
constexpr size_t WS_CMAT = WS_BMAT + 524288;
constexpr size_t WS_WFI = 2 * MiB;
constexpr size_t WFI_SZ = (size_t)5632 * 1024 * 2;
constexpr size_t WS_WFO = WS_WFI + 4 * WFI_SZ;
constexpr size_t WFO_SZ = (size_t)1024 * 2816 * 2;
constexpr size_t WS_WSI = WS_WFO + 4 * WFO_SZ;
constexpr size_t WS_WGLU = WS_WSI + 2 * MiB;
constexpr size_t WS_WQKV = WS_WGLU + 4 * MiB;
constexpr size_t WS_WO = WS_WQKV + 6 * MiB;
constexpr size_t WS_X = 82 * MiB;
constexpr size_t WS_H16 = 148 * MiB;
constexpr size_t WS_R = 181 * MiB;
constexpr size_t WS_HID = WS_R;
constexpr size_t WS_U16 = WS_R;
constexpr size_t WS_G16 = WS_R + 33 * MiB;
constexpr size_t WS_E = WS_R + 66 * MiB;
constexpr size_t WS_CIN = WS_R + 83 * MiB;
constexpr size_t WS_Q16 = WS_R;
constexpr size_t WS_K16 = WS_R + 33 * MiB;
constexpr size_t WS_V16 = WS_R + 66 * MiB;
constexpr size_t WS_VT = WS_R + 99 * MiB;
constexpr size_t WS_VTC = WS_R + 131 * MiB;
constexpr size_t WS_SS = WS_CMAT + 524288;
constexpr size_t WS_GS = WS_SS + (size_t)6 * 16896 * 4;
constexpr size_t WS_BIAS = 313 * MiB;
constexpr size_t WS_END = 314 * MiB;
static_assert(WS_GS + 6 * 3 * 1024 * 4 <= 2 * MiB, "small tables below the weights");
static_assert(WS_WO + 2 * MiB == WS_X, "weights end at X");

constexpr int LDS_BYTES = 163840;
constexpr int NPHASE = 24;

namespace pg8 {
constexpr int BM = 256, BK = 64, HALF = 128, HTB = HALF * BK * 2, STAGE_BYTES = 8 * HTB, NXCD = 8, WGM = 8;
__host__ __device__ __forceinline__ int lds_byte(int r, int c) { const int st = (r >> 4) * 2 + (c >> 5), rr = r & 15, cc = c & 31, ob = rr * 64 + cc * 2; return st * 1024 + (ob ^ (((ob >> 9) & 1) << 5)); }
__host__ __device__ __forceinline__ void stage_rc(int b, int& R, int& C) { const int st = b / 1024, sb = b % 1024, swz = sb ^ (((sb >> 9) & 1) << 5); R = (st >> 1) * 16 + swz / 64; C = (st & 1) * 32 + (swz % 64) / 2; }
__host__ __device__ __forceinline__ int perm32(int rho) { const int n = rho >> 4, i = rho & 15; return 8 * (i >> 2) + 4 * n + (i & 3); }

struct Unit { int pm, pn; };
struct Gemm { const u16* A; const u16* Bt; int M, N, K; };

struct StaticOrder {
    int nM, nN, nwg, G, c;
    __device__ void init(int M, int N, int G_, int c_) { nM = M / BM; nN = N / BM; nwg = nM * nN; G = G_; c = c_; }
    __device__ bool next(int i, Unit& u) const {
        const long L = (long)i * G + c; if (L >= nwg) return false;
        int wgid = (int)L; { const int q = nwg / NXCD, r = nwg % NXCD, xcd = wgid % NXCD, off = wgid / NXCD; wgid = (xcd < r ? xcd * (q + 1) : r * (q + 1) + (xcd - r) * q) + off; }
        const int nig = WGM * nN, gid = wgid / nig, fm = gid * WGM, gsz = (nM - fm) < WGM ? (nM - fm) : WGM;
        u.pm = fm + ((wgid % nig) % gsz); u.pn = (wgid % nig) / gsz; return true;
    }
};

__device__ __forceinline__ unsigned pk2h(float a, float b) { f16x2 v; v.x = (f16)a; v.y = (f16)b; return __builtin_bit_cast(unsigned, v); }
__device__ __forceinline__ float sigmoidf_(float x) { return __builtin_amdgcn_rcpf(1.0f + __expf(-x)); }

struct Epi {
    static constexpr bool PERM = true;
    f16* O16; size_t split_stride;
    const float* Xs; float* Xd; const float* gate;
    const float* ss; const float* bias;
    f16* An; const float* gsn; float* ssn;
    int mode;
    int ldo; int split_cols; float coef;
    __device__ __forceinline__ void operator()(const f32x4 (&acc)[2][2][4][2], const Unit& u, int wr, int wc, int fr, int fq) const {
        const int row0 = u.pm * BM + wr * 64 + fr;
        const int rowt = u.pm * BM; const int mi = rowt < SEQ ? 0 : (rowt < MLAT ? 1 : 2);
        if (mode == 0) {
            int colt = u.pn * BM; f16* base = O16;
            const float* bp = bias + mi * 5632 + colt + wc * 32 + 8 * fq;
            if (split_cols) { const int t = colt / split_cols; base += (size_t)t * split_stride; colt -= t * split_cols; }
            const int col0 = colt + wc * 32 + 8 * fq;
            f32x4 bv[2][2];
#pragma unroll
            for (int bj = 0; bj < 2; ++bj)
#pragma unroll
                for (int n = 0; n < 2; ++n) bv[bj][n] = *(const f32x4*)(bp + bj * HALF + 4 * n);
#pragma unroll
            for (int ai = 0; ai < 2; ++ai)
#pragma unroll
                for (int m = 0; m < 4; ++m) { const int row = row0 + ai * HALF + m * 16; f16* rowp = base + (size_t)row * ldo + col0;
                    const float rinv = __builtin_amdgcn_rsqf(ss[row] * (1.0f / 1024.0f) + 1e-6f);
#pragma unroll
                    for (int bj = 0; bj < 2; ++bj) { const f32x4 v0 = acc[ai][bj][m][0] * rinv + bv[bj][0], v1 = acc[ai][bj][m][1] * rinv + bv[bj][1];
                        u32x4 w; w.x = pk2h(v0[0], v0[1]); w.y = pk2h(v0[2], v0[3]); w.z = pk2h(v1[0], v1[1]); w.w = pk2h(v1[2], v1[3]);
                        *(u32x4*)(rowp + bj * HALF) = w; } }
        } else if (mode == 1) {
            const int col0 = u.pn * HALF + wc * 32 + 8 * fq;
            const float* bp = bias + mi * 5632 + u.pn * BM + wc * 32 + 8 * fq;
            f32x4 bv[2][2];
#pragma unroll
            for (int bj = 0; bj < 2; ++bj)
#pragma unroll
                for (int n = 0; n < 2; ++n) bv[bj][n] = *(const f32x4*)(bp + bj * HALF + 4 * n);
#pragma unroll
            for (int ai = 0; ai < 2; ++ai)
#pragma unroll
                for (int m = 0; m < 4; ++m) { const int row = row0 + ai * HALF + m * 16; f16* rowp = O16 + (size_t)row * ldo + col0;
                    const float rinv = __builtin_amdgcn_rsqf(ss[row] * (1.0f / 1024.0f) + 1e-6f);
                    float h[8];
#pragma unroll
                    for (int n = 0; n < 2; ++n)
#pragma unroll
                        for (int e = 0; e < 4; ++e) { const float g = acc[ai][0][m][n][e] * rinv + bv[0][n][e], up = acc[ai][1][m][n][e] * rinv + bv[1][n][e]; h[n * 4 + e] = g * sigmoidf_(g) * up; }
                    u32x4 w; w.x = pk2h(h[0], h[1]); w.y = pk2h(h[2], h[3]); w.z = pk2h(h[4], h[5]); w.w = pk2h(h[6], h[7]);
                    *(u32x4*)rowp = w; }
        } else {
            const float* gp = gate + mi * 9216;
            if (mode == 2) {
                const int col0 = u.pn * BM + wc * 32 + 8 * fq;
                f32x4 gv[2][2], gs[2][2];
#pragma unroll
                for (int bj = 0; bj < 2; ++bj)
#pragma unroll
                    for (int n = 0; n < 2; ++n) { gv[bj][n] = *(const f32x4*)(gp + col0 + bj * HALF + 4 * n) * coef;
                        gs[bj][n] = *(const f32x4*)(gsn + mi * 1024 + col0 + bj * HALF + 4 * n); }
#pragma unroll
                for (int ai = 0; ai < 2; ++ai)
#pragma unroll
                    for (int m = 0; m < 4; ++m) { const int row = row0 + ai * HALF + m * 16; const size_t off = (size_t)row * D + col0; float sq = 0.f;
#pragma unroll
                        for (int bj = 0; bj < 2; ++bj) { f32x4 xn[2];
#pragma unroll
                            for (int n = 0; n < 2; ++n) { const f32x4 xs = *(const f32x4*)(Xs + off + bj * HALF + 4 * n);
                                xn[n] = xs + gv[bj][n] * acc[ai][bj][m][n];
                                *(f32x4*)(Xd + off + bj * HALF + 4 * n) = xn[n];
                                sq += (xn[n][0] * xn[n][0] + xn[n][1] * xn[n][1]) + (xn[n][2] * xn[n][2] + xn[n][3] * xn[n][3]); }
                            if (An) { const f32x4 a0 = xn[0] * gs[bj][0], a1 = xn[1] * gs[bj][1];
                                u32x4 w; w.x = pk2h(a0[0], a0[1]); w.y = pk2h(a0[2], a0[3]); w.z = pk2h(a1[0], a1[1]); w.w = pk2h(a1[2], a1[3]);
                                *(u32x4*)(An + off + bj * HALF) = w; } }
                        if (An) { sq += __shfl_xor(sq, 16); sq += __shfl_xor(sq, 32); if (fq == 0) atomicAdd(ssn + row, sq); } }
            } else {
                const int col0 = u.pn * HALF + wc * 32 + 8 * fq;
                f32x4 gv[2], gs[2];
#pragma unroll
                for (int n = 0; n < 2; ++n) { gv[n] = *(const f32x4*)(gp + col0 + 4 * n); gs[n] = *(const f32x4*)(gsn + mi * 1024 + col0 + 4 * n); }
#pragma unroll
                for (int ai = 0; ai < 2; ++ai)
#pragma unroll
                    for (int m = 0; m < 4; ++m) { const int row = row0 + ai * HALF + m * 16; const size_t off = (size_t)row * D + col0; float sq = 0.f; f32x4 xn[2];
#pragma unroll
                        for (int n = 0; n < 2; ++n) { const f32x4 xs = *(const f32x4*)(Xs + off + 4 * n); const f32x4 a = acc[ai][0][m][n], b = acc[ai][1][m][n];
#pragma unroll
                            for (int e = 0; e < 4; ++e) xn[n][e] = xs[e] + gv[n][e] * a[e] * sigmoidf_(b[e]);
                            *(f32x4*)(Xd + off + 4 * n) = xn[n];
                            sq += (xn[n][0] * xn[n][0] + xn[n][1] * xn[n][1]) + (xn[n][2] * xn[n][2] + xn[n][3] * xn[n][3]); }
                        const f32x4 a0 = xn[0] * gs[0], a1 = xn[1] * gs[1];
                        u32x4 w; w.x = pk2h(a0[0], a0[1]); w.y = pk2h(a0[2], a0[3]); w.z = pk2h(a1[0], a1[1]); w.w = pk2h(a1[2], a1[3]);
                        *(u32x4*)(An + off) = w;
                        sq += __shfl_xor(sq, 16); sq += __shfl_xor(sq, 32); if (fq == 0) atomicAdd(ssn + row, sq); }
            }
        }
    }
};

__device__ __forceinline__ void gemm_phase(LAS unsigned char* lds, const Gemm g, const StaticOrder& S, const Epi& E) {
    int tid_ = threadIdx.x; asm volatile("" : "+v"(tid_));
    const int tid = tid_, wid = __builtin_amdgcn_readfirstlane(tid >> 6), lane = tid & 63, wr = wid >> 2, wc = wid & 3, fr = lane & 15, fq = lane >> 4;
    const int K = g.K, nt = K / BK;
    unsigned voffA[2], voffB[2];
#pragma unroll
    for (int i = 0; i < 2; ++i) { int R, C; stage_rc(tid * 16 + i * 8192, R, C); const int Rb = Epi::PERM ? ((R & ~31) + perm32(R & 31)) : R;
        voffA[i] = (unsigned)(R * K + C) * 2u; voffB[i] = (unsigned)(Rb * K + C) * 2u; }
    const size_t kstep = (size_t)(BK * 2);
    const size_t hstep = (size_t)HALF * K * 2;
    const size_t tstep = 2 * hstep;
    const unsigned ldsw = (unsigned)wid * 1024u;
    const int aoff = lds_byte(wr * 64 + fr, fq * 8), boff = lds_byte(wc * 32 + fr, fq * 8);
#define PG8_SA(b, h) (((b) * 2 + (h)) * HTB)
#define PG8_SB(b, h) ((4 + (b) * 2 + (h)) * HTB)
#define PG8_STAGE(bufoff, gbase, voff) do { _Pragma("unroll") for (int _i = 0; _i < 2; ++_i) \
        __builtin_amdgcn_global_load_lds((const unsigned*)((const char*)(gbase) + (voff)[_i]), (LAS unsigned*)(lds + (bufoff) + ldsw + _i * 8192), 16, 0, 0); } while (0)
#define PG8_LDA(dst, b, h) do { _Pragma("unroll") for (int m = 0; m < 4; ++m) _Pragma("unroll") for (int k = 0; k < 2; ++k) dst[m][k] = *(const LAS f16x8*)(lds + PG8_SA(b, h) + aoff + m * 2048 + k * 1024); } while (0)
#define PG8_LDB(dst, b, h) do { _Pragma("unroll") for (int n = 0; n < 2; ++n) _Pragma("unroll") for (int k = 0; k < 2; ++k) dst[n][k] = *(const LAS f16x8*)(lds + PG8_SB(b, h) + boff + n * 2048 + k * 1024); } while (0)
#define PG8_MMA(ai, bj, At, Bt) do { __builtin_amdgcn_s_setprio(1); _Pragma("unroll") for (int m = 0; m < 4; ++m) _Pragma("unroll") for (int n = 0; n < 2; ++n) _Pragma("unroll") for (int k = 0; k < 2; ++k) \
        acc[ai][bj][m][n] = __builtin_amdgcn_mfma_f32_16x16x32_f16(Bt[n][k], At[m][k], acc[ai][bj][m][n], 0, 0, 0); __builtin_amdgcn_s_setprio(0); } while (0)
#define PG8_WAIT_V(n) asm volatile("s_waitcnt vmcnt(" #n ")" ::: "memory")
#define PG8_WAIT_L(n) asm volatile("s_waitcnt lgkmcnt(" #n ")" ::: "memory")
#define PG8_BAR __builtin_amdgcn_s_barrier()
#define PG8_SCHED __builtin_amdgcn_sched_barrier(0)
    Unit cur, nxt; int ui = 0;
    if (!S.next(0, cur)) return;
    f32x4 acc[2][2][4][2];
#pragma unroll
    for (int a = 0; a < 2; ++a)
#pragma unroll
        for (int b = 0; b < 2; ++b)
#pragma unroll
            for (int m = 0; m < 4; ++m)
#pragma unroll
                for (int n = 0; n < 2; ++n) acc[a][b][m][n] = (f32x4){0.f, 0.f, 0.f, 0.f};
    f16x8 At[4][2], B0[2][2], B1[2][2];
    const char* cA = (const char*)g.A + (size_t)cur.pm * tstep; const char* cB = (const char*)g.Bt + (size_t)cur.pn * tstep;
    PG8_STAGE(PG8_SB(0, 0), cB, voffB); PG8_STAGE(PG8_SB(0, 1), cB + hstep, voffB); PG8_STAGE(PG8_SA(0, 0), cA, voffA); PG8_STAGE(PG8_SA(0, 1), cA + hstep, voffA);
    if (wr == 1) PG8_BAR;
    PG8_WAIT_V(2); PG8_BAR;
    PG8_STAGE(PG8_SB(1, 0), cB + kstep, voffB); PG8_STAGE(PG8_SA(1, 0), cA + kstep, voffA); PG8_STAGE(PG8_SB(1, 1), cB + hstep + kstep, voffB);
    PG8_WAIT_V(6); PG8_BAR;
    for (;;) {
        const bool has_next = S.next(ui + 1, nxt);
        const char* nA = has_next ? (const char*)g.A + (size_t)nxt.pm * tstep : cA; const char* nB = has_next ? (const char*)g.Bt + (size_t)nxt.pn * tstep : cB;
        for (int t = 0; t < nt; t += 2) {
            const bool last = (t == nt - 2);
            const char* a1 = cA + (size_t)(t + 1) * kstep;
            const char* a2 = last ? nA : cA + (size_t)(t + 2) * kstep; const char* b2 = last ? nB : cB + (size_t)(t + 2) * kstep;
            const char* a3 = a2 + kstep; const char* b3 = b2 + kstep;
            PG8_LDB(B0, 0, 0); PG8_LDB(B1, 0, 1); PG8_SCHED; PG8_LDA(At, 0, 0); PG8_STAGE(PG8_SA(1, 1), a1 + hstep, voffA);
            PG8_WAIT_V(8); PG8_WAIT_L(0); PG8_BAR; PG8_MMA(0, 0, At, B0); PG8_MMA(0, 1, At, B1); PG8_BAR; PG8_SCHED;
            PG8_LDA(At, 0, 1); PG8_STAGE(PG8_SB(0, 0), b2, voffB); PG8_STAGE(PG8_SB(0, 1), b2 + hstep, voffB); PG8_STAGE(PG8_SA(0, 0), a2, voffA);
            PG8_WAIT_V(8); PG8_WAIT_L(0); PG8_BAR; PG8_MMA(1, 0, At, B0); PG8_MMA(1, 1, At, B1); PG8_BAR; PG8_SCHED;
            PG8_LDB(B0, 1, 0); PG8_LDB(B1, 1, 1); PG8_SCHED; PG8_LDA(At, 1, 0); PG8_STAGE(PG8_SA(0, 1), a2 + hstep, voffA);
            PG8_WAIT_V(8); PG8_WAIT_L(0); PG8_BAR; PG8_MMA(0, 0, At, B0); PG8_MMA(0, 1, At, B1); PG8_BAR; PG8_SCHED;
            PG8_LDA(At, 1, 1); PG8_STAGE(PG8_SB(1, 0), b3, voffB); PG8_STAGE(PG8_SB(1, 1), b3 + hstep, voffB); PG8_STAGE(PG8_SA(1, 0), a3, voffA);
            PG8_WAIT_V(8); PG8_WAIT_L(0); PG8_BAR; PG8_MMA(1, 0, At, B0); PG8_MMA(1, 1, At, B1); PG8_BAR; PG8_SCHED;
        }
        if (wr == 0) PG8_BAR;
        E(acc, cur, wr, wc, fr, fq);
        if (!has_next) break;
#pragma unroll
        for (int a = 0; a < 2; ++a)
#pragma unroll
            for (int b = 0; b < 2; ++b)
#pragma unroll
                for (int m = 0; m < 4; ++m)
#pragma unroll
                    for (int n = 0; n < 2; ++n) acc[a][b][m][n] = (f32x4){0.f, 0.f, 0.f, 0.f};
        cur = nxt; cA = nA; cB = nB; ++ui;
        if (wr == 1) PG8_BAR;
    }
    PG8_WAIT_V(0);
    PG8_BAR;
#undef PG8_SA
#undef PG8_SB
#undef PG8_STAGE
#undef PG8_LDA
#undef PG8_LDB
#undef PG8_MMA
#undef PG8_WAIT_V
#undef PG8_WAIT_L
#undef PG8_BAR
#undef PG8_SCHED
}
}
using pg8::pk2h;
using pg8::sigmoidf_;

#define LDS_WAIT() asm volatile("s_waitcnt lgkmcnt(0)" ::: "memory")
#define CFENCE() asm volatile("" ::: "memory")

struct Args {
    const float* in[24]; float* out; unsigned char* ws; int ph_lo, ph_hi;
};

struct Frame {
    LAS unsigned char* lds; int tid, lane, wave, vcu, G;
};

__device__ __forceinline__ float wave_sum(float v) {
#pragma unroll
    for (int o = 1; o < 64; o <<= 1) v += __shfl_xor(v, o);
    return v;
}

__device__ __forceinline__ void p0_transpose_item(const float* W, int K, int N, int half_n, f16* WT, LAS float* scr, int item, int lane) {
    const int nblk = N / 32, kb = item / nblk, nb = item % nblk, k0 = 64 * kb, n0 = 32 * nb;
    int d0 = n0;
    if (half_n) { const int j = n0 < half_n ? n0 : n0 - half_n; d0 = (j >> 7) * 256 + (n0 < half_n ? 0 : 128) + (j & 127); }
#pragma unroll 8
    for (int i = 0; i < 32; ++i) { const int kk = 2 * i + (lane >> 5); scr[kk * 33 + (lane & 31)] = W[(size_t)(k0 + kk) * N + n0 + (lane & 31)]; }
    LDS_WAIT();
    const int c = lane & 7;
#pragma unroll
    for (int j = 0; j < 4; ++j) { const int n = (lane >> 3) + 8 * j; const LAS float* s = scr + (8 * c) * 33 + n;
        u32x4 o; o.x = pk2h(s[0 * 33], s[1 * 33]); o.y = pk2h(s[2 * 33], s[3 * 33]); o.z = pk2h(s[4 * 33], s[5 * 33]); o.w = pk2h(s[6 * 33], s[7 * 33]);
        *(u32x4*)(WT + (size_t)(d0 + n) * K + k0 + 8 * c) = o; }
    LDS_WAIT();
}

__device__ __forceinline__ void dsincos(double r, double& s, double& c) {
    const double r2 = r * r; double ts = r, tc = 1.0; s = r; c = 1.0;
#pragma unroll
    for (int i = 1; i <= 14; ++i) { tc = -tc * r2 / (double)((2 * i - 1) * (2 * i)); c += tc; ts = -ts * r2 / (double)((2 * i) * (2 * i + 1)); s += ts; }
}
__device__ __forceinline__ double dexp_small(double x) {
    double t = 1.0, s = 1.0;
#pragma unroll
    for (int i = 1; i <= 14; ++i) { t = t * x / (double)i; s += t; }
    return s;
}

__device__ __forceinline__ void conv_job(Frame& F, const Args& a, int job, int worker, int nworkers) {
    unsigned char* ws = a.ws;
    LAS float* scr = (LAS float*)(F.lds + 8192 + F.wave * 16384);
    constexpr int I_FI = (1024 / 64) * (5632 / 32), I_FO = (2816 / 64) * (1024 / 32), I_SQ = 16 * 32, I_GLU = 16 * 64, I_QKV = 16 * 96;
    const int q = job == 0 ? 0 : (job == 1 ? 1 : (job == 2 ? 2 : 3));
    const int nextra = job == 1 ? I_SQ + I_GLU : (job == 2 ? I_QKV + I_SQ : 0);
    const int nitems = I_FI + I_FO + nextra;
    for (int it = worker; it < nitems; it += nworkers) {
        int r = it;
        if (r < I_FI) { p0_transpose_item(a.in[7] + (size_t)q * 1024 * 5632, 1024, 5632, 2816, (f16*)(ws + WS_WFI + q * WFI_SZ), scr, r, F.lane); continue; } r -= I_FI;
        if (r < I_FO) { p0_transpose_item(a.in[8] + (size_t)q * 2816 * 1024, 2816, 1024, 0, (f16*)(ws + WS_WFO + q * WFO_SZ), scr, r, F.lane); continue; } r -= I_FO;
        if (job == 1) {
            if (r < I_SQ) { p0_transpose_item(a.in[9], 1024, 1024, 0, (f16*)(ws + WS_WSI), scr, r, F.lane); continue; } r -= I_SQ;
            p0_transpose_item(a.in[18], 1024, 2048, 1024, (f16*)(ws + WS_WGLU), scr, r, F.lane);
        } else {
            if (r < I_QKV) { p0_transpose_item(a.in[19], 1024, 3072, 0, (f16*)(ws + WS_WQKV), scr, r, F.lane); continue; } r -= I_QKV;
            p0_transpose_item(a.in[23], 1024, 1024, 0, (f16*)(ws + WS_WO), scr, r, F.lane);
        }
    }
}
__device__ __forceinline__ void bias_rows(Frame& F, const Args& a, int sl_lo, int sl_hi) {
    unsigned char* ws = a.ws;
    const float* MOD = (const float*)(ws + WS_MOD); float* BIAS = (float*)(ws + WS_BIAS);
    const int gw = F.vcu * 8 + F.wave, NGW = F.G * 8;
    for (int sl = sl_lo; sl <= sl_hi; ++sl) {
        const int nrows = sl == 1 ? 1024 : (sl == 4 ? 3072 : 5632);
        const f16* Wt = sl == 0 ? (const f16*)(ws + WS_WFI) : sl == 1 ? (const f16*)(ws + WS_WSI) : sl == 2 ? (const f16*)(ws + WS_WFI + 1 * WFI_SZ)
                      : sl == 3 ? (const f16*)(ws + WS_WFI + 2 * WFI_SZ) : sl == 4 ? (const f16*)(ws + WS_WQKV) : (const f16*)(ws + WS_WFI + 3 * WFI_SZ);
        const int l = sl / 3, sb = sl % 3;
        for (int n = gw; n < nrows; n += NGW) {
            const f16x8 w0 = *(const f16x8*)(Wt + (size_t)n * D + 16 * F.lane), w1 = *(const f16x8*)(Wt + (size_t)n * D + 16 * F.lane + 8);
            float d[3];
#pragma unroll
            for (int mi = 0; mi < 3; ++mi) { const float* sh = MOD + (l * 3 + mi) * 9216 + sb * 3072 + 16 * F.lane; float acc = 0.f;
#pragma unroll
                for (int q = 0; q < 4; ++q) { const f32x4 sv = *(const f32x4*)(sh + 4 * q);
#pragma unroll
                    for (int e = 0; e < 4; ++e) { const int k = 4 * q + e; acc += sv[e] * (float)(k < 8 ? w0[k & 7] : w1[k & 7]); } }
                d[mi] = wave_sum(acc); }
            if (F.lane == 0) { BIAS[(sl * 3 + 0) * 5632 + n] = d[0]; BIAS[(sl * 3 + 1) * 5632 + n] = d[1]; BIAS[(sl * 3 + 2) * 5632 + n] = d[2]; }
        }
    }
}
__device__ __forceinline__ void p0_phase(Frame& F, const Args& a) {
    unsigned char* ws = a.ws;
    float* MOD = (float*)(ws + WS_MOD);
    {
        const float* cin = a.in[1]; const float* cctx = a.in[3]; const float* ada_w = a.in[5]; const float* ada_b = a.in[6];
        LAS float* red = (LAS float*)F.lds;
        const int c4 = F.lane & 15, ko = F.lane >> 4;
        for (int u = blockIdx.x; u < 576; u += F.G) {
            const int kh = u & 1, cgl = u >> 1, l = cgl / 144, cg = cgl % 144;
            const float* Wl = ada_w + (size_t)l * 1024 * 9216 + cg * 64 + c4 * 4;
            const int kbase = kh * 512 + F.wave * 64 + ko;
            float acc[3][4];
#pragma unroll
            for (int m = 0; m < 3; ++m)
#pragma unroll
                for (int e = 0; e < 4; ++e) acc[m][e] = 0.f;
#pragma unroll 4
            for (int i = 0; i < 16; ++i) { const int k = kbase + 4 * i; const f32x4 w = *(const f32x4*)(Wl + (size_t)k * 9216);
                const float c0 = cin[k], c1 = cin[1024 + k], c2 = cctx[k];
                const float s0 = c0 * sigmoidf_(c0), s1 = c1 * sigmoidf_(c1), s2 = c2 * sigmoidf_(c2);
#pragma unroll
                for (int e = 0; e < 4; ++e) { acc[0][e] += s0 * w[e]; acc[1][e] += s1 * w[e]; acc[2][e] += s2 * w[e]; } }
#pragma unroll
            for (int m = 0; m < 3; ++m)
#pragma unroll
                for (int e = 0; e < 4; ++e) { float v = acc[m][e]; v += __shfl_xor(v, 16); v += __shfl_xor(v, 32); acc[m][e] = v; }
            if (F.lane < 16) {
#pragma unroll
                for (int m = 0; m < 3; ++m)
#pragma unroll
                    for (int e = 0; e < 4; ++e) red[(F.wave * 3 + m) * 64 + c4 * 4 + e] = acc[m][e];
            }
            __syncthreads();
            if (F.tid < 192) { const int m = F.tid >> 6, col = F.tid & 63; float s = 0.f;
#pragma unroll
                for (int w = 0; w < 8; ++w) s += red[(w * 3 + m) * 64 + col];
                if (kh == 0) s += ada_b[l * 9216 + cg * 64 + col];
                atomicAdd(MOD + (size_t)(l * 3 + m) * 9216 + cg * 64 + col, s); }
            __syncthreads();
        }
    }
    conv_job(F, a, 0, F.vcu * 8 + F.wave, F.G * 8);
    { float* SS = (float*)(ws + WS_SS); for (int i = blockIdx.x * 512 + F.tid; i < 5 * MALL; i += F.G * 512) SS[MALL + i] = 0.f; }
    {
        const float* lam_re = a.in[10]; const float* lam_im = a.in[11]; const float* lstep = a.in[12];
        const float* b_re = a.in[13]; const float* b_im = a.in[14]; const float* c_re = a.in[15]; const float* c_im = a.in[16];
        float* Lam = (float*)(ws + WS_LAM); float* LamT = (float*)(ws + WS_LAMT); f16* Bm = (f16*)(ws + WS_BMAT); f16* Cm = (f16*)(ws + WS_CMAT);
        for (int idx = blockIdx.x * 512 + F.tid; idx < 8192; idx += F.G * 512) {
            const int p = idx & 63, g = (idx >> 6) & 63, dir = idx >> 12;
            const double lr = fmin((double)lam_re[idx], -1e-4), li = (double)lam_im[idx];
            const double dt = (double)expf(lstep[dir * 64 + g]);
            const double mag = dexp_small(lr * dt);
            double th = li * dt; const double twopi = 6.283185307179586476925287;
            th -= twopi * rint(th / twopi);
            double sn, cs; dsincos(th, sn, cs);
            const double ar = mag * cs, ai = mag * sn;
            const double den = lr * lr + li * li;
            const double cr = ((ar - 1.0) * lr + ai * li) / den, ci = (ai * lr - (ar - 1.0) * li) / den;
            Lam[idx * 2] = (float)ar; Lam[idx * 2 + 1] = (float)ai;
            double pr = ar, pi = ai;
#pragma unroll
            for (int q = 0; q < 6; ++q) { const double nr = pr * pr - pi * pi, ni = 2.0 * pr * pi; pr = nr; pi = ni; }
            LamT[idx * 2] = (float)pr; LamT[idx * 2 + 1] = (float)pi;
            const float* br = b_re + (size_t)idx * 16; const float* bi = b_im + (size_t)idx * 16;
            f16* bo = Bm + ((size_t)(g * 2 + dir) * 128 + 2 * p) * 16;
#pragma unroll
            for (int h = 0; h < 16; ++h) { bo[h] = (f16)br[h]; bo[16 + h] = (f16)bi[h]; }
#pragma unroll
            for (int h = 0; h < 16; ++h) {
                const double Cr = (double)c_re[((size_t)(dir * 64 + g) * 16 + h) * 64 + p], Ci = (double)c_im[((size_t)(dir * 64 + g) * 16 + h) * 64 + p];
                const double er = Cr * cr - Ci * ci, ei = Cr * ci + Ci * cr;
                f16* co = Cm + ((size_t)(g * 2 + dir) * 16 + h) * 128 + 2 * p;
                co[0] = (f16)(float)(er * 1024.0); co[1] = (f16)(float)(-ei * 1024.0);
            }
        }
    }
}

__device__ __forceinline__ void p1_phase(Frame& F, const Args& a) {
    unsigned char* ws = a.ws;
    const float* MOD = (const float*)(ws + WS_MOD); const float* norm_g = a.in[4];
    float* X = (float*)(ws + WS_X); f16* H16 = (f16*)(ws + WS_H16); float* SS = (float*)(ws + WS_SS); float* GS = (float*)(ws + WS_GS); float* BIAS = (float*)(ws + WS_BIAS);
    const int gw = F.vcu * 8 + F.wave, NGW = F.G * 8;
    for (int row = gw; row < MALL; row += NGW) {
        const float* xr = row < MLAT ? a.in[0] + (size_t)row * D : a.in[2] + (size_t)(row - MLAT) * D;
        const int mi = row < SEQ ? 0 : (row < MLAT ? 1 : 2);
        const float* sc = MOD + mi * 9216 + 1024;
        f32x4 v[4]; float sq = 0.f;
#pragma unroll
        for (int j = 0; j < 4; ++j) { v[j] = *((const f32x4*)xr + F.lane + 64 * j); sq += (v[j].x * v[j].x + v[j].y * v[j].y) + (v[j].z * v[j].z + v[j].w * v[j].w); }
        sq = wave_sum(sq);
        if (F.lane == 0) SS[row] = sq;
#pragma unroll
        for (int j = 0; j < 4; ++j) { const int col = 4 * (F.lane + 64 * j);
            const f32x4 gg = *(const f32x4*)(norm_g + col), s1 = *(const f32x4*)(sc + col);
            const f32x4 h = v[j] * gg * (s1 + 1.0f);
            u32x2 w; w.x = pk2h(h.x, h.y); w.y = pk2h(h.z, h.w);
            *(u32x2*)(H16 + (size_t)row * D + col) = w;
            *(f32x4*)(X + (size_t)row * D + col) = v[j]; }
    }
    for (int i = blockIdx.x * 512 + F.tid; i < 6 * 3 * 1024; i += F.G * 512) { const int col = i & 1023, mi = (i >> 10) % 3, sl = i / 3072, l = sl / 3, sb = sl % 3;
        GS[i] = norm_g[sl * 1024 + col] * (1.0f + MOD[(l * 3 + mi) * 9216 + sb * 3072 + 1024 + col]); }
    bias_rows(F, a, 0, 0);
}

__device__ __forceinline__ void s5_unit_decode(int unit, int w, int& gq, int& c, int& b, int& g, int& rowbase) {
    gq = unit & 15; c = (unit >> 4) % NCH; b = unit / (16 * NCH); g = gq * 4 + (w >> 1);
    rowbase = c < 4 ? MLAT + b * CTX + 64 * c : b * SEQ + 64 * (c - 4);
}
template <bool P2>
__device__ __forceinline__ void s5_load_unit(int unit, int w, int dir, int l, const f16* U16, const f32x2* Cin, f16x4 (&af)[4], f32x2& st) {
    int gq, c, b, g, rowbase; s5_unit_decode(unit, w, gq, c, b, g, rowbase);
    const int fq = l >> 4, fr = l & 15;
#pragma unroll
    for (int s = 0; s < 4; ++s) af[s] = *(const f16x4*)(U16 + (size_t)(rowbase + 16 * (dir ? 3 - s : s) + fr) * D + 16 * g + 4 * fq);
    if (P2) st = Cin[((size_t)((dir * 2 + b) * NCH + c) * 64 + g) * 64 + l];
}
__device__ __forceinline__ float fma_s(float a, float b, float c) { float r; asm("v_fma_f32 %0, %1, %2, %3" : "=v"(r) : "v"(a), "v"(b), "v"(c)); return r; }
template <bool P2>
__device__ __forceinline__ void s5_pass(Frame& F, unsigned char* ws, const float* ssm_d) {
    int l_ = F.lane; asm volatile("" : "+v"(l_));
    const int w = F.wave, l = l_, fq = l >> 4, fr = l & 15;
    LAS float* W = (LAS float*)(F.lds + w * 8448);
    LAS f16* XS = (LAS f16*)(F.lds + 67584 + w * 4352);
    LAS float* YBall = (LAS float*)(F.lds + 67584 + 34816);
    LAS float* YB = YBall + w * 1024;
    const float* Lam = (const float*)(ws + WS_LAM); const f16* Bm = (const f16*)(ws + WS_BMAT); const f16* Cm = (const f16*)(ws + WS_CMAT);
    const f16* U16 = (const f16*)(ws + WS_U16); f16* G16 = (f16*)(ws + WS_G16);
    f32x2* Eb = (f32x2*)(ws + WS_E); const f32x2* Cin = (const f32x2*)(ws + WS_CIN);
    const int dir = w & 1;
    int wstep = dir ? -132 : 132, xstep = dir ? -136 : 136, w0 = dir ? 15 * 132 : 0, x0 = dir ? 15 * 136 : 0;
    asm volatile("" : "+s"(wstep), "+s"(xstep), "+s"(w0), "+s"(x0));
    const LAS float* Wl = W + w0 + 2 * l; LAS f16* XSl = XS + x0 + 2 * l;
    constexpr int NU = NB * NCH * 16;
    int gcur = -1; float ar = 0.f, ai = 0.f;
    f16x4 bf[8]; f16x8 cfr[4];
    f16x4 af[4], afn[4]; f32x2 st = (f32x2){0.f, 0.f}, stn = (f32x2){0.f, 0.f};
    int unit = blockIdx.x;
    if (unit < NU) s5_load_unit<P2>(unit, w, dir, l, U16, Cin, af, st);
    for (; unit < NU; unit += F.G) {
        int gq, c, b, g, rowbase; s5_unit_decode(unit, w, gq, c, b, g, rowbase);
        if (g != gcur) {
            gcur = g;
            ar = Lam[((dir * 64 + g) * 64 + l) * 2]; ai = Lam[((dir * 64 + g) * 64 + l) * 2 + 1];
#pragma unroll
            for (int j = 0; j < 8; ++j) bf[j] = *(const f16x4*)(Bm + ((size_t)(g * 2 + dir) * 128 + 16 * j + fr) * 16 + 4 * fq);
            if (P2) {
#pragma unroll
                for (int kk = 0; kk < 4; ++kk) cfr[kk] = *(const f16x8*)(Cm + ((size_t)(g * 2 + dir) * 16 + fr) * 128 + 32 * kk + 8 * fq);
            }
        }
        if (unit + F.G < NU) s5_load_unit<P2>(unit + F.G, w, dir, l, U16, Cin, afn, stn);
        const size_t sidx = ((size_t)((dir * 2 + b) * NCH + c) * 64 + g) * 64 + l;
        float xr = st.x, xi = st.y; const float nai = -ai;
        const int cgl = F.tid >> 7, ct = (F.tid >> 1) & 63, chb = F.tid & 1, cgg = gq * 4 + cgl;
        const size_t co = (size_t)(rowbase + ct) * D + 16 * cgg + 8 * chb;
        f16x8 uu; f32x4 dv0, dv1;
        if (P2) { uu = *(const f16x8*)(U16 + co); dv0 = *(const f32x4*)(ssm_d + 16 * cgg + 8 * chb); dv1 = *(const f32x4*)(ssm_d + 16 * cgg + 8 * chb + 4); }
#pragma unroll
        for (int s = 0; s < 4; ++s) {
            const int sc = dir ? 3 - s : s;
            const f16x4 a4 = af[s];
#pragma unroll
            for (int j = 0; j < 8; ++j) { const f32x4 dd = __builtin_amdgcn_mfma_f32_16x16x16f16(bf[j], a4, (f32x4){0.f, 0.f, 0.f, 0.f}, 0, 0, 0);
                *(LAS f32x4*)(W + fr * 132 + 16 * j + 4 * fq) = dd; }
            CFENCE();
#pragma unroll
            for (int k = 0; k < 16; ++k) {
                const f32x2 bu = *(const LAS f32x2*)(Wl + k * wstep);
                const float nr = fma_s(nai, xi, fma_s(ar, xr, bu.x)), ni = fma_s(ai, xr, fma_s(ar, xi, bu.y)); xr = nr; xi = ni;
                if (P2) { f16x2 hv; hv.x = (f16)xr; hv.y = (f16)xi; *(LAS f16x2*)(XSl + k * xstep) = hv; } }
            if (P2) {
                CFENCE();
                f32x4 Y = (f32x4){0.f, 0.f, 0.f, 0.f};
#pragma unroll
                for (int kk = 0; kk < 4; ++kk) { const f16x8 xa = *(const LAS f16x8*)(XS + fr * 136 + 32 * kk + 8 * fq); Y = __builtin_amdgcn_mfma_f32_16x16x32_f16(cfr[kk], xa, Y, 0, 0, 0); }
                *(LAS f32x4*)(YB + (16 * sc + fr) * 16 + 4 * fq) = Y;
            }
            CFENCE();
        }
        if (!P2) { Eb[sidx] = (f32x2){xr, xi}; }
        else {
            __syncthreads();
            const LAS float* y0 = YBall + (cgl * 2) * 1024 + ct * 16 + 8 * chb; const LAS float* y1 = y0 + 1024;
            const size_t o = co;
            float hv[8];
#pragma unroll
            for (int e = 0; e < 8; ++e) { const float dd = e < 4 ? dv0[e & 3] : dv1[e & 3];
                const float y = (y0[e] + y1[e]) * (1.0f / 1024.0f) + (float)uu[e] * dd;
                const float z = 1.5957691216057308f * (y + 0.044715f * y * y * y);
                hv[e] = y * sigmoidf_(z); }
            u32x4 wv; wv.x = pk2h(hv[0], hv[1]); wv.y = pk2h(hv[2], hv[3]); wv.z = pk2h(hv[4], hv[5]); wv.w = pk2h(hv[6], hv[7]);
            *(u32x4*)(G16 + o) = wv;
            __syncthreads();
        }
#pragma unroll
        for (int s = 0; s < 4; ++s) af[s] = afn[s];
        st = stn;
    }
}

__device__ __forceinline__ void s5_carry(Frame& F, unsigned char* ws) {
    const float* LamT = (const float*)(ws + WS_LAMT); const f32x2* Eb = (const f32x2*)(ws + WS_E); f32x2* Cin = (f32x2*)(ws + WS_CIN);
    for (int wv = F.wave * F.G + blockIdx.x; wv < 256; wv += F.G * 8) {
        const int idx = wv * 64 + F.lane;
        const int p = idx & 63, g = (idx >> 6) & 63, b = (idx >> 12) & 1, dir = idx >> 13;
        const float lr = LamT[((dir * 64 + g) * 64 + p) * 2], li = LamT[((dir * 64 + g) * 64 + p) * 2 + 1];
        float sr = 0.f, si = 0.f;
        for (int k0 = 0; k0 < NCH; k0 += 12) {
            f32x2 e[12]; size_t ad[12];
#pragma unroll
            for (int j = 0; j < 12; ++j) { const int k = k0 + j; const int c = dir ? (k < 4 ? 3 - k : 135 - k) : k;
                ad[j] = ((size_t)((dir * 2 + b) * NCH + c) * 64 + g) * 64 + p; e[j] = Eb[ad[j]]; }
#pragma unroll
            for (int j = 0; j < 12; ++j) { Cin[ad[j]] = (f32x2){sr, si};
                const float nr = lr * sr - li * si + e[j].x, ni = lr * si + li * sr + e[j].y; sr = nr; si = ni; }
        }
    }
}

__device__ __forceinline__ void qknorm_phase(Frame& F, unsigned char* ws, const float* qg, const float* kg) {
    f16* Q = (f16*)(ws + WS_Q16); f16* Kp = (f16*)(ws + WS_K16); const f16* V = (const f16*)(ws + WS_V16); f16* VT = (f16*)(ws + WS_VT); f16* VTC = (f16*)(ws + WS_VTC);
    LAS f16* T = (LAS f16*)(F.lds + F.wave * 9216);
    const int gw = F.vcu * 8 + F.wave, NGW = F.G * 8, l = F.lane;
    const int dchunk = (l & 7) * 8;
    float qgv[8], kgv[8];
#pragma unroll
    for (int e = 0; e < 8; ++e) { qgv[e] = qg[dchunk + e] * 0.125f; kgv[e] = kg[dchunk + e]; }
    for (int u = gw; u < 264 * 16; u += NGW) {
        const int h = u & 15, tb = u >> 4, R0 = tb * 64;
#pragma unroll
        for (int which = 0; which < 2; ++which) {
            if (which == 0 && tb >= 256) continue;
            f16* P = which ? Kp : Q;
#pragma unroll 2
            for (int it = 0; it < 8; ++it) { f16* p = P + (size_t)(R0 + it * 8 + (l >> 3)) * D + h * 64 + dchunk;
                const f16x8 v = *(const f16x8*)p; float f[8], ss = 0.f;
#pragma unroll
                for (int e = 0; e < 8; ++e) { f[e] = (float)v[e]; ss += f[e] * f[e]; }
                ss += __shfl_xor(ss, 1); ss += __shfl_xor(ss, 2); ss += __shfl_xor(ss, 4);
                const float rinv = __builtin_amdgcn_rsqf(ss * (1.0f / 64.0f) + EPS);
                u32x4 o;
                if (which) { o.x = pk2h(f[0] * rinv * kgv[0], f[1] * rinv * kgv[1]); o.y = pk2h(f[2] * rinv * kgv[2], f[3] * rinv * kgv[3]); o.z = pk2h(f[4] * rinv * kgv[4], f[5] * rinv * kgv[5]); o.w = pk2h(f[6] * rinv * kgv[6], f[7] * rinv * kgv[7]); }
                else { o.x = pk2h(f[0] * rinv * qgv[0], f[1] * rinv * qgv[1]); o.y = pk2h(f[2] * rinv * qgv[2], f[3] * rinv * qgv[3]); o.z = pk2h(f[4] * rinv * qgv[4], f[5] * rinv * qgv[5]); o.w = pk2h(f[6] * rinv * qgv[6], f[7] * rinv * qgv[7]); }
                *(u32x4*)p = o; }
        }
#pragma unroll 2
        for (int it = 0; it < 8; ++it) { const int tok = it * 8 + (l >> 3);
            *(LAS u32x4*)(T + tok * 72 + dchunk) = *(const u32x4*)(V + (size_t)(R0 + tok) * D + h * 64 + dchunk); }
        LDS_WAIT();
        f16* dst; int ldt;
        if (tb < 256) { const int b = tb >> 7, t0 = (tb & 127) * 64; dst = VT + ((size_t)(b * 16 + h) * 64) * SEQ + t0; ldt = SEQ; }
        else { const int b = (tb - 256) >> 2, t0 = ((tb - 256) & 3) * 64; dst = VTC + ((size_t)(b * 16 + h) * 64) * CTX + t0; ldt = CTX; }
#pragma unroll 2
        for (int it = 0; it < 8; ++it) { const int d = it * 8 + (l >> 3), tc = (l & 7) * 8; f16x8 o;
#pragma unroll
            for (int e = 0; e < 8; ++e) o[e] = T[(tc + e) * 72 + d];
            *(f16x8*)(dst + (size_t)d * ldt + tc) = o; }
        LDS_WAIT();
    }
}

constexpr int AT_KROW = 144, AT_KC = 82944, AT_VC = 119808, AT_TAB = 156672;
#define AT_BAR() do { asm volatile("s_waitcnt lgkmcnt(0)" ::: "memory"); __builtin_amdgcn_s_barrier(); asm volatile("" ::: "memory"); } while (0)
typedef short v4i16_t __attribute__((ext_vector_type(4)));
__device__ __forceinline__ f16x4 at_vtr(const LAS unsigned char* p) { return __builtin_bit_cast(f16x4, __builtin_amdgcn_ds_read_tr16_b64_v4i16((LAS v4i16_t*)p)); }
__device__ __forceinline__ void attn_decode(int up, int G, int& rp, int& bh, int& rs0) {
    if (G == 256) { const int i = up & 255, k = up >> 8; bh = i >> 3; rp = (i & 7) * 8 + k; } else { rp = up & 63; bh = up >> 6; }
    rs0 = min(max(2 * rp - 4, 0), 120);
}
constexpr int AT_NPF = 5;
template <int I0, int I1, int NT>
__device__ __forceinline__ void attn_load_band(const f16* Src, int bh, int rs0, int tid, u32x4 (&tk)[NT]) {
    const int b = bh >> 4, h = bh & 15;
#pragma unroll
    for (int it = I0; it < I1; ++it) { const int q = it * 512 + tid, row = q >> 3, c16 = q & 7;
        const int gr = min(rs0 + (row >> 6), 127);
        tk[it - I0] = *(const u32x4*)(Src + (size_t)(b * SEQ + gr * 64 + (row & 63)) * D + h * 64 + c16 * 8); }
}
__device__ __forceinline__ u32x4 at_knorm(u32x4 raw, const float (&kgv)[8]) {
    const f16x8 v = __builtin_bit_cast(f16x8, raw); float f[8], ss = 0.f;
#pragma unroll
    for (int e = 0; e < 8; ++e) { f[e] = (float)v[e]; ss += f[e] * f[e]; }
    ss += __builtin_bit_cast(float, __builtin_amdgcn_update_dpp(0, __builtin_bit_cast(int, ss), 0xB1, 0xf, 0xf, true));
    ss += __builtin_bit_cast(float, __builtin_amdgcn_update_dpp(0, __builtin_bit_cast(int, ss), 0x4E, 0xf, 0xf, true));
    ss += __builtin_bit_cast(float, __builtin_amdgcn_update_dpp(0, __builtin_bit_cast(int, ss), 0x141, 0xf, 0xf, true));
    const float rinv = __builtin_amdgcn_rsqf(ss * (1.0f / 64.0f) + EPS);
    u32x4 o; o.x = pk2h(f[0] * rinv * kgv[0], f[1] * rinv * kgv[1]); o.y = pk2h(f[2] * rinv * kgv[2], f[3] * rinv * kgv[3]);
    o.z = pk2h(f[4] * rinv * kgv[4], f[5] * rinv * kgv[5]); o.w = pk2h(f[6] * rinv * kgv[6], f[7] * rinv * kgv[7]); return o;
}
__device__ __forceinline__ void attn_phase(Frame& F, unsigned char* ws, const float* rpb, const float* qg, const float* kg) {
    f16* Q = (f16*)(ws + WS_Q16); const f16* Kp = (const f16*)(ws + WS_K16); const f16* Vp = (const f16*)(ws + WS_V16);
    const int w = F.wave;
    LAS unsigned char* SM = F.lds;
    constexpr int NUP = NB * 16 * 64;
    u32x4 tk[AT_NPF];
    int bh_cur = -1;
    { int rp, bh, rs0; if ((int)blockIdx.x < NUP) { attn_decode(blockIdx.x, F.G, rp, bh, rs0); attn_load_band<0, AT_NPF, AT_NPF>(Kp, bh, rs0, F.tid, tk); } }
    for (int up = blockIdx.x; up < NUP; up += F.G) {
        int l_ = F.lane; asm volatile("" : "+v"(l_));
        const int l = l_, fr = l & 15, fq = l >> 4, tid = w * 64 + l;
        int rp, bh, rs0; attn_decode(up, F.G, rp, bh, rs0);
        const int b = bh >> 4, h = bh & 15;
        const int r0 = 2 * rp;
        const int r = r0 + (w >> 2), qt = w & 3;
        const int rs = min(max(r - 4, 0), 120), i0 = rs - rs0;
        const int cw = qt == 0 ? 0 : (qt == 1 ? 8 : (qt == 2 ? 24 : 32));
        const int qc = 16 * qt + fr, cs = min(max(qc - 8, 0), 48);
        const size_t qrow = (size_t)(b * SEQ + r * 64 + qc) * D + h * 64;
        float kgv[8];
#pragma unroll
        for (int e = 0; e < 8; ++e) kgv[e] = kg[(tid & 7) * 8 + e];
        u32x4 trk[9 - AT_NPF]; attn_load_band<AT_NPF, 9, 9 - AT_NPF>(Kp, bh, rs0, tid, trk);
        f16x8 q0, q1;
        { const f16x8 r0v = *(const f16x8*)(Q + qrow + 8 * fq), r1v = *(const f16x8*)(Q + qrow + 32 + 8 * fq); float f0[8], f1[8], ss = 0.f;
#pragma unroll
            for (int e = 0; e < 8; ++e) { f0[e] = (float)r0v[e]; f1[e] = (float)r1v[e]; ss += f0[e] * f0[e] + f1[e] * f1[e]; }
            ss += __shfl_xor(ss, 16); ss += __shfl_xor(ss, 32);
            const float rinv = __builtin_amdgcn_rsqf(ss * (1.0f / 64.0f) + EPS) * (0.125f * 1.4426950408889634f);
#pragma unroll
            for (int e = 0; e < 8; ++e) { q0[e] = (f16)(f0[e] * rinv * qg[8 * fq + e]); q1[e] = (f16)(f1[e] * rinv * qg[32 + 8 * fq + e]); } }
        {
#pragma unroll
        for (int it = 0; it < 9; ++it) { const int q = it * 512 + tid, row = q >> 3, c16 = q & 7; *(LAS u32x4*)(SM + row * AT_KROW + c16 * 16) = at_knorm(it < AT_NPF ? tk[it < AT_NPF ? it : 0] : trk[it >= AT_NPF ? it - AT_NPF : 0], kgv); } }
        if (bh != bh_cur) {
            bh_cur = bh;
#pragma unroll
            for (int it = 0; it < 4; ++it) { const int q = it * 512 + tid, row = q >> 3, c16 = q & 7; const size_t go = (size_t)(MLAT + b * CTX + row) * D + h * 64 + c16 * 8;
                *(LAS u32x4*)(SM + AT_KC + row * AT_KROW + c16 * 16) = at_knorm(*(const u32x4*)(Kp + go), kgv);
                *(LAS u32x4*)(SM + AT_VC + row * AT_KROW + c16 * 16) = *(const u32x4*)(Vp + go); }
            if (tid < 465) ((LAS float*)(SM + AT_TAB))[tid] = rpb[h * 465 + tid] * 1.4426950408889634f;
        }
        const LAS float* rp_ = (const LAS float*)(SM + AT_TAB);
        AT_BAR();
        f32x4 S[32];
        float mx = -INFINITY;
#pragma unroll
        for (int i = 0; i < 8; ++i)
#pragma unroll
            for (int hf = 0; hf < 2; ++hf) {
                const LAS unsigned char* kr = SM + ((i0 + i) * 64 + cw + 16 * hf + fr) * AT_KROW + 16 * fq;
                const f16x8 k0 = *(const LAS f16x8*)kr, k1 = *(const LAS f16x8*)(kr + 64);
                f32x4 sv = __builtin_amdgcn_mfma_f32_16x16x32_f16(k0, q0, (f32x4){0.f, 0.f, 0.f, 0.f}, 0, 0, 0);
                sv = __builtin_amdgcn_mfma_f32_16x16x32_f16(k1, q1, sv, 0, 0, 0);
                const int ri = rs + i - r + 7;
#pragma unroll
                for (int e = 0; e < 4; ++e) { const int kc = cw + 16 * hf + 4 * fq + e; const bool valid = (kc >= cs) && (kc < cs + 16);
                    const int ci = min(max(kc - qc + 15, 0), 30);
                    const float bz = rp_[ri * 31 + ci];
                    const float z = (sv[e] + bz) + (valid ? 0.f : -INFINITY); sv[e] = z; mx = fmaxf(mx, z); }
                S[i * 2 + hf] = sv;
            }
#pragma unroll
        for (int j = 0; j < 16; ++j) {
            const LAS unsigned char* kr = SM + AT_KC + (16 * j + fr) * AT_KROW + 16 * fq;
            const f16x8 k0 = *(const LAS f16x8*)kr, k1 = *(const LAS f16x8*)(kr + 64);
            f32x4 sv = __builtin_amdgcn_mfma_f32_16x16x32_f16(k0, q0, (f32x4){0.f, 0.f, 0.f, 0.f}, 0, 0, 0);
            sv = __builtin_amdgcn_mfma_f32_16x16x32_f16(k1, q1, sv, 0, 0, 0);
#pragma unroll
            for (int e = 0; e < 4; ++e) mx = fmaxf(mx, sv[e]);
            S[16 + j] = sv;
        }
        mx = fmaxf(mx, __shfl_xor(mx, 16)); mx = fmaxf(mx, __shfl_xor(mx, 32));
        float sum = 0.f;
        f16x4 P[32];
#pragma unroll
        for (int t = 0; t < 32; ++t) {
#pragma unroll
            for (int e = 0; e < 4; ++e) { const float p = __builtin_amdgcn_exp2f(S[t][e] - mx); sum += p; P[t][e] = (f16)p; } }
        sum += __shfl_xor(sum, 16); sum += __shfl_xor(sum, 32);
        const float rsum = __builtin_amdgcn_rcpf(sum);
        __builtin_amdgcn_sched_barrier(0);
        u32x4 tv[9];
        attn_load_band<0, 9, 9>(Vp, bh, rs0, tid, tv);
        __builtin_amdgcn_sched_barrier(0);
        AT_BAR();
#pragma unroll
        for (int it = 0; it < 9; ++it) { const int q = it * 512 + tid, row = q >> 3, c16 = q & 7; *(LAS u32x4*)(SM + row * AT_KROW + c16 * 16) = tv[it]; }
        AT_BAR();
        if (up + F.G < NUP) { int rp2, bh2, rs2; attn_decode(up + F.G, F.G, rp2, bh2, rs2); attn_load_band<0, AT_NPF, AT_NPF>(Kp, bh2, rs2, tid, tk); }
        __builtin_amdgcn_sched_barrier(0);
        f32x4 O[4];
#pragma unroll
        for (int dt = 0; dt < 4; ++dt) O[dt] = (f32x4){0.f, 0.f, 0.f, 0.f};
        const int trq = fr >> 2, trp = fr & 3;
#pragma unroll
        for (int i = 0; i < 8; ++i) {
            f16x8 pf;
#pragma unroll
            for (int e = 0; e < 4; ++e) { pf[e] = P[2 * i][e]; pf[4 + e] = P[2 * i + 1][e]; }
            const LAS unsigned char* vb_ = SM + ((i0 + i) * 64 + cw + 4 * fq + trq) * AT_KROW + 8 * trp;
#pragma unroll
            for (int dt = 0; dt < 4; ++dt) { const f16x4 va = at_vtr(vb_ + 32 * dt), vb = at_vtr(vb_ + 16 * AT_KROW + 32 * dt); f16x8 vf;
#pragma unroll
                for (int e = 0; e < 4; ++e) { vf[e] = va[e]; vf[4 + e] = vb[e]; }
                O[dt] = __builtin_amdgcn_mfma_f32_16x16x32_f16(vf, pf, O[dt], 0, 0, 0); }
        }
#pragma unroll
        for (int jp = 0; jp < 8; ++jp) {
            f16x8 pf;
#pragma unroll
            for (int e = 0; e < 4; ++e) { pf[e] = P[16 + 2 * jp][e]; pf[4 + e] = P[17 + 2 * jp][e]; }
            const LAS unsigned char* vb_ = SM + AT_VC + (32 * jp + 4 * fq + trq) * AT_KROW + 8 * trp;
#pragma unroll
            for (int dt = 0; dt < 4; ++dt) { const f16x4 va = at_vtr(vb_ + 32 * dt), vb = at_vtr(vb_ + 16 * AT_KROW + 32 * dt); f16x8 vf;
#pragma unroll
                for (int e = 0; e < 4; ++e) { vf[e] = va[e]; vf[4 + e] = vb[e]; }
                O[dt] = __builtin_amdgcn_mfma_f32_16x16x32_f16(vf, pf, O[dt], 0, 0, 0); }
        }
#pragma unroll
        for (int dt = 0; dt < 4; ++dt) { u32x2 o; o.x = pk2h(O[dt][0] * rsum, O[dt][1] * rsum); o.y = pk2h(O[dt][2] * rsum, O[dt][3] * rsum);
            *(u32x2*)(Q + qrow + 16 * dt + 4 * fq) = o; }
        AT_BAR();
    }
}

template <int NT, int MODE, int CB = 0>
__device__ __forceinline__ void ctx_gemm(Frame& F, const f16* A, int lda, const f16* Bt, int K, const pg8::Epi& E) {
    constexpr int KC = 256, PITCH = KC * 2 + 16, NROWS = 32 + 16 * NT, NLD = NROWS / 16;
    LAS unsigned char* SM = F.lds;
    const int w = F.wave, rt = w >> 2, kq = w & 3;
    for (int tile = blockIdx.x; tile < 256; tile += F.G) {
        int l_ = F.lane; asm volatile("" : "+v"(l_));
        const int l = l_, fr = l & 15, fq = l >> 4, tid = w * 64 + l;
        const int rb = tile & 15, cb = tile >> 4;
        const int row = MLAT + rb * 32 + 16 * rt + fr;
        const f16* src[NLD];
#pragma unroll
        for (int it = 0; it < NLD; ++it) { const int q = it * 512 + tid, srow = q >> 5, c16 = q & 31;
            if (srow < 32) src[it] = A + (size_t)(MLAT + rb * 32 + srow) * lda + c16 * 8;
            else { const int j = srow - 32; int brow;
                if (MODE == 3) { const int jj = cb * 64 + 16 * ((j >> 4) & 3) + (j & 15); brow = (jj >> 7) * 256 + (jj & 127) + ((j >> 4) >= 4 ? 128 : 0); }
                else brow = CB + cb * (16 * NT) + j;
                src[it] = Bt + (size_t)brow * K + c16 * 8; } }
        f32x4 fin[NT / 4];
#pragma unroll
        for (int i = 0; i < NT / 4; ++i) fin[i] = (f32x4){0.f, 0.f, 0.f, 0.f};
        u32x4 tr[NLD];
#pragma unroll
        for (int it = 0; it < NLD; ++it) tr[it] = *(const u32x4*)src[it];
        for (int kc = 0; kc < K; kc += KC) {
            __syncthreads();
#pragma unroll
            for (int it = 0; it < NLD; ++it) { const int q = it * 512 + tid; *(LAS u32x4*)(SM + (q >> 5) * PITCH + (q & 31) * 16) = tr[it]; }
            __syncthreads();
            if (kc + KC < K) {
#pragma unroll
                for (int it = 0; it < NLD; ++it) tr[it] = *(const u32x4*)(src[it] + kc + KC);
            }
#pragma unroll
            for (int ks = 0; ks < KC / 32; ++ks) { const f16x8 av = *(const LAS f16x8*)(SM + (16 * rt + fr) * PITCH + ks * 64 + 16 * fq);
#pragma unroll
                for (int i = 0; i < NT / 4; ++i) { const f16x8 bv = *(const LAS f16x8*)(SM + (32 + 16 * (kq + 4 * i) + fr) * PITCH + ks * 64 + 16 * fq);
                    fin[i] = __builtin_amdgcn_mfma_f32_16x16x32_f16(bv, av, fin[i], 0, 0, 0); } }
        }
        if (MODE == 0) {
            const float rinv = __builtin_amdgcn_rsqf(E.ss[row] * (1.0f / 1024.0f) + 1e-6f);
#pragma unroll
            for (int i = 0; i < NT / 4; ++i) { int col = CB + cb * (16 * NT) + 16 * (kq + 4 * i) + 4 * fq; f16* base = E.O16;
                const f32x4 v = fin[i] * rinv + *(const f32x4*)(E.bias + 2 * 5632 + col);
                if (E.split_cols) { const int t = col / E.split_cols; base += (size_t)t * E.split_stride; col -= t * E.split_cols; }
                u32x2 o; o.x = pk2h(v[0], v[1]); o.y = pk2h(v[2], v[3]);
                *(u32x2*)(base + (size_t)row * E.ldo + col) = o; }
        } else {
            const int col = cb * 64 + 16 * kq + 4 * fq; const size_t off = (size_t)row * D + col;
            const f32x4 xs = *(const f32x4*)(E.Xs + off); f32x4 xn;
            if (MODE == 2) { const f32x4 gv = *(const f32x4*)(E.gate + 2 * 9216 + col) * E.coef; xn = xs + gv * fin[0]; }
            else { const f32x4 gv = *(const f32x4*)(E.gate + 2 * 9216 + col);
#pragma unroll
                for (int e = 0; e < 4; ++e) xn[e] = xs[e] + gv[e] * fin[0][e] * sigmoidf_(fin[NT / 4 - 1][e]); }
            *(f32x4*)(E.Xd + off) = xn;
            if (E.An) { const f32x4 a0 = xn * *(const f32x4*)(E.gsn + 2 * 1024 + col);
                u32x2 o; o.x = pk2h(a0[0], a0[1]); o.y = pk2h(a0[2], a0[3]);
                *(u32x2*)(E.An + off) = o;
                float sq = (xn[0] * xn[0] + xn[1] * xn[1]) + (xn[2] * xn[2] + xn[3] * xn[3]);
                sq += __shfl_xor(sq, 16); sq += __shfl_xor(sq, 32); if (fq == 0) atomicAdd(E.ssn + row, sq); }
        }
        __syncthreads();
    }
}

#define XB_TMO      128
#define XB_XCNT(j)  (256  + 64 * (j))
#define XB_XSUB(j)  (1280 + 64 * (j))
#define XB_XGEN(j)  (2304 + 64 * (j))
#define XB_TOP      3328
#define XB_TOPGEN   3392
#define XCD_BAR_WORDS 3456
#define XB_SPIN_CAP (1u << 18)

__device__ __forceinline__ unsigned xb_ld(unsigned* p)              { return __hip_atomic_load(p, __ATOMIC_RELAXED, __HIP_MEMORY_SCOPE_AGENT); }
__device__ __forceinline__ unsigned xb_add(unsigned* p, unsigned v) { return __hip_atomic_fetch_add(p, v, __ATOMIC_RELAXED, __HIP_MEMORY_SCOPE_AGENT); }
__device__ __forceinline__ unsigned xb_xcc_id() { return (unsigned)__builtin_amdgcn_s_getreg((3 << 11) | 20) & 0xFu; }
#define XB_SPIN(cond, bar) do { unsigned _sp = 0; while (cond) { __builtin_amdgcn_s_sleep(1); \
    if ((++_sp & 255u) == 0u) { if (xb_ld(&(bar)[XB_TMO])) break; if (_sp > XB_SPIN_CAP) { atomicAdd(&(bar)[XB_TMO], 1u); break; } } } } while (0)

struct XcdBarrier {
    unsigned* bar; unsigned x;
    volatile LAS unsigned* st;
};

__device__ __forceinline__ XcdBarrier xcd_barrier_post(unsigned* bar, volatile LAS unsigned* st) {
    XcdBarrier b; b.bar = bar; b.x = xb_xcc_id(); b.st = st;
    if (threadIdx.x == 0) (void)xb_add(&bar[XB_XCNT(b.x)], 1u);
    return b;
}
__device__ __forceinline__ void xcd_barrier_complete(unsigned* bar, unsigned x, unsigned& nloc, unsigned& nx) {
    const unsigned G = gridDim.x * gridDim.y * gridDim.z;
    unsigned sum, cnt, mine, sp = 0u;
    for (;;) {
        sum = 0u; cnt = 0u; mine = 0u;
#pragma unroll
        for (unsigned j = 0; j < 16; ++j) { const unsigned c = xb_ld(&bar[XB_XCNT(j)]); sum += c; cnt += (c > 0u) ? 1u : 0u; mine = (j == x) ? c : mine; }
        if (sum == G) break;
        __builtin_amdgcn_s_sleep(1);
        if ((++sp & 255u) == 0u) { if (xb_ld(&bar[XB_TMO])) break; if (sp > XB_SPIN_CAP) { atomicAdd(&bar[XB_TMO], 1u); break; } }
    }
    nloc = mine > 0u ? mine : 1u; nx = cnt > 0u ? cnt : 1u;
}

__device__ __forceinline__ void xcd_barrier(const XcdBarrier& b) {
    asm volatile("s_waitcnt vmcnt(0)" ::: "memory");
    __syncthreads();
    if (threadIdx.x == 0) {
        unsigned* bar = b.bar;
        __builtin_amdgcn_s_waitcnt(0);
        unsigned nloc = b.st[0], nx = b.st[1];
        if (nloc == 0u) { xcd_barrier_complete(bar, b.x, nloc, nx); b.st[0] = nloc; b.st[1] = nx; }
        const unsigned old = xb_add(&bar[XB_XSUB(b.x)], 1u);
        const unsigned gen = old / nloc;
        if (old + 1u == (gen + 1u) * nloc) {
            __builtin_amdgcn_fence(__ATOMIC_RELEASE, "agent");
            asm volatile("s_waitcnt vmcnt(0)" ::: "memory");
            const unsigned og = xb_add(&bar[XB_TOP], 1u);
            const unsigned tg = og / nx;
            if (og + 1u == (tg + 1u) * nx) xb_add(&bar[XB_TOPGEN], 1u);
            else XB_SPIN(xb_ld(&bar[XB_TOPGEN]) == tg, bar);
            __builtin_amdgcn_fence(__ATOMIC_ACQUIRE, "agent");
            xb_add(&bar[XB_XGEN(b.x)], 1u);
            asm volatile("s_waitcnt vmcnt(0)" ::: "memory");
        } else {
            XB_SPIN(xb_ld(&bar[XB_XGEN(b.x)]) == gen, bar);
            __builtin_amdgcn_fence(__ATOMIC_ACQUIRE, "agent");
            asm volatile("s_waitcnt vmcnt(0)" ::: "memory");
        }
    }
    __syncthreads();
}

__global__ void __launch_bounds__(512, 2) fwd_megakernel(Args args) {
    extern __shared__ __attribute__((aligned(16))) unsigned char lds_raw[];
    Frame F;
    F.lds = (LAS unsigned char*)lds_raw;
    F.tid = threadIdx.x; F.lane = F.tid & 63; F.wave = __builtin_amdgcn_readfirstlane(F.tid >> 6);
    F.G = gridDim.x; { const int bx = blockIdx.x; F.vcu = (F.G % 8 == 0) ? (bx % 8) * (F.G / 8) + bx / 8 : bx; }
    unsigned char* ws = args.ws;
    float* MOD = (float*)(ws + WS_MOD); float* X = (float*)(ws + WS_X); f16* H16 = (f16*)(ws + WS_H16); f16* HID = (f16*)(ws + WS_HID);
    const float* norm_g = args.in[4];
    cg::grid_group grid = cg::this_grid();
    volatile LAS unsigned* bst = (volatile LAS unsigned*)(F.lds + LDS_BYTES - 16);
    if (F.tid < 4) bst[F.tid] = 0u;
    __syncthreads();
    XcdBarrier xbar = xcd_barrier_post((unsigned*)(ws + WS_BAR), bst);

    const int lo = args.ph_lo, hi = args.ph_hi;
    if (hi > (1 << 20)) grid.sync();
#define IN(k) (lo <= (k) && (k) < hi)
#define SEAM(k) do { if (IN(k) && IN((k) + 1)) xcd_barrier(xbar); asm volatile("" : "+v"(F.tid), "+v"(F.lane)); } while (0)
#define RUN_GEMM(Ap, Bp, Mr, Nc, Kc) do { pg8::Gemm g{(const u16*)(Ap), (const u16*)(Bp), (Mr), (Nc), (Kc)}; pg8::StaticOrder S; S.init(g.M, g.N, F.G, (int)blockIdx.x); pg8::gemm_phase(F.lds, g, S, E); } while (0)
#define CONV_TAIL(job) do { const int rem_ = (66 * 22) % F.G; \
        if (rem_ == 0) conv_job(F, args, (job), F.vcu * 8 + F.wave, F.G * 8); \
        else if ((int)blockIdx.x >= rem_) conv_job(F, args, (job), ((int)blockIdx.x - rem_) * 8 + F.wave, (F.G - rem_) * 8); } while (0)
#define SSP(sl) ((float*)(ws + WS_SS) + (size_t)(sl) * MALL)
#define GSP(sl) ((const float*)(ws + WS_GS) + (sl) * 3072)
#define BIASP(sl) ((const float*)(ws + WS_BIAS) + (sl) * 3 * 5632)
#define EPI_F16(dst, ld, sc, sst, sl) pg8::Epi E{(dst), (sst), nullptr, nullptr, nullptr, SSP(sl), BIASP(sl), nullptr, nullptr, nullptr, 0, (ld), (sc), 0.f}
#define EPI_SWIGLU(sl) pg8::Epi E{HID, 0, nullptr, nullptr, nullptr, SSP(sl), BIASP(sl), nullptr, nullptr, nullptr, 1, FH, 0, 0.f}
#define EPI_RES(md, dst, gt, cf, nsl) pg8::Epi E{nullptr, 0, X, (dst), (gt), nullptr, nullptr, (nsl) >= 0 ? H16 : nullptr, GSP((nsl) >= 0 ? (nsl) : 0), SSP((nsl) >= 0 ? (nsl) : 0), (md), 0, 0, (cf)}
    if (IN(0)) { p0_phase(F, args); } SEAM(0);
    if (IN(1)) { p1_phase(F, args); } SEAM(1);
    if (IN(2)) { EPI_SWIGLU(0); RUN_GEMM(H16, ws + WS_WFI + 0 * WFI_SZ, MALL, 5632, 1024); CONV_TAIL(1); } SEAM(2);
#if REP_FFNIN > 1
    if (IN(2)) { EPI_SWIGLU(0); RUN_GEMM(H16, ws + WS_WFI + 0 * WFI_SZ, MALL, 5632, 1024); } SEAM(2);
#endif
    if (IN(3)) { EPI_RES(2, X, MOD + 0 * 3072 + 2048, 0.5f, 1); RUN_GEMM(HID, ws + WS_WFO + 0 * WFO_SZ, MLAT, 1024, FH); ctx_gemm<4, 2>(F, HID, FH, (const f16*)(ws + WS_WFO + 0 * WFO_SZ), FH, E); bias_rows(F, args, 1, 2); } SEAM(3);
    if (IN(5)) { EPI_F16((f16*)(ws + WS_U16), D, 0, 0, 1); RUN_GEMM(H16, ws + WS_WSI, MLAT, 1024, 1024); ctx_gemm<4, 0>(F, H16, D, (const f16*)(ws + WS_WSI), 1024, E); } SEAM(5);
    if (IN(6)) { s5_pass<false>(F, ws, args.in[17]); } SEAM(6);
#if REP_S5 == 2
    if (IN(6)) { s5_pass<false>(F, ws, args.in[17]); } SEAM(6);
#endif
    if (IN(7)) { s5_carry(F, ws); } SEAM(7);
    if (IN(8)) { s5_pass<true>(F, ws, args.in[17]); } SEAM(8);
#if REP_S5 == 4
    if (IN(8)) { s5_pass<true>(F, ws, args.in[17]); } SEAM(8);
#endif
    if (IN(9)) { EPI_RES(3, X, MOD + 1 * 3072 + 2048, 1.f, 2); RUN_GEMM(ws + WS_G16, ws + WS_WGLU, MLAT, 2048, 1024); ctx_gemm<8, 3>(F, (const f16*)(ws + WS_G16), D, (const f16*)(ws + WS_WGLU), 1024, E); } SEAM(9);
    if (IN(11)) { EPI_SWIGLU(2); RUN_GEMM(H16, ws + WS_WFI + 1 * WFI_SZ, MALL, 5632, 1024); CONV_TAIL(2); } SEAM(11);
    if (IN(12)) { EPI_RES(2, X, MOD + 2 * 3072 + 2048, 0.5f, 3); RUN_GEMM(HID, ws + WS_WFO + 1 * WFO_SZ, MLAT, 1024, FH); ctx_gemm<4, 2>(F, HID, FH, (const f16*)(ws + WS_WFO + 1 * WFO_SZ), FH, E); bias_rows(F, args, 3, 4); } SEAM(12);
    if (IN(14)) { EPI_SWIGLU(3); RUN_GEMM(H16, ws + WS_WFI + 2 * WFI_SZ, MALL, 5632, 1024); CONV_TAIL(3); } SEAM(14);
    if (IN(15)) { EPI_RES(2, X, MOD + 3 * 9216 + 0 * 3072 + 2048, 0.5f, 4); RUN_GEMM(HID, ws + WS_WFO + 2 * WFO_SZ, MLAT, 1024, FH); ctx_gemm<4, 2>(F, HID, FH, (const f16*)(ws + WS_WFO + 2 * WFO_SZ), FH, E); bias_rows(F, args, 5, 5); } SEAM(15);
    if (IN(17)) { EPI_F16((f16*)(ws + WS_Q16), D, 1024, (size_t)MALL * D, 4); RUN_GEMM(H16, ws + WS_WQKV, MLAT, 3072, 1024); ctx_gemm<8, 0, 1024>(F, H16, D, (const f16*)(ws + WS_WQKV), 1024, E); } SEAM(17);
    if (IN(19)) { attn_phase(F, ws, args.in[22], args.in[20], args.in[21]); } SEAM(19);
#if REP_ATTN > 1
    if (IN(19)) { attn_phase(F, ws, args.in[22], args.in[20], args.in[21]); } SEAM(19);
#endif
    if (IN(20)) { EPI_RES(2, X, MOD + 3 * 9216 + 1 * 3072 + 2048, 1.f, 5); RUN_GEMM(ws + WS_Q16, ws + WS_WO, MLAT, 1024, 1024); } SEAM(20);
    if (IN(22)) { EPI_SWIGLU(5); RUN_GEMM(H16, ws + WS_WFI + 3 * WFI_SZ, MLAT, 5632, 1024); } SEAM(22);
    if (IN(23)) { EPI_RES(2, args.out, MOD + 3 * 9216 + 2 * 3072 + 2048, 0.5f, -1); RUN_GEMM(HID, ws + WS_WFO + 3 * WFO_SZ, MLAT, 1024, FH); }
}

extern "C" void kernel_launch(void* const* d_in, const int* in_sizes, int n_in, void* d_out, int out_size, void* d_ws, size_t ws_size, hipStream_t stream) {
    static int grid = 0;
    if (grid == 0) {
        if (n_in != 24 || ws_size < WS_END) { fprintf(stderr, "kernel_launch: unexpected n_in %d or ws_size %zu (< %zu)\n", n_in, ws_size, (size_t)WS_END); grid = -1; return; }
        int dev = 0, cus = 0, per_cu = 0;
        hipGetDevice(&dev); hipDeviceGetAttribute(&cus, hipDeviceAttributeMultiprocessorCount, dev);
        if (hipFuncSetAttribute((const void*)fwd_megakernel, hipFuncAttributeMaxDynamicSharedMemorySize, LDS_BYTES) != hipSuccess) { fprintf(stderr, "kernel_launch: hipFuncSetAttribute failed\n"); }
        if (hipOccupancyMaxActiveBlocksPerMultiprocessor(&per_cu, (const void*)fwd_megakernel, 512, LDS_BYTES) != hipSuccess || per_cu < 1) { fprintf(stderr, "kernel_launch: occupancy query says %d\n", per_cu); per_cu = 1; }
        (void)hipGetLastError();
        grid = cus * 1;
        if (grid <= 0) grid = 256;
    }
    if (grid < 0) return;
    hipMemsetAsync((char*)d_ws + WS_MOD, 0, MOD_BYTES, stream);
    Args a{};
    for (int i = 0; i < 24; ++i) a.in[i] = (const float*)d_in[i];
    a.out = (float*)d_out; a.ws = (unsigned char*)d_ws;
#if MK_COOP
    a.ph_lo = 0; a.ph_hi = NPHASE;
    void* kargs[] = {&a};
    hipError_t e = hipLaunchCooperativeKernel((const void*)fwd_megakernel, dim3(grid), dim3(512), kargs, LDS_BYTES, stream);
    if (e != hipSuccess) fprintf(stderr, "cooperative launch failed: %s (grid %d)\n", hipGetErrorString(e), grid);
#else
    for (int ph = 0; ph < NPHASE; ++ph) {
        a.ph_lo = ph; a.ph_hi = ph + 1;
        hipLaunchKernelGGL(fwd_megakernel, dim3(grid), dim3(512), LDS_BYTES, stream, a);
    }
#endif
}
```

```cpp
#include <hip/hip_runtime.h>
#include <hip/hip_cooperative_groups.h>
#include <cstdio>
#include <cstdint>
namespace cg = cooperative_groups;

#ifndef REP_S5
#define REP_S5 1
#endif
#ifndef REP_ATTN
#define REP_ATTN 1
#endif
#ifndef REP_FFNIN
#define REP_FFNIN 1
#endif
#ifndef REP_NORM
#define REP_NORM 1
#endif
#ifndef REP_CONV
#define REP_CONV 1
#endif
#ifndef MK_COOP
#define MK_COOP 1
#endif

#define LAS __attribute__((address_space(3)))
typedef _Float16 f16;
typedef f16 f16x8 __attribute__((ext_vector_type(8)));
typedef f16 f16x4 __attribute__((ext_vector_type(4)));
typedef f16 f16x2 __attribute__((ext_vector_type(2)));
typedef float f32x4 __attribute__((ext_vector_type(4)));
typedef float f32x2 __attribute__((ext_vector_type(2)));
typedef unsigned u32x4 __attribute__((ext_vector_type(4)));
typedef unsigned u32x2 __attribute__((ext_vector_type(2)));
typedef unsigned short u16;

constexpr int D = 1024, SEQ = 8192, NB = 2, CTX = 256, FH = 2816;
constexpr int MLAT = NB * SEQ;
constexpr int MALL = MLAT + NB * CTX;
constexpr int NCH = 132;
constexpr float EPS = 1e-6f;

constexpr size_t MiB = 1u << 20;
constexpr size_t WS_MOD = 0;
constexpr size_t MOD_BYTES = 262144;
constexpr size_t WS_BAR = 229376;
constexpr size_t WS_LAM = 262144;
constexpr size_t WS_LAMT = WS_LAM + 65536;
constexpr size_t WS_BMAT = WS_LAMT + 65536;
constexpr size_t WS_CMAT = WS_BMAT + 524288;
constexpr size_t WS_WFI = 2 * MiB;
constexpr size_t WFI_SZ = (size_t)5632 * 1024 * 2;
constexpr size_t WS_WFO = WS_WFI + 4 * WFI_SZ;
constexpr size_t WFO_SZ = (size_t)1024 * 2816 * 2;
constexpr size_t WS_WSI = WS_WFO + 4 * WFO_SZ;
constexpr size_t WS_WGLU = WS_WSI + 2 * MiB;
constexpr size_t WS_WQKV = WS_WGLU + 4 * MiB;
constexpr size_t WS_WO = WS_WQKV + 6 * MiB;
constexpr size_t WS_X = 82 * MiB;
constexpr size_t WS_H16 = 148 * MiB;
constexpr size_t WS_R = 181 * MiB;
constexpr size_t WS_HID = WS_R;
constexpr size_t WS_U16 = WS_R;
constexpr size_t WS_G16 = WS_R + 33 * MiB;
constexpr size_t WS_E = WS_R + 66 * MiB;
constexpr size_t WS_CIN = WS_R + 83 * MiB;
constexpr size_t WS_Q16 = WS_R;
constexpr size_t WS_K16 = WS_R + 33 * MiB;
constexpr size_t WS_V16 = WS_R + 66 * MiB;
constexpr size_t WS_VT = WS_R + 99 * MiB;
constexpr size_t WS_VTC = WS_R + 131 * MiB;
constexpr size_t WS_SS = WS_CMAT + 524288;
constexpr size_t WS_GS = WS_SS + (size_t)6 * 16896 * 4;
constexpr size_t WS_BIAS = 313 * MiB;
constexpr size_t WS_END = 314 * MiB;
static_assert(WS_GS + 6 * 3 * 1024 * 4 <= 2 * MiB, "small tables below the weights");
static_assert(WS_WO + 2 * MiB == WS_X, "weights end at X");

constexpr int LDS_BYTES = 163840;
constexpr int NPHASE = 24;

namespace pg8 {
constexpr int BM = 256, BK = 64, HALF = 128, HTB = HALF * BK * 2, STAGE_BYTES = 8 * HTB, NXCD = 8, WGM = 8;
__host__ __device__ __forceinline__ int lds_byte(int r, int c) { const int st = (r >> 4) * 2 + (c >> 5), rr = r & 15, cc = c & 31, ob = rr * 64 + cc * 2; return st * 1024 + (ob ^ (((ob >> 9) & 1) << 5)); }
__host__ __device__ __forceinline__ void stage_rc(int b, int& R, int& C) { const int st = b / 1024, sb = b % 1024, swz = sb ^ (((sb >> 9) & 1) << 5); R = (st >> 1) * 16 + swz / 64; C = (st & 1) * 32 + (swz % 64) / 2; }
__host__ __device__ __forceinline__ int perm32(int rho) { const int n = rho >> 4, i = rho & 15; return 8 * (i >> 2) + 4 * n + (i & 3); }

struct Unit { int pm, pn; };
struct Gemm { const u16* A; const u16* Bt; int M, N, K; };

struct StaticOrder {
    int nM, nN, nwg, G, c;
    __device__ void init(int M, int N, int G_, int c_) { nM = M / BM; nN = N / BM; nwg = nM * nN; G = G_; c = c_; }
    __device__ bool next(int i, Unit& u) const {
        const long L = (long)i * G + c; if (L >= nwg) return false;
        int wgid = (int)L; { const int q = nwg / NXCD, r = nwg % NXCD, xcd = wgid % NXCD, off = wgid / NXCD; wgid = (xcd < r ? xcd * (q + 1) : r * (q + 1) + (xcd - r) * q) + off; }
        const int nig = WGM * nN, gid = wgid / nig, fm = gid * WGM, gsz = (nM - fm) < WGM ? (nM - fm) : WGM;
        u.pm = fm + ((wgid % nig) % gsz); u.pn = (wgid % nig) / gsz; return true;
    }
};

__device__ __forceinline__ unsigned pk2h(float a, float b) { f16x2 v; v.x = (f16)a; v.y = (f16)b; return __builtin_bit_cast(unsigned, v); }
__device__ __forceinline__ float sigmoidf_(float x) { return __builtin_amdgcn_rcpf(1.0f + __expf(-x)); }

struct Epi {
    static constexpr bool PERM = true;
    f16* O16; size_t split_stride;
    const float* Xs; float* Xd; const float* gate;
    const float* ss; const float* bias;
    f16* An; const float* gsn; float* ssn;
    int mode;
    int ldo; int split_cols; float coef;
    __device__ __forceinline__ void operator()(const f32x4 (&acc)[2][2][4][2], const Unit& u, int wr, int wc, int fr, int fq) const {
        const int row0 = u.pm * BM + wr * 64 + fr;
        const int rowt = u.pm * BM; const int mi = rowt < SEQ ? 0 : (rowt < MLAT ? 1 : 2);
        if (mode == 0) {
            int colt = u.pn * BM; f16* base = O16;
            const float* bp = bias + mi * 5632 + colt + wc * 32 + 8 * fq;
            if (split_cols) { const int t = colt / split_cols; base += (size_t)t * split_stride; colt -= t * split_cols; }
            const int col0 = colt + wc * 32 + 8 * fq;
            f32x4 bv[2][2];
#pragma unroll
            for (int bj = 0; bj < 2; ++bj)
#pragma unroll
                for (int n = 0; n < 2; ++n) bv[bj][n] = *(const f32x4*)(bp + bj * HALF + 4 * n);
#pragma unroll
            for (int ai = 0; ai < 2; ++ai)
#pragma unroll
                for (int m = 0; m < 4; ++m) { const int row = row0 + ai * HALF + m * 16; f16* rowp = base + (size_t)row * ldo + col0;
                    const float rinv = __builtin_amdgcn_rsqf(ss[row] * (1.0f / 1024.0f) + 1e-6f);
#pragma unroll
                    for (int bj = 0; bj < 2; ++bj) { const f32x4 v0 = acc[ai][bj][m][0] * rinv + bv[bj][0], v1 = acc[ai][bj][m][1] * rinv + bv[bj][1];
                        u32x4 w; w.x = pk2h(v0[0], v0[1]); w.y = pk2h(v0[2], v0[3]); w.z = pk2h(v1[0], v1[1]); w.w = pk2h(v1[2], v1[3]);
                        *(u32x4*)(rowp + bj * HALF) = w; } }
        } else if (mode == 1) {
            const int col0 = u.pn * HALF + wc * 32 + 8 * fq;
            const float* bp = bias + mi * 5632 + u.pn * BM + wc * 32 + 8 * fq;
            f32x4 bv[2][2];
#pragma unroll
            for (int bj = 0; bj < 2; ++bj)
#pragma unroll
                for (int n = 0; n < 2; ++n) bv[bj][n] = *(const f32x4*)(bp + bj * HALF + 4 * n);
#pragma unroll
            for (int ai = 0; ai < 2; ++ai)
#pragma unroll
                for (int m = 0; m < 4; ++m) { const int row = row0 + ai * HALF + m * 16; f16* rowp = O16 + (size_t)row * ldo + col0;
                    const float rinv = __builtin_amdgcn_rsqf(ss[row] * (1.0f / 1024.0f) + 1e-6f);
                    float h[8];
#pragma unroll
                    for (int n = 0; n < 2; ++n)
#pragma unroll
                        for (int e = 0; e < 4; ++e) { const float g = acc[ai][0][m][n][e] * rinv + bv[0][n][e], up = acc[ai][1][m][n][e] * rinv + bv[1][n][e]; h[n * 4 + e] = g * sigmoidf_(g) * up; }
                    u32x4 w; w.x = pk2h(h[0], h[1]); w.y = pk2h(h[2], h[3]); w.z = pk2h(h[4], h[5]); w.w = pk2h(h[6], h[7]);
                    *(u32x4*)rowp = w; }
        } else {
            const float* gp = gate + mi * 9216;
            if (mode == 2) {
                const int col0 = u.pn * BM + wc * 32 + 8 * fq;
                f32x4 gv[2][2], gs[2][2];
#pragma unroll
                for (int bj = 0; bj < 2; ++bj)
#pragma unroll
                    for (int n = 0; n < 2; ++n) { gv[bj][n] = *(const f32x4*)(gp + col0 + bj * HALF + 4 * n) * coef;
                        gs[bj][n] = *(const f32x4*)(gsn + mi * 1024 + col0 + bj * HALF + 4 * n); }
#pragma unroll
                for (int ai = 0; ai < 2; ++ai) {
#pragma unroll
                  for (int mp = 0; mp < 2; ++mp) {
                    f32x4 xpre[4][2][2];
#pragma unroll
                    for (int m = 2 * mp; m < 2 * mp + 2; ++m)
#pragma unroll
                        for (int bj = 0; bj < 2; ++bj)
#pragma unroll
                            for (int n = 0; n < 2; ++n) xpre[m][bj][n] = *(const f32x4*)(Xs + (size_t)(row0 + ai * HALF + m * 16) * D + col0 + bj * HALF + 4 * n);
                    asm volatile("" ::: "memory");
#pragma unroll
                    for (int m = 2 * mp; m < 2 * mp + 2; ++m) { const int row = row0 + ai * HALF + m * 16; const size_t off = (size_t)row * D + col0; float sq = 0.f;
#pragma unroll
                        for (int bj = 0; bj < 2; ++bj) { f32x4 xn[2];
#pragma unroll
                            for (int n = 0; n < 2; ++n) { const f32x4 xs = xpre[m][bj][n];
                                xn[n] = xs + gv[bj][n] * acc[ai][bj][m][n];
                                *(f32x4*)(Xd + off + bj * HALF + 4 * n) = xn[n];
                                sq += (xn[n][0] * xn[n][0] + xn[n][1] * xn[n][1]) + (xn[n][2] * xn[n][2] + xn[n][3] * xn[n][3]); }
                            if (An) { const f32x4 a0 = xn[0] * gs[bj][0], a1 = xn[1] * gs[bj][1];
                                u32x4 w; w.x = pk2h(a0[0], a0[1]); w.y = pk2h(a0[2], a0[3]); w.z = pk2h(a1[0], a1[1]); w.w = pk2h(a1[2], a1[3]);
                                *(u32x4*)(An + off + bj * HALF) = w; } }
                        if (An) { sq += __shfl_xor(sq, 16); sq += __shfl_xor(sq, 32); if (fq == 0) atomicAdd(ssn + row, sq); } }
                  }
                }
            } else {
                const int col0 = u.pn * HALF + wc * 32 + 8 * fq;
                f32x4 gv[2], gs[2];
#pragma unroll
                for (int n = 0; n < 2; ++n) { gv[n] = *(const f32x4*)(gp + col0 + 4 * n); gs[n] = *(const f32x4*)(gsn + mi * 1024 + col0 + 4 * n); }
#pragma unroll
                for (int ai = 0; ai < 2; ++ai) {
                    f32x4 xpre[4][2];
#pragma unroll
                    for (int m = 0; m < 4; ++m)
#pragma unroll
                        for (int n = 0; n < 2; ++n) xpre[m][n] = *(const f32x4*)(Xs + (size_t)(row0 + ai * HALF + m * 16) * D + col0 + 4 * n);
                    asm volatile("" ::: "memory");
#pragma unroll
                    for (int m = 0; m < 4; ++m) { const int row = row0 + ai * HALF + m * 16; const size_t off = (size_t)row * D + col0; float sq = 0.f; f32x4 xn[2];
#pragma unroll
                        for (int n = 0; n < 2; ++n) { const f32x4 xs = xpre[m][n]; const f32x4 a = acc[ai][0][m][n], b = acc[ai][1][m][n];
#pragma unroll
                            for (int e = 0; e < 4; ++e) xn[n][e] = xs[e] + gv[n][e] * a[e] * sigmoidf_(b[e]);
                            *(f32x4*)(Xd + off + 4 * n) = xn[n];
                            sq += (xn[n][0] * xn[n][0] + xn[n][1] * xn[n][1]) + (xn[n][2] * xn[n][2] + xn[n][3] * xn[n][3]); }
                        const f32x4 a0 = xn[0] * gs[0], a1 = xn[1] * gs[1];
                        u32x4 w; w.x = pk2h(a0[0], a0[1]); w.y = pk2h(a0[2], a0[3]); w.z = pk2h(a1[0], a1[1]); w.w = pk2h(a1[2], a1[3]);
                        *(u32x4*)(An + off) = w;
                        sq += __shfl_xor(sq, 16); sq += __shfl_xor(sq, 32); if (fq == 0) atomicAdd(ssn + row, sq); }
                }
            }
        }
    }
};

__device__ __forceinline__ void gemm_phase(LAS unsigned char* lds, const Gemm g, const StaticOrder& S, const Epi& E) {
    int tid_ = threadIdx.x; asm volatile("" : "+v"(tid_));
    const int tid = tid_, wid = __builtin_amdgcn_readfirstlane(tid >> 6), lane = tid & 63, wr = wid >> 2, wc = wid & 3, fr = lane & 15, fq = lane >> 4;
    const int K = g.K, nt = K / BK;
    unsigned voffA[2], voffB[2];
#pragma unroll
    for (int i = 0; i < 2; ++i) { int R, C; stage_rc(tid * 16 + i * 8192, R, C); const int Rb = Epi::PERM ? ((R & ~31) + perm32(R & 31)) : R;
        voffA[i] = (unsigned)(R * K + C) * 2u; voffB[i] = (unsigned)(Rb * K + C) * 2u; }
    const size_t kstep = (size_t)(BK * 2);
    const size_t hstep = (size_t)HALF * K * 2;
    const size_t tstep = 2 * hstep;
    const unsigned ldsw = (unsigned)wid * 1024u;
    const int aoff = lds_byte(wr * 64 + fr, fq * 8), boff = lds_byte(wc * 32 + fr, fq * 8);
#define PG8_SA(b, h) (((b) * 2 + (h)) * HTB)
#define PG8_SB(b, h) ((4 + (b) * 2 + (h)) * HTB)
#define PG8_STAGE(bufoff, gbase, voff) do { _Pragma("unroll") for (int _i = 0; _i < 2; ++_i) \
        __builtin_amdgcn_global_load_lds((const unsigned*)((const char*)(gbase) + (voff)[_i]), (LAS unsigned*)(lds + (bufoff) + ldsw + _i * 8192), 16, 0, 0); } while (0)
#define PG8_LDA(dst, b, h) do { _Pragma("unroll") for (int m = 0; m < 4; ++m) _Pragma("unroll") for (int k = 0; k < 2; ++k) dst[m][k] = *(const LAS f16x8*)(lds + PG8_SA(b, h) + aoff + m * 2048 + k * 1024); } while (0)
#define PG8_LDB(dst, b, h) do { _Pragma("unroll") for (int n = 0; n < 2; ++n) _Pragma("unroll") for (int k = 0; k < 2; ++k) dst[n][k] = *(const LAS f16x8*)(lds + PG8_SB(b, h) + boff + n * 2048 + k * 1024); } while (0)
#define PG8_MMA(ai, bj, At, Bt) do { __builtin_amdgcn_s_setprio(1); _Pragma("unroll") for (int m = 0; m < 4; ++m) _Pragma("unroll") for (int n = 0; n < 2; ++n) _Pragma("unroll") for (int k = 0; k < 2; ++k) \
        acc[ai][bj][m][n] = __builtin_amdgcn_mfma_f32_16x16x32_f16(Bt[n][k], At[m][k], acc[ai][bj][m][n], 0, 0, 0); __builtin_amdgcn_s_setprio(0); } while (0)
#define PG8_WAIT_V(n) asm volatile("s_waitcnt vmcnt(" #n ")" ::: "memory")
#define PG8_WAIT_L(n) asm volatile("s_waitcnt lgkmcnt(" #n ")" ::: "memory")
#define PG8_BAR __builtin_amdgcn_s_barrier()
#define PG8_SCHED __builtin_amdgcn_sched_barrier(0)
    Unit cur, nxt; int ui = 0;
    if (!S.next(0, cur)) return;
    f32x4 acc[2][2][4][2];
#pragma unroll
    for (int a = 0; a < 2; ++a)
#pragma unroll
        for (int b = 0; b < 2; ++b)
#pragma unroll
            for (int m = 0; m < 4; ++m)
#pragma unroll
                for (int n = 0; n < 2; ++n) acc[a][b][m][n] = (f32x4){0.f, 0.f, 0.f, 0.f};
    f16x8 At[4][2], B0[2][2], B1[2][2];
    const char* cA = (const char*)g.A + (size_t)cur.pm * tstep; const char* cB = (const char*)g.Bt + (size_t)cur.pn * tstep;
    PG8_STAGE(PG8_SB(0, 0), cB, voffB); PG8_STAGE(PG8_SB(0, 1), cB + hstep, voffB); PG8_STAGE(PG8_SA(0, 0), cA, voffA); PG8_STAGE(PG8_SA(0, 1), cA + hstep, voffA);
    if (wr == 1) PG8_BAR;
    PG8_WAIT_V(2); PG8_BAR;
    PG8_STAGE(PG8_SB(1, 0), cB + kstep, voffB); PG8_STAGE(PG8_SA(1, 0), cA + kstep, voffA); PG8_STAGE(PG8_SB(1, 1), cB + hstep + kstep, voffB);
    PG8_WAIT_V(6); PG8_BAR;
    for (;;) {
        const bool has_next = S.next(ui + 1, nxt);
        const char* nA = has_next ? (const char*)g.A + (size_t)nxt.pm * tstep : cA; const char* nB = has_next ? (const char*)g.Bt + (size_t)nxt.pn * tstep : cB;
        for (int t = 0; t < nt; t += 2) {
            const bool last = (t == nt - 2);
            const char* a1 = cA + (size_t)(t + 1) * kstep;
            const char* a2 = last ? nA : cA + (size_t)(t + 2) * kstep; const char* b2 = last ? nB : cB + (size_t)(t + 2) * kstep;
            const char* a3 = a2 + kstep; const char* b3 = b2 + kstep;
            PG8_LDB(B0, 0, 0); PG8_LDB(B1, 0, 1); PG8_SCHED; PG8_LDA(At, 0, 0); PG8_STAGE(PG8_SA(1, 1), a1 + hstep, voffA);
            PG8_WAIT_V(8); PG8_WAIT_L(0); PG8_BAR; PG8_MMA(0, 0, At, B0); PG8_MMA(0, 1, At, B1); PG8_BAR; PG8_SCHED;
            PG8_LDA(At, 0, 1); PG8_STAGE(PG8_SB(0, 0), b2, voffB); PG8_STAGE(PG8_SB(0, 1), b2 + hstep, voffB); PG8_STAGE(PG8_SA(0, 0), a2, voffA);
            PG8_WAIT_V(8); PG8_WAIT_L(0); PG8_BAR; PG8_MMA(1, 0, At, B0); PG8_MMA(1, 1, At, B1); PG8_BAR; PG8_SCHED;
            PG8_LDB(B0, 1, 0); PG8_LDB(B1, 1, 1); PG8_SCHED; PG8_LDA(At, 1, 0); PG8_STAGE(PG8_SA(0, 1), a2 + hstep, voffA);
            PG8_WAIT_V(8); PG8_WAIT_L(0); PG8_BAR; PG8_MMA(0, 0, At, B0); PG8_MMA(0, 1, At, B1); PG8_BAR; PG8_SCHED;
            PG8_LDA(At, 1, 1); PG8_STAGE(PG8_SB(1, 0), b3, voffB); PG8_STAGE(PG8_SB(1, 1), b3 + hstep, voffB); PG8_STAGE(PG8_SA(1, 0), a3, voffA);
            PG8_WAIT_V(8); PG8_WAIT_L(0); PG8_BAR; PG8_MMA(1, 0, At, B0); PG8_MMA(1, 1, At, B1); PG8_BAR; PG8_SCHED;
        }
        if (wr == 0) PG8_BAR;
        E(acc, cur, wr, wc, fr, fq);
        if (!has_next) break;
#pragma unroll
        for (int a = 0; a < 2; ++a)
#pragma unroll
            for (int b = 0; b < 2; ++b)
#pragma unroll
                for (int m = 0; m < 4; ++m)
#pragma unroll
                    for (int n = 0; n < 2; ++n) acc[a][b][m][n] = (f32x4){0.f, 0.f, 0.f, 0.f};
        cur = nxt; cA = nA; cB = nB; ++ui;
        if (wr == 1) PG8_BAR;
    }
    PG8_WAIT_V(0);
    PG8_BAR;
#undef PG8_SA
#undef PG8_SB
#undef PG8_STAGE
#undef PG8_LDA
#undef PG8_LDB
#undef PG8_MMA
#undef PG8_WAIT_V
#undef PG8_WAIT_L
#undef PG8_BAR
#undef PG8_SCHED
}
}
using pg8::pk2h;
using pg8::sigmoidf_;

#define LDS_WAIT() asm volatile("s_waitcnt lgkmcnt(0)" ::: "memory")
#define CFENCE() asm volatile("" ::: "memory")

struct Args {
    const float* in[24]; float* out; unsigned char* ws; int ph_lo, ph_hi;
};

struct Frame {
    LAS unsigned char* lds; int tid, lane, wave, vcu, G;
};

__device__ __forceinline__ float wave_sum(float v) {
#pragma unroll
    for (int o = 1; o < 64; o <<= 1) v += __shfl_xor(v, o);
    return v;
}

__device__ __forceinline__ void p0_transpose_item(const float* W, int K, int N, int half_n, f16* WT, LAS float* scr, int item, int lane) {
    const int nblk = N / 32, kb = item / nblk, nb = item % nblk, k0 = 64 * kb, n0 = 32 * nb;
    int d0 = n0;
    if (half_n) { const int j = n0 < half_n ? n0 : n0 - half_n; d0 = (j >> 7) * 256 + (n0 < half_n ? 0 : 128) + (j & 127); }
#pragma unroll 8
    for (int i = 0; i < 32; ++i) { const int kk = 2 * i + (lane >> 5); scr[kk * 33 + (lane & 31)] = W[(size_t)(k0 + kk) * N + n0 + (lane & 31)]; }
    LDS_WAIT();
    const int c = lane & 7;
#pragma unroll
    for (int j = 0; j < 4; ++j) { const int n = (lane >> 3) + 8 * j; const LAS float* s = scr + (8 * c) * 33 + n;
        u32x4 o; o.x = pk2h(s[0 * 33], s[1 * 33]); o.y = pk2h(s[2 * 33], s[3 * 33]); o.z = pk2h(s[4 * 33], s[5 * 33]); o.w = pk2h(s[6 * 33], s[7 * 33]);
        *(u32x4*)(WT + (size_t)(d0 + n) * K + k0 + 8 * c) = o; }
    LDS_WAIT();
}

__device__ __forceinline__ void dsincos(double r, double& s, double& c) {
    const double r2 = r * r; double ts = r, tc = 1.0; s = r; c = 1.0;
#pragma unroll
    for (int i = 1; i <= 14; ++i) { tc = -tc * r2 / (double)((2 * i - 1) * (2 * i)); c += tc; ts = -ts * r2 / (double)((2 * i) * (2 * i + 1)); s += ts; }
}
__device__ __forceinline__ double dexp_small(double x) {
    double t = 1.0, s = 1.0;
#pragma unroll
    for (int i = 1; i <= 14; ++i) { t = t * x / (double)i; s += t; }
    return s;
}

__device__ __forceinline__ void conv_job(Frame& F, const Args& a, int job, int worker, int nworkers) {
    unsigned char* ws = a.ws;
    LAS float* scr = (LAS float*)(F.lds + 8192 + F.wave * 16384);
    constexpr int I_FI = (1024 / 64) * (5632 / 32), I_FO = (2816 / 64) * (1024 / 32), I_SQ = 16 * 32, I_GLU = 16 * 64, I_QKV = 16 * 96;
    const int q = job == 0 ? 0 : (job == 1 ? 1 : (job == 2 ? 2 : 3));
    const int nextra = job == 1 ? I_SQ + I_GLU : (job == 2 ? I_QKV + I_SQ : 0);
    const int nitems = I_FI + I_FO + nextra;
    for (int it = worker; it < nitems; it += nworkers) {
        int r = it;
        if (r < I_FI) { p0_transpose_item(a.in[7] + (size_t)q * 1024 * 5632, 1024, 5632, 2816, (f16*)(ws + WS_WFI + q * WFI_SZ), scr, r, F.lane); continue; } r -= I_FI;
        if (r < I_FO) { p0_transpose_item(a.in[8] + (size_t)q * 2816 * 1024, 2816, 1024, 0, (f16*)(ws + WS_WFO + q * WFO_SZ), scr, r, F.lane); continue; } r -= I_FO;
        if (job == 1) {
            if (r < I_SQ) { p0_transpose_item(a.in[9], 1024, 1024, 0, (f16*)(ws + WS_WSI), scr, r, F.lane); continue; } r -= I_SQ;
            p0_transpose_item(a.in[18], 1024, 2048, 1024, (f16*)(ws + WS_WGLU), scr, r, F.lane);
        } else {
            if (r < I_QKV) { p0_transpose_item(a.in[19], 1024, 3072, 0, (f16*)(ws + WS_WQKV), scr, r, F.lane); continue; } r -= I_QKV;
            p0_transpose_item(a.in[23], 1024, 1024, 0, (f16*)(ws + WS_WO), scr, r, F.lane);
        }
    }
}
__device__ __forceinline__ void bias_rows(Frame& F, const Args& a, int sl_lo, int sl_hi) {
    unsigned char* ws = a.ws;
    const float* MOD = (const float*)(ws + WS_MOD); float* BIAS = (float*)(ws + WS_BIAS);
    const int gw = F.vcu * 8 + F.wave, NGW = F.G * 8;
    for (int sl = sl_lo; sl <= sl_hi; ++sl) {
        const int nrows = sl == 1 ? 1024 : (sl == 4 ? 3072 : 5632);
        const f16* Wt = sl == 0 ? (const f16*)(ws + WS_WFI) : sl == 1 ? (const f16*)(ws + WS_WSI) : sl == 2 ? (const f16*)(ws + WS_WFI + 1 * WFI_SZ)
                      : sl == 3 ? (const f16*)(ws + WS_WFI + 2 * WFI_SZ) : sl == 4 ? (const f16*)(ws + WS_WQKV) : (const f16*)(ws + WS_WFI + 3 * WFI_SZ);
        const int l = sl / 3, sb = sl % 3;
        for (int n = gw; n < nrows; n += NGW) {
            const f16x8 w0 = *(const f16x8*)(Wt + (size_t)n * D + 16 * F.lane), w1 = *(const f16x8*)(Wt + (size_t)n * D + 16 * F.lane + 8);
            float d[3];
#pragma unroll
            for (int mi = 0; mi < 3; ++mi) { const float* sh = MOD + (l * 3 + mi) * 9216 + sb * 3072 + 16 * F.lane; float acc = 0.f;
#pragma unroll
                for (int q = 0; q < 4; ++q) { const f32x4 sv = *(const f32x4*)(sh + 4 * q);
#pragma unroll
                    for (int e = 0; e < 4; ++e) { const int k = 4 * q + e; acc += sv[e] * (float)(k < 8 ? w0[k & 7] : w1[k & 7]); } }
                d[mi] = wave_sum(acc); }
            if (F.lane == 0) { BIAS[(sl * 3 + 0) * 5632 + n] = d[0]; BIAS[(sl * 3 + 1) * 5632 + n] = d[1]; BIAS[(sl * 3 + 2) * 5632 + n] = d[2]; }
        }
    }
}
__device__ __forceinline__ void p0_phase(Frame& F, const Args& a) {
    unsigned char* ws = a.ws;
    float* MOD = (float*)(ws + WS_MOD);
    {
        const float* cin = a.in[1]; const float* cctx = a.in[3]; const float* ada_w = a.in[5]; const float* ada_b = a.in[6];
        LAS float* red = (LAS float*)F.lds;
        const int c4 = F.lane & 15, ko = F.lane >> 4;
        for (int u = blockIdx.x; u < 576; u += F.G) {
            const int kh = u & 1, cgl = u >> 1, l = cgl / 144, cg = cgl % 144;
            const float* Wl = ada_w + (size_t)l * 1024 * 9216 + cg * 64 + c4 * 4;
            const int kbase = kh * 512 + F.wave * 64 + ko;
            float acc[3][4];
#pragma unroll
            for (int m = 0; m < 3; ++m)
#pragma unroll
                for (int e = 0; e < 4; ++e) acc[m][e] = 0.f;
#pragma unroll 4
            for (int i = 0; i < 16; ++i) { const int k = kbase + 4 * i; const f32x4 w = *(const f32x4*)(Wl + (size_t)k * 9216);
                const float c0 = cin[k], c1 = cin[1024 + k], c2 = cctx[k];
                const float s0 = c0 * sigmoidf_(c0), s1 = c1 * sigmoidf_(c1), s2 = c2 * sigmoidf_(c2);
#pragma unroll
                for (int e = 0; e < 4; ++e) { acc[0][e] += s0 * w[e]; acc[1][e] += s1 * w[e]; acc[2][e] += s2 * w[e]; } }
#pragma unroll
            for (int m = 0; m < 3; ++m)
#pragma unroll
                for (int e = 0; e < 4; ++e) { float v = acc[m][e]; v += __shfl_xor(v, 16); v += __shfl_xor(v, 32); acc[m][e] = v; }
            if (F.lane < 16) {
#pragma unroll
                for (int m = 0; m < 3; ++m)
#pragma unroll
                    for (int e = 0; e < 4; ++e) red[(F.wave * 3 + m) * 64 + c4 * 4 + e] = acc[m][e];
            }
            __syncthreads();
            if (F.tid < 192) { const int m = F.tid >> 6, col = F.tid & 63; float s = 0.f;
#pragma unroll
                for (int w = 0; w < 8; ++w) s += red[(w * 3 + m) * 64 + col];
                if (kh == 0) s += ada_b[l * 9216 + cg * 64 + col];
                atomicAdd(MOD + (size_t)(l * 3 + m) * 9216 + cg * 64 + col, s); }
            __syncthreads();
        }
    }
    conv_job(F, a, 0, F.vcu * 8 + F.wave, F.G * 8);
    { float* SS = (float*)(ws + WS_SS); for (int i = blockIdx.x * 512 + F.tid; i < 5 * MALL; i += F.G * 512) SS[MALL + i] = 0.f; }
    {
        const float* lam_re = a.in[10]; const float* lam_im = a.in[11]; const float* lstep = a.in[12];
        const float* b_re = a.in[13]; const float* b_im = a.in[14]; const float* c_re = a.in[15]; const float* c_im = a.in[16];
        float* Lam = (float*)(ws + WS_LAM); float* LamT = (float*)(ws + WS_LAMT); f16* Bm = (f16*)(ws + WS_BMAT); f16* Cm = (f16*)(ws + WS_CMAT);
        for (int idx = blockIdx.x * 512 + F.tid; idx < 8192; idx += F.G * 512) {
            const int p = idx & 63, g = (idx >> 6) & 63, dir = idx >> 12;
            const double lr = fmin((double)lam_re[idx], -1e-4), li = (double)lam_im[idx];
            const double dt = (double)expf(lstep[dir * 64 + g]);
            const double mag = dexp_small(lr * dt);
            double th = li * dt; const double twopi = 6.283185307179586476925287;
            th -= twopi * rint(th / twopi);
            double sn, cs; dsincos(th, sn, cs);
            const double ar = mag * cs, ai = mag * sn;
            const double den = lr * lr + li * li;
            const double cr = ((ar - 1.0) * lr + ai * li) / den, ci = (ai * lr - (ar - 1.0) * li) / den;
            Lam[idx * 2] = (float)ar; Lam[idx * 2 + 1] = (float)ai;
            double pr = ar, pi = ai;
#pragma unroll
            for (int q = 0; q < 6; ++q) { const double nr = pr * pr - pi * pi, ni = 2.0 * pr * pi; pr = nr; pi = ni; }
            LamT[idx * 2] = (float)pr; LamT[idx * 2 + 1] = (float)pi;
            const float* br = b_re + (size_t)idx * 16; const float* bi = b_im + (size_t)idx * 16;
            f16* bo = Bm + ((size_t)(g * 2 + dir) * 128 + 2 * p) * 16;
#pragma unroll
            for (int h = 0; h < 16; ++h) { bo[h] = (f16)br[h]; bo[16 + h] = (f16)bi[h]; }
#pragma unroll
            for (int h = 0; h < 16; ++h) {
                const double Cr = (double)c_re[((size_t)(dir * 64 + g) * 16 + h) * 64 + p], Ci = (double)c_im[((size_t)(dir * 64 + g) * 16 + h) * 64 + p];
                const double er = Cr * cr - Ci * ci, ei = Cr * ci + Ci * cr;
                f16* co = Cm + ((size_t)(g * 2 + dir) * 16 + h) * 128 + 2 * p;
                co[0] = (f16)(float)(er * 1024.0); co[1] = (f16)(float)(-ei * 1024.0);
            }
        }
    }
}

__device__ __forceinline__ void p1_phase(Frame& F, const Args& a) {
    unsigned char* ws = a.ws;
    const float* MOD = (const float*)(ws + WS_MOD); const float* norm_g = a.in[4];
    float* X = (float*)(ws + WS_X); f16* H16 = (f16*)(ws + WS_H16); float* SS = (float*)(ws + WS_SS); float* GS = (float*)(ws + WS_GS); float* BIAS = (float*)(ws + WS_BIAS);
    const int gw = F.vcu * 8 + F.wave, NGW = F.G * 8;
    for (int row = gw; row < MALL; row += NGW) {
        const float* xr = row < MLAT ? a.in[0] + (size_t)row * D : a.in[2] + (size_t)(row - MLAT) * D;
        const int mi = row < SEQ ? 0 : (row < MLAT ? 1 : 2);
        const float* sc = MOD + mi * 9216 + 1024;
        f32x4 v[4]; float sq = 0.f;
#pragma unroll
        for (int j = 0; j < 4; ++j) { v[j] = *((const f32x4*)xr + F.lane + 64 * j); sq += (v[j].x * v[j].x + v[j].y * v[j].y) + (v[j].z * v[j].z + v[j].w * v[j].w); }
        sq = wave_sum(sq);
        if (F.lane == 0) SS[row] = sq;
#pragma unroll
        for (int j = 0; j < 4; ++j) { const int col = 4 * (F.lane + 64 * j);
            const f32x4 gg = *(const f32x4*)(norm_g + col), s1 = *(const f32x4*)(sc + col);
            const f32x4 h = v[j] * gg * (s1 + 1.0f);
            u32x2 w; w.x = pk2h(h.x, h.y); w.y = pk2h(h.z, h.w);
            *(u32x2*)(H16 + (size_t)row * D + col) = w;
            *(f32x4*)(X + (size_t)row * D + col) = v[j]; }
    }
    for (int i = blockIdx.x * 512 + F.tid; i < 6 * 3 * 1024; i += F.G * 512) { const int col = i & 1023, mi = (i >> 10) % 3, sl = i / 3072, l = sl / 3, sb = sl % 3;
        GS[i] = norm_g[sl * 1024 + col] * (1.0f + MOD[(l * 3 + mi) * 9216 + sb * 3072 + 1024 + col]); }
    bias_rows(F, a, 0, 0);
}

__device__ __forceinline__ void s5_unit_decode(int unit, int w, int& gq, int& c, int& b, int& g, int& rowbase) {
    gq = unit & 15; c = (unit >> 4) % NCH; b = unit / (16 * NCH); g = gq * 4 + (w >> 1);
    rowbase = c < 4 ? MLAT + b * CTX + 64 * c : b * SEQ + 64 * (c - 4);
}
template <bool P2>
__device__ __forceinline__ void s5_load_unit(int unit, int w, int dir, int l, const f16* U16, const f32x2* Cin, f16x4 (&af)[4], f32x2& st) {
    int gq, c, b, g, rowbase; s5_unit_decode(unit, w, gq, c, b, g, rowbase);
    const int fq = l >> 4, fr = l & 15;
#pragma unroll
    for (int s = 0; s < 4; ++s) af[s] = *(const f16x4*)(U16 + (size_t)(rowbase + 16 * (dir ? 3 - s : s) + fr) * D + 16 * g + 4 * fq);
    if (P2) st = Cin[((size_t)((dir * 2 + b) * NCH + c) * 64 + g) * 64 + l];
}
__device__ __forceinline__ float fma_s(float a, float b, float c) { float r; asm("v_fma_f32 %0, %1, %2, %3" : "=v"(r) : "v"(a), "v"(b), "v"(c)); return r; }
template <bool P2>
__device__ __forceinline__ void s5_pass(Frame& F, unsigned char* ws, const float* ssm_d) {
    int l_ = F.lane; asm volatile("" : "+v"(l_));
    const int w = F.wave, l = l_, fq = l >> 4, fr = l & 15;
    LAS float* W = (LAS float*)(F.lds + w * 8448);
    LAS f16* XS = (LAS f16*)(F.lds + 67584 + w * 4352);
    LAS float* YBall = (LAS float*)(F.lds + 67584 + 34816);
    LAS float* YB = YBall + w * 1024;
    const float* Lam = (const float*)(ws + WS_LAM); const f16* Bm = (const f16*)(ws + WS_BMAT); const f16* Cm = (const f16*)(ws + WS_CMAT);
    const f16* U16 = (const f16*)(ws + WS_U16); f16* G16 = (f16*)(ws + WS_G16);
    f32x2* Eb = (f32x2*)(ws + WS_E); const f32x2* Cin = (const f32x2*)(ws + WS_CIN);
    const int dir = w & 1;
    int wstep = dir ? -132 : 132, xstep = dir ? -136 : 136, w0 = dir ? 15 * 132 : 0, x0 = dir ? 15 * 136 : 0;
    asm volatile("" : "+s"(wstep), "+s"(xstep), "+s"(w0), "+s"(x0));
    const LAS float* Wl = W + w0 + 2 * l; LAS f16* XSl = XS + x0 + 2 * l;
    constexpr int NU = NB * NCH * 16;
    int gcur = -1; float ar = 0.f, ai = 0.f;
    f16x4 bf[8]; f16x8 cfr[4];
    f16x4 af[4], afn[4]; f32x2 st = (f32x2){0.f, 0.f}, stn = (f32x2){0.f, 0.f};
    int unit = blockIdx.x;
    if (unit < NU) s5_load_unit<P2>(unit, w, dir, l, U16, Cin, af, st);
    for (; unit < NU; unit += F.G) {
        int gq, c, b, g, rowbase; s5_unit_decode(unit, w, gq, c, b, g, rowbase);
        if (g != gcur) {
            gcur = g;
            ar = Lam[((dir * 64 + g) * 64 + l) * 2]; ai = Lam[((dir * 64 + g) * 64 + l) * 2 + 1];
#pragma unroll
            for (int j = 0; j < 8; ++j) bf[j] = *(const f16x4*)(Bm + ((size_t)(g * 2 + dir) * 128 + 16 * j + fr) * 16 + 4 * fq);
            if (P2) {
#pragma unroll
                for (int kk = 0; kk < 4; ++kk) cfr[kk] = *(const f16x8*)(Cm + ((size_t)(g * 2 + dir) * 16 + fr) * 128 + 32 * kk + 8 * fq);
            }
        }
        if (unit + F.G < NU) s5_load_unit<P2>(unit + F.G, w, dir, l, U16, Cin, afn, stn);
        const size_t sidx = ((size_t)((dir * 2 + b) * NCH + c) * 64 + g) * 64 + l;
        float xr = st.x, xi = st.y; const float nai = -ai;
        const int cgl = F.tid >> 7, ct = (F.tid >> 1) & 63, chb = F.tid & 1, cgg = gq * 4 + cgl;
        const size_t co = (size_t)(rowbase + ct) * D + 16 * cgg + 8 * chb;
        f16x8 uu; f32x4 dv0, dv1;
        if (P2) { uu = *(const f16x8*)(U16 + co); dv0 = *(const f32x4*)(ssm_d + 16 * cgg + 8 * chb); dv1 = *(const f32x4*)(ssm_d + 16 * cgg + 8 * chb + 4); }
#pragma unroll
        for (int s = 0; s < 4; ++s) {
            const int sc = dir ? 3 - s : s;
            const f16x4 a4 = af[s];
#pragma unroll
            for (int j = 0; j < 8; ++j) { const f32x4 dd = __builtin_amdgcn_mfma_f32_16x16x16f16(bf[j], a4, (f32x4){0.f, 0.f, 0.f, 0.f}, 0, 0, 0);
                *(LAS f32x4*)(W + fr * 132 + 16 * j + 4 * fq) = dd; }
            CFENCE();
#pragma unroll
            for (int k = 0; k < 16; ++k) {
                const f32x2 bu = *(const LAS f32x2*)(Wl + k * wstep);
                const float nr = fma_s(nai, xi, fma_s(ar, xr, bu.x)), ni = fma_s(ai, xr, fma_s(ar, xi, bu.y)); xr = nr; xi = ni;
                if (P2) { f16x2 hv; hv.x = (f16)xr; hv.y = (f16)xi; *(LAS f16x2*)(XSl + k * xstep) = hv; } }
            if (P2) {
                CFENCE();
                f32x4 Y = (f32x4){0.f, 0.f, 0.f, 0.f};
#pragma unroll
                for (int kk = 0; kk < 4; ++kk) { const f16x8 xa = *(const LAS f16x8*)(XS + fr * 136 + 32 * kk + 8 * fq); Y = __builtin_amdgcn_mfma_f32_16x16x32_f16(cfr[kk], xa, Y, 0, 0, 0); }
                *(LAS f32x4*)(YB + (16 * sc + fr) * 16 + 4 * fq) = Y;
            }
            CFENCE();
        }
        if (!P2) { Eb[sidx] = (f32x2){xr, xi}; }
        else {
            __syncthreads();
            const LAS float* y0 = YBall + (cgl * 2) * 1024 + ct * 16 + 8 * chb; const LAS float* y1 = y0 + 1024;
            const size_t o = co;
            float hv[8];
#pragma unroll
            for (int e = 0; e < 8; ++e) { const float dd = e < 4 ? dv0[e & 3] : dv1[e & 3];
                const float y = (y0[e] + y1[e]) * (1.0f / 1024.0f) + (float)uu[e] * dd;
                const float z = 1.5957691216057308f * (y + 0.044715f * y * y * y);
                hv[e] = y * sigmoidf_(z); }
            u32x4 wv; wv.x = pk2h(hv[0], hv[1]); wv.y = pk2h(hv[2], hv[3]); wv.z = pk2h(hv[4], hv[5]); wv.w = pk2h(hv[6], hv[7]);
            *(u32x4*)(G16 + o) = wv;
            __syncthreads();
        }
#pragma unroll
        for (int s = 0; s < 4; ++s) af[s] = afn[s];
        st = stn;
    }
}

__device__ __forceinline__ void s5_carry(Frame& F, unsigned char* ws) {
    const float* LamT = (const float*)(ws + WS_LAMT); const f32x2* Eb = (const f32x2*)(ws + WS_E); f32x2* Cin = (f32x2*)(ws + WS_CIN);
    for (int wv = F.wave * F.G + blockIdx.x; wv < 256; wv += F.G * 8) {
        const int idx = wv * 64 + F.lane;
        const int p = idx & 63, g = (idx >> 6) & 63, b = (idx >> 12) & 1, dir = idx >> 13;
        const float lr = LamT[((dir * 64 + g) * 64 + p) * 2], li = LamT[((dir * 64 + g) * 64 + p) * 2 + 1];
        float sr = 0.f, si = 0.f;
        for (int k0 = 0; k0 < NCH; k0 += 12) {
            f32x2 e[12]; size_t ad[12];
#pragma unroll
            for (int j = 0; j < 12; ++j) { const int k = k0 + j; const int c = dir ? (k < 4 ? 3 - k : 135 - k) : k;
                ad[j] = ((size_t)((dir * 2 + b) * NCH + c) * 64 + g) * 64 + p; e[j] = Eb[ad[j]]; }
#pragma unroll
            for (int j = 0; j < 12; ++j) { Cin[ad[j]] = (f32x2){sr, si};
                const float nr = lr * sr - li * si + e[j].x, ni = lr * si + li * sr + e[j].y; sr = nr; si = ni; }
        }
    }
}

__device__ __forceinline__ void qknorm_phase(Frame& F, unsigned char* ws, const float* qg, const float* kg) {
    f16* Q = (f16*)(ws + WS_Q16); f16* Kp = (f16*)(ws + WS_K16); const f16* V = (const f16*)(ws + WS_V16); f16* VT = (f16*)(ws + WS_VT); f16* VTC = (f16*)(ws + WS_VTC);
    LAS f16* T = (LAS f16*)(F.lds + F.wave * 9216);
    const int gw = F.vcu * 8 + F.wave, NGW = F.G * 8, l = F.lane;
    const int dchunk = (l & 7) * 8;
    float qgv[8], kgv[8];
#pragma unroll
    for (int e = 0; e < 8; ++e) { qgv[e] = qg[dchunk + e] * 0.125f; kgv[e] = kg[dchunk + e]; }
    for (int u = gw; u < 264 * 16; u += NGW) {
        const int h = u & 15, tb = u >> 4, R0 = tb * 64;
#pragma unroll
        for (int which = 0; which < 2; ++which) {
            if (which == 0 && tb >= 256) continue;
            f16* P = which ? Kp : Q;
#pragma unroll 2
            for (int it = 0; it < 8; ++it) { f16* p = P + (size_t)(R0 + it * 8 + (l >> 3)) * D + h * 64 + dchunk;
                const f16x8 v = *(const f16x8*)p; float f[8], ss = 0.f;
#pragma unroll
                for (int e = 0; e < 8; ++e) { f[e] = (float)v[e]; ss += f[e] * f[e]; }
                ss += __shfl_xor(ss, 1); ss += __shfl_xor(ss, 2); ss += __shfl_xor(ss, 4);
                const float rinv = __builtin_amdgcn_rsqf(ss * (1.0f / 64.0f) + EPS);
                u32x4 o;
                if (which) { o.x = pk2h(f[0] * rinv * kgv[0], f[1] * rinv * kgv[1]); o.y = pk2h(f[2] * rinv * kgv[2], f[3] * rinv * kgv[3]); o.z = pk2h(f[4] * rinv * kgv[4], f[5] * rinv * kgv[5]); o.w = pk2h(f[6] * rinv * kgv[6], f[7] * rinv * kgv[7]); }
                else { o.x = pk2h(f[0] * rinv * qgv[0], f[1] * rinv * qgv[1]); o.y = pk2h(f[2] * rinv * qgv[2], f[3] * rinv * qgv[3]); o.z = pk2h(f[4] * rinv * qgv[4], f[5] * rinv * qgv[5]); o.w = pk2h(f[6] * rinv * qgv[6], f[7] * rinv * qgv[7]); }
                *(u32x4*)p = o; }
        }
#pragma unroll 2
        for (int it = 0; it < 8; ++it) { const int tok = it * 8 + (l >> 3);
            *(LAS u32x4*)(T + tok * 72 + dchunk) = *(const u32x4*)(V + (size_t)(R0 + tok) * D + h * 64 + dchunk); }
        LDS_WAIT();
        f16* dst; int ldt;
        if (tb < 256) { const int b = tb >> 7, t0 = (tb & 127) * 64; dst = VT + ((size_t)(b * 16 + h) * 64) * SEQ + t0; ldt = SEQ; }
        else { const int b = (tb - 256) >> 2, t0 = ((tb - 256) & 3) * 64; dst = VTC + ((size_t)(b * 16 + h) * 64) * CTX + t0; ldt = CTX; }
#pragma unroll 2
        for (int it = 0; it < 8; ++it) { const int d = it * 8 + (l >> 3), tc = (l & 7) * 8; f16x8 o;
#pragma unroll
            for (int e = 0; e < 8; ++e) o[e] = T[(tc + e) * 72 + d];
            *(f16x8*)(dst + (size_t)d * ldt + tc) = o; }
        LDS_WAIT();
    }
}

constexpr int AT_KROW = 144, AT_KC = 82944, AT_VC = 119808, AT_TAB = 156672;
#define AT_BAR() do { asm volatile("s_waitcnt lgkmcnt(0)" ::: "memory"); __builtin_amdgcn_s_barrier(); asm volatile("" ::: "memory"); } while (0)
typedef short v4i16_t __attribute__((ext_vector_type(4)));
__device__ __forceinline__ f16x4 at_vtr(const LAS unsigned char* p) { return __builtin_bit_cast(f16x4, __builtin_amdgcn_ds_read_tr16_b64_v4i16((LAS v4i16_t*)p)); }
__device__ __forceinline__ void attn_decode(int up, int G, int& rp, int& bh, int& rs0) {
    if (G == 256) { const int i = up & 255, k = up >> 8; bh = i >> 3; rp = (i & 7) * 8 + k; } else { rp = up & 63; bh = up >> 6; }
    rs0 = min(max(2 * rp - 4, 0), 120);
}
constexpr int AT_NPF = 5;
template <int I0, int I1, int NT>
__device__ __forceinline__ void attn_load_band(const f16* Src, int bh, int rs0, int tid, u32x4 (&tk)[NT]) {
    const int b = bh >> 4, h = bh & 15;
#pragma unroll
    for (int it = I0; it < I1; ++it) { const int q = it * 512 + tid, row = q >> 3, c16 = q & 7;
        const int gr = min(rs0 + (row >> 6), 127);
        tk[it - I0] = *(const u32x4*)(Src + (size_t)(b * SEQ + gr * 64 + (row & 63)) * D + h * 64 + c16 * 8); }
}
__device__ __forceinline__ u32x4 at_knorm(u32x4 raw, const float (&kgv)[8]) {
    const f16x8 v = __builtin_bit_cast(f16x8, raw); float f[8], ss = 0.f;
#pragma unroll
    for (int e = 0; e < 8; ++e) { f[e] = (float)v[e]; ss += f[e] * f[e]; }
    ss += __builtin_bit_cast(float, __builtin_amdgcn_update_dpp(0, __builtin_bit_cast(int, ss), 0xB1, 0xf, 0xf, true));
    ss += __builtin_bit_cast(float, __builtin_amdgcn_update_dpp(0, __builtin_bit_cast(int, ss), 0x4E, 0xf, 0xf, true));
    ss += __builtin_bit_cast(float, __builtin_amdgcn_update_dpp(0, __builtin_bit_cast(int, ss), 0x141, 0xf, 0xf, true));
    const float rinv = __builtin_amdgcn_rsqf(ss * (1.0f / 64.0f) + EPS);
    u32x4 o; o.x = pk2h(f[0] * rinv * kgv[0], f[1] * rinv * kgv[1]); o.y = pk2h(f[2] * rinv * kgv[2], f[3] * rinv * kgv[3]);
    o.z = pk2h(f[4] * rinv * kgv[4], f[5] * rinv * kgv[5]); o.w = pk2h(f[6] * rinv * kgv[6], f[7] * rinv * kgv[7]); return o;
}
__device__ __forceinline__ void attn_phase(Frame& F, unsigned char* ws, const float* rpb, const float* qg, const float* kg) {
    f16* Q = (f16*)(ws + WS_Q16); const f16* Kp = (const f16*)(ws + WS_K16); const f16* Vp = (const f16*)(ws + WS_V16);
    const int w = F.wave;
    LAS unsigned char* SM = F.lds;
    constexpr int NUP = NB * 16 * 64;
    u32x4 tk[AT_NPF];
    int bh_cur = -1;
    { int rp, bh, rs0; if ((int)blockIdx.x < NUP) { attn_decode(blockIdx.x, F.G, rp, bh, rs0); attn_load_band<0, AT_NPF, AT_NPF>(Kp, bh, rs0, F.tid, tk); } }
    for (int up = blockIdx.x; up < NUP; up += F.G) {
        int l_ = F.lane; asm volatile("" : "+v"(l_));
        const int l = l_, fr = l & 15, fq = l >> 4, tid = w * 64 + l;
        int rp, bh, rs0; attn_decode(up, F.G, rp, bh, rs0);
        const int b = bh >> 4, h = bh & 15;
        const int r0 = 2 * rp;
        const int r = r0 + (w >> 2), qt = w & 3;
        const int rs = min(max(r - 4, 0), 120), i0 = rs - rs0;
        const int cw = qt == 0 ? 0 : (qt == 1 ? 8 : (qt == 2 ? 24 : 32));
        const int qc = 16 * qt + fr, cs = min(max(qc - 8, 0), 48);
        const size_t qrow = (size_t)(b * SEQ + r * 64 + qc) * D + h * 64;
        float kgv[8];
#pragma unroll
        for (int e = 0; e < 8; ++e) kgv[e] = kg[(tid & 7) * 8 + e];
        u32x4 trk[9 - AT_NPF]; attn_load_band<AT_NPF, 9, 9 - AT_NPF>(Kp, bh, rs0, tid, trk);
        f16x8 q0, q1;
        { const f16x8 r0v = *(const f16x8*)(Q + qrow + 8 * fq), r1v = *(const f16x8*)(Q + qrow + 32 + 8 * fq); float f0[8], f1[8], ss = 0.f;
#pragma unroll
            for (int e = 0; e < 8; ++e) { f0[e] = (float)r0v[e]; f1[e] = (float)r1v[e]; ss += f0[e] * f0[e] + f1[e] * f1[e]; }
            ss += __shfl_xor(ss, 16); ss += __shfl_xor(ss, 32);
            const float rinv = __builtin_amdgcn_rsqf(ss * (1.0f / 64.0f) + EPS) * (0.125f * 1.4426950408889634f);
#pragma unroll
            for (int e = 0; e < 8; ++e) { q0[e] = (f16)(f0[e] * rinv * qg[8 * fq + e]); q1[e] = (f16)(f1[e] * rinv * qg[32 + 8 * fq + e]); } }
        {
#pragma unroll
        for (int it = 0; it < 9; ++it) { const int q = it * 512 + tid, row = q >> 3, c16 = q & 7; *(LAS u32x4*)(SM + row * AT_KROW + c16 * 16) = at_knorm(it < AT_NPF ? tk[it < AT_NPF ? it : 0] : trk[it >= AT_NPF ? it - AT_NPF : 0], kgv); } }
        if (bh != bh_cur) {
            bh_cur = bh;
#pragma unroll
            for (int it = 0; it < 4; ++it) { const int q = it * 512 + tid, row = q >> 3, c16 = q & 7; const size_t go = (size_t)(MLAT + b * CTX + row) * D + h * 64 + c16 * 8;
                *(LAS u32x4*)(SM + AT_KC + row * AT_KROW + c16 * 16) = at_knorm(*(const u32x4*)(Kp + go), kgv);
                *(LAS u32x4*)(SM + AT_VC + row * AT_KROW + c16 * 16) = *(const u32x4*)(Vp + go); }
            if (tid < 465) ((LAS float*)(SM + AT_TAB))[tid] = rpb[h * 465 + tid] * 1.4426950408889634f;
        }
        const LAS float* rp_ = (const LAS float*)(SM + AT_TAB);
        AT_BAR();
        f32x4 S[32];
        float mx = -INFINITY;
#pragma unroll
        for (int i = 0; i < 8; ++i)
#pragma unroll
            for (int hf = 0; hf < 2; ++hf) {
                const LAS unsigned char* kr = SM + ((i0 + i) * 64 + cw + 16 * hf + fr) * AT_KROW + 16 * fq;
                const f16x8 k0 = *(const LAS f16x8*)kr, k1 = *(const LAS f16x8*)(kr + 64);
                f32x4 sv = __builtin_amdgcn_mfma_f32_16x16x32_f16(k0, q0, (f32x4){0.f, 0.f, 0.f, 0.f}, 0, 0, 0);
                sv = __builtin_amdgcn_mfma_f32_16x16x32_f16(k1, q1, sv, 0, 0, 0);
                const int ri = rs + i - r + 7;
#pragma unroll
                for (int e = 0; e < 4; ++e) { const int kc = cw + 16 * hf + 4 * fq + e; const bool valid = (kc >= cs) && (kc < cs + 16);
                    const int ci = min(max(kc - qc + 15, 0), 30);
                    const float bz = rp_[ri * 31 + ci];
                    const float z = (sv[e] + bz) + (valid ? 0.f : -INFINITY); sv[e] = z; mx = fmaxf(mx, z); }
                S[i * 2 + hf] = sv;
            }
#pragma unroll
        for (int j = 0; j < 16; ++j) {
            const LAS unsigned char* kr = SM + AT_KC + (16 * j + fr) * AT_KROW + 16 * fq;
            const f16x8 k0 = *(const LAS f16x8*)kr, k1 = *(const LAS f16x8*)(kr + 64);
            f32x4 sv = __builtin_amdgcn_mfma_f32_16x16x32_f16(k0, q0, (f32x4){0.f, 0.f, 0.f, 0.f}, 0, 0, 0);
            sv = __builtin_amdgcn_mfma_f32_16x16x32_f16(k1, q1, sv, 0, 0, 0);
#pragma unroll
            for (int e = 0; e < 4; ++e) mx = fmaxf(mx, sv[e]);
            S[16 + j] = sv;
        }
        mx = fmaxf(mx, __shfl_xor(mx, 16)); mx = fmaxf(mx, __shfl_xor(mx, 32));
        float sum = 0.f;
        f16x4 P[32];
#pragma unroll
        for (int t = 0; t < 32; ++t) {
#pragma unroll
            for (int e = 0; e < 4; ++e) { const float p = __builtin_amdgcn_exp2f(S[t][e] - mx); sum += p; P[t][e] = (f16)p; } }
        sum += __shfl_xor(sum, 16); sum += __shfl_xor(sum, 32);
        const float rsum = __builtin_amdgcn_rcpf(sum);
        __builtin_amdgcn_sched_barrier(0);
        u32x4 tv[9];
        attn_load_band<0, 9, 9>(Vp, bh, rs0, tid, tv);
        __builtin_amdgcn_sched_barrier(0);
        AT_BAR();
#pragma unroll
        for (int it = 0; it < 9; ++it) { const int q = it * 512 + tid, row = q >> 3, c16 = q & 7; *(LAS u32x4*)(SM + row * AT_KROW + c16 * 16) = tv[it]; }
        AT_BAR();
        if (up + F.G < NUP) { int rp2, bh2, rs2; attn_decode(up + F.G, F.G, rp2, bh2, rs2); attn_load_band<0, AT_NPF, AT_NPF>(Kp, bh2, rs2, tid, tk); }
        __builtin_amdgcn_sched_barrier(0);
        f32x4 O[4];
#pragma unroll
        for (int dt = 0; dt < 4; ++dt) O[dt] = (f32x4){0.f, 0.f, 0.f, 0.f};
        const int trq = fr >> 2, trp = fr & 3;
#pragma unroll
        for (int i = 0; i < 8; ++i) {
            f16x8 pf;
#pragma unroll
            for (int e = 0; e < 4; ++e) { pf[e] = P[2 * i][e]; pf[4 + e] = P[2 * i + 1][e]; }
            const LAS unsigned char* vb_ = SM + ((i0 + i) * 64 + cw + 4 * fq + trq) * AT_KROW + 8 * trp;
#pragma unroll
            for (int dt = 0; dt < 4; ++dt) { const f16x4 va = at_vtr(vb_ + 32 * dt), vb = at_vtr(vb_ + 16 * AT_KROW + 32 * dt); f16x8 vf;
#pragma unroll
                for (int e = 0; e < 4; ++e) { vf[e] = va[e]; vf[4 + e] = vb[e]; }
                O[dt] = __builtin_amdgcn_mfma_f32_16x16x32_f16(vf, pf, O[dt], 0, 0, 0); }
        }
#pragma unroll
        for (int jp = 0; jp < 8; ++jp) {
            f16x8 pf;
#pragma unroll
            for (int e = 0; e < 4; ++e) { pf[e] = P[16 + 2 * jp][e]; pf[4 + e] = P[17 + 2 * jp][e]; }
            const LAS unsigned char* vb_ = SM + AT_VC + (32 * jp + 4 * fq + trq) * AT_KROW + 8 * trp;
#pragma unroll
            for (int dt = 0; dt < 4; ++dt) { const f16x4 va = at_vtr(vb_ + 32 * dt), vb = at_vtr(vb_ + 16 * AT_KROW + 32 * dt); f16x8 vf;
#pragma unroll
                for (int e = 0; e < 4; ++e) { vf[e] = va[e]; vf[4 + e] = vb[e]; }
                O[dt] = __builtin_amdgcn_mfma_f32_16x16x32_f16(vf, pf, O[dt], 0, 0, 0); }
        }
#pragma unroll
        for (int dt = 0; dt < 4; ++dt) { u32x2 o; o.x = pk2h(O[dt][0] * rsum, O[dt][1] * rsum); o.y = pk2h(O[dt][2] * rsum, O[dt][3] * rsum);
            *(u32x2*)(Q + qrow + 16 * dt + 4 * fq) = o; }
        AT_BAR();
    }
}

template <int NT, int MODE, int CB = 0>
__device__ __forceinline__ void ctx_gemm(Frame& F, const f16* A, int lda, const f16* Bt, int K, const pg8::Epi& E) {
    constexpr int KC = 256, PITCH = KC * 2 + 16, NROWS = 32 + 16 * NT, NLD = NROWS / 16;
    LAS unsigned char* SM = F.lds;
    const int w = F.wave, rt = w >> 2, kq = w & 3;
    for (int tile = blockIdx.x; tile < 256; tile += F.G) {
        int l_ = F.lane; asm volatile("" : "+v"(l_));
        const int l = l_, fr = l & 15, fq = l >> 4, tid = w * 64 + l;
        const int rb = tile & 15, cb = tile >> 4;
        const int row = MLAT + rb * 32 + 16 * rt + fr;
        const f16* src[NLD];
#pragma unroll
        for (int it = 0; it < NLD; ++it) { const int q = it * 512 + tid, srow = q >> 5, c16 = q & 31;
            if (srow < 32) src[it] = A + (size_t)(MLAT + rb * 32 + srow) * lda + c16 * 8;
            else { const int j = srow - 32; int brow;
                if (MODE == 3) { const int jj = cb * 64 + 16 * ((j >> 4) & 3) + (j & 15); brow = (jj >> 7) * 256 + (jj & 127) + ((j >> 4) >= 4 ? 128 : 0); }
                else brow = CB + cb * (16 * NT) + j;
                src[it] = Bt + (size_t)brow * K + c16 * 8; } }
        f32x4 fin[NT / 4];
#pragma unroll
        for (int i = 0; i < NT / 4; ++i) fin[i] = (f32x4){0.f, 0.f, 0.f, 0.f};
        u32x4 tr[NLD];
#pragma unroll
        for (int it = 0; it < NLD; ++it) tr[it] = *(const u32x4*)src[it];
        for (int kc = 0; kc < K; kc += KC) {
            __syncthreads();
#pragma unroll
            for (int it = 0; it < NLD; ++it) { const int q = it * 512 + tid; *(LAS u32x4*)(SM + (q >> 5) * PITCH + (q & 31) * 16) = tr[it]; }
            __syncthreads();
            if (kc + KC < K) {
#pragma unroll
                for (int it = 0; it < NLD; ++it) tr[it] = *(const u32x4*)(src[it] + kc + KC);
            }
#pragma unroll
            for (int ks = 0; ks < KC / 32; ++ks) { const f16x8 av = *(const LAS f16x8*)(SM + (16 * rt + fr) * PITCH + ks * 64 + 16 * fq);
#pragma unroll
                for (int i = 0; i < NT / 4; ++i) { const f16x8 bv = *(const LAS f16x8*)(SM + (32 + 16 * (kq + 4 * i) + fr) * PITCH + ks * 64 + 16 * fq);
                    fin[i] = __builtin_amdgcn_mfma_f32_16x16x32_f16(bv, av, fin[i], 0, 0, 0); } }
        }
        if (MODE == 0) {
            const float rinv = __builtin_amdgcn_rsqf(E.ss[row] * (1.0f / 1024.0f) + 1e-6f);
#pragma unroll
            for (int i = 0; i < NT / 4; ++i) { int col = CB + cb * (16 * NT) + 16 * (kq + 4 * i) + 4 * fq; f16* base = E.O16;
                const f32x4 v = fin[i] * rinv + *(const f32x4*)(E.bias + 2 * 5632 + col);
                if (E.split_cols) { const int t = col / E.split_cols; base += (size_t)t * E.split_stride; col -= t * E.split_cols; }
                u32x2 o; o.x = pk2h(v[0], v[1]); o.y = pk2h(v[2], v[3]);
                *(u32x2*)(base + (size_t)row * E.ldo + col) = o; }
        } else {
            const int col = cb * 64 + 16 * kq + 4 * fq; const size_t off = (size_t)row * D + col;
            const f32x4 xs = *(const f32x4*)(E.Xs + off); f32x4 xn;
            if (MODE == 2) { const f32x4 gv = *(const f32x4*)(E.gate + 2 * 9216 + col) * E.coef; xn = xs + gv * fin[0]; }
            else { const f32x4 gv = *(const f32x4*)(E.gate + 2 * 9216 + col);
#pragma unroll
                for (int e = 0; e < 4; ++e) xn[e] = xs[e] + gv[e] * fin[0][e] * sigmoidf_(fin[NT / 4 - 1][e]); }
            *(f32x4*)(E.Xd + off) = xn;
            if (E.An) { const f32x4 a0 = xn * *(const f32x4*)(E.gsn + 2 * 1024 + col);
                u32x2 o; o.x = pk2h(a0[0], a0[1]); o.y = pk2h(a0[2], a0[3]);
                *(u32x2*)(E.An + off) = o;
                float sq = (xn[0] * xn[0] + xn[1] * xn[1]) + (xn[2] * xn[2] + xn[3] * xn[3]);
                sq += __shfl_xor(sq, 16); sq += __shfl_xor(sq, 32); if (fq == 0) atomicAdd(E.ssn + row, sq); }
        }
        __syncthreads();
    }
}

#define XB_TMO      128
#define XB_XCNT(j)  (256  + 64 * (j))
#define XB_XSUB(j)  (1280 + 64 * (j))
#define XB_XGEN(j)  (2304 + 64 * (j))
#define XB_TOP      3328
#define XB_TOPGEN   3392
#define XCD_BAR_WORDS 3456
#define XB_SPIN_CAP (1u << 18)

__device__ __forceinline__ unsigned xb_ld(unsigned* p)              { return __hip_atomic_load(p, __ATOMIC_RELAXED, __HIP_MEMORY_SCOPE_AGENT); }
__device__ __forceinline__ unsigned xb_add(unsigned* p, unsigned v) { return __hip_atomic_fetch_add(p, v, __ATOMIC_RELAXED, __HIP_MEMORY_SCOPE_AGENT); }
__device__ __forceinline__ unsigned xb_xcc_id() { return (unsigned)__builtin_amdgcn_s_getreg((3 << 11) | 20) & 0xFu; }
#define XB_SPIN(cond, bar) do { unsigned _sp = 0; while (cond) { __builtin_amdgcn_s_sleep(1); \
    if ((++_sp & 255u) == 0u) { if (xb_ld(&(bar)[XB_TMO])) break; if (_sp > XB_SPIN_CAP) { atomicAdd(&(bar)[XB_TMO], 1u); break; } } } } while (0)

struct XcdBarrier {
    unsigned* bar; unsigned x;
    volatile LAS unsigned* st;
};

__device__ __forceinline__ XcdBarrier xcd_barrier_post(unsigned* bar, volatile LAS unsigned* st) {
    XcdBarrier b; b.bar = bar; b.x = xb_xcc_id(); b.st = st;
    if (threadIdx.x == 0) (void)xb_add(&bar[XB_XCNT(b.x)], 1u);
    return b;
}
__device__ __forceinline__ void xcd_barrier_complete(unsigned* bar, unsigned x, unsigned& nloc, unsigned& nx) {
    const unsigned G = gridDim.x * gridDim.y * gridDim.z;
    unsigned sum, cnt, mine, sp = 0u;
    for (;;) {
        sum = 0u; cnt = 0u; mine = 0u;
#pragma unroll
        for (unsigned j = 0; j < 16; ++j) { const unsigned c = xb_ld(&bar[XB_XCNT(j)]); sum += c; cnt += (c > 0u) ? 1u : 0u; mine = (j == x) ? c : mine; }
        if (sum == G) break;
        __builtin_amdgcn_s_sleep(1);
        if ((++sp & 255u) == 0u) { if (xb_ld(&bar[XB_TMO])) break; if (sp > XB_SPIN_CAP) { atomicAdd(&bar[XB_TMO], 1u); break; } }
    }
    nloc = mine > 0u ? mine : 1u; nx = cnt > 0u ? cnt : 1u;
}

__device__ __forceinline__ void xcd_barrier(const XcdBarrier& b) {
    asm volatile("s_waitcnt vmcnt(0)" ::: "memory");
    __syncthreads();
    if (threadIdx.x == 0) {
        unsigned* bar = b.bar;
        __builtin_amdgcn_s_waitcnt(0);
        unsigned nloc = b.st[0], nx = b.st[1];
        if (nloc == 0u) { xcd_barrier_complete(bar, b.x, nloc, nx); b.st[0] = nloc; b.st[1] = nx; }
        const unsigned old = xb_add(&bar[XB_XSUB(b.x)], 1u);
        const unsigned gen = old / nloc;
        if (old + 1u == (gen + 1u) * nloc) {
            __builtin_amdgcn_fence(__ATOMIC_RELEASE, "agent");
            asm volatile("s_waitcnt vmcnt(0)" ::: "memory");
            const unsigned og = xb_add(&bar[XB_TOP], 1u);
            const unsigned tg = og / nx;
            if (og + 1u == (tg + 1u) * nx) xb_add(&bar[XB_TOPGEN], 1u);
            else XB_SPIN(xb_ld(&bar[XB_TOPGEN]) == tg, bar);
            __builtin_amdgcn_fence(__ATOMIC_ACQUIRE, "agent");
            xb_add(&bar[XB_XGEN(b.x)], 1u);
            asm volatile("s_waitcnt vmcnt(0)" ::: "memory");
        } else {
            XB_SPIN(xb_ld(&bar[XB_XGEN(b.x)]) == gen, bar);
            __builtin_amdgcn_fence(__ATOMIC_ACQUIRE, "agent");
            asm volatile("s_waitcnt vmcnt(0)" ::: "memory");
        }
    }
    __syncthreads();
}

__global__ void __launch_bounds__(512, 2) fwd_megakernel(Args args) {
    extern __shared__ __attribute__((aligned(16))) unsigned char lds_raw[];
    Frame F;
    F.lds = (LAS unsigned char*)lds_raw;
    F.tid = threadIdx.x; F.lane = F.tid & 63; F.wave = __builtin_amdgcn_readfirstlane(F.tid >> 6);
    F.G = gridDim.x; { const int bx = blockIdx.x; F.vcu = (F.G % 8 == 0) ? (bx % 8) * (F.G / 8) + bx / 8 : bx; }
    unsigned char* ws = args.ws;
    float* MOD = (float*)(ws + WS_MOD); float* X = (float*)(ws + WS_X); f16* H16 = (f16*)(ws + WS_H16); f16* HID = (f16*)(ws + WS_HID);
    const float* norm_g = args.in[4];
    cg::grid_group grid = cg::this_grid();
    volatile LAS unsigned* bst = (volatile LAS unsigned*)(F.lds + LDS_BYTES - 16);
    if (F.tid < 4) bst[F.tid] = 0u;
    __syncthreads();
    XcdBarrier xbar = xcd_barrier_post((unsigned*)(ws + WS_BAR), bst);

    const int lo = args.ph_lo, hi = args.ph_hi;
    if (hi > (1 << 20)) grid.sync();
#define IN(k) (lo <= (k) && (k) < hi)
#define SEAM(k) do { if (IN(k) && IN((k) + 1)) xcd_barrier(xbar); asm volatile("" : "+v"(F.tid), "+v"(F.lane)); } while (0)
#define RUN_GEMM(Ap, Bp, Mr, Nc, Kc) do { pg8::Gemm g{(const u16*)(Ap), (const u16*)(Bp), (Mr), (Nc), (Kc)}; pg8::StaticOrder S; S.init(g.M, g.N, F.G, (int)blockIdx.x); pg8::gemm_phase(F.lds, g, S, E); } while (0)
#define CONV_TAIL(job) do { const int rem_ = (66 * 22) % F.G; \
        if (rem_ == 0) conv_job(F, args, (job), F.vcu * 8 + F.wave, F.G * 8); \
        else if ((int)blockIdx.x >= rem_) conv_job(F, args, (job), ((int)blockIdx.x - rem_) * 8 + F.wave, (F.G - rem_) * 8); } while (0)
#define SSP(sl) ((float*)(ws + WS_SS) + (size_t)(sl) * MALL)
#define GSP(sl) ((const float*)(ws + WS_GS) + (sl) * 3072)
#define BIASP(sl) ((const float*)(ws + WS_BIAS) + (sl) * 3 * 5632)
#define EPI_F16(dst, ld, sc, sst, sl) pg8::Epi E{(dst), (sst), nullptr, nullptr, nullptr, SSP(sl), BIASP(sl), nullptr, nullptr, nullptr, 0, (ld), (sc), 0.f}
#define EPI_SWIGLU(sl) pg8::Epi E{HID, 0, nullptr, nullptr, nullptr, SSP(sl), BIASP(sl), nullptr, nullptr, nullptr, 1, FH, 0, 0.f}
#define EPI_RES(md, dst, gt, cf, nsl) pg8::Epi E{nullptr, 0, X, (dst), (gt), nullptr, nullptr, (nsl) >= 0 ? H16 : nullptr, GSP((nsl) >= 0 ? (nsl) : 0), SSP((nsl) >= 0 ? (nsl) : 0), (md), 0, 0, (cf)}
    if (IN(0)) { p0_phase(F, args); } SEAM(0);
    if (IN(1)) { p1_phase(F, args); } SEAM(1);
    if (IN(2)) { EPI_SWIGLU(0); RUN_GEMM(H16, ws + WS_WFI + 0 * WFI_SZ, MALL, 5632, 1024); CONV_TAIL(1); } SEAM(2);
#if REP_FFNIN > 1
    if (IN(2)) { EPI_SWIGLU(0); RUN_GEMM(H16, ws + WS_WFI + 0 * WFI_SZ, MALL, 5632, 1024); } SEAM(2);
#endif
    if (IN(3)) { EPI_RES(2, X, MOD + 0 * 3072 + 2048, 0.5f, 1); RUN_GEMM(HID, ws + WS_WFO + 0 * WFO_SZ, MLAT, 1024, FH); ctx_gemm<4, 2>(F, HID, FH, (const f16*)(ws + WS_WFO + 0 * WFO_SZ), FH, E); bias_rows(F, args, 1, 2); } SEAM(3);
    if (IN(5)) { EPI_F16((f16*)(ws + WS_U16), D, 0, 0, 1); RUN_GEMM(H16, ws + WS_WSI, MLAT, 1024, 1024); ctx_gemm<4, 0>(F, H16, D, (const f16*)(ws + WS_WSI), 1024, E); } SEAM(5);
    if (IN(6)) { s5_pass<false>(F, ws, args.in[17]); } SEAM(6);
#if REP_S5 == 2
    if (IN(6)) { s5_pass<false>(F, ws, args.in[17]); } SEAM(6);
#endif
    if (IN(7)) { s5_carry(F, ws); } SEAM(7);
    if (IN(8)) { s5_pass<true>(F, ws, args.in[17]); } SEAM(8);
#if REP_S5 == 4
    if (IN(8)) { s5_pass<true>(F, ws, args.in[17]); } SEAM(8);
#endif
    if (IN(9)) { EPI_RES(3, X, MOD + 1 * 3072 + 2048, 1.f, 2); RUN_GEMM(ws + WS_G16, ws + WS_WGLU, MLAT, 2048, 1024); ctx_gemm<8, 3>(F, (const f16*)(ws + WS_G16), D, (const f16*)(ws + WS_WGLU), 1024, E); } SEAM(9);
    if (IN(11)) { EPI_SWIGLU(2); RUN_GEMM(H16, ws + WS_WFI + 1 * WFI_SZ, MALL, 5632, 1024); CONV_TAIL(2); } SEAM(11);
    if (IN(12)) { EPI_RES(2, X, MOD + 2 * 3072 + 2048, 0.5f, 3); RUN_GEMM(HID, ws + WS_WFO + 1 * WFO_SZ, MLAT, 1024, FH); ctx_gemm<4, 2>(F, HID, FH, (const f16*)(ws + WS_WFO + 1 * WFO_SZ), FH, E); bias_rows(F, args, 3, 4); } SEAM(12);
    if (IN(14)) { EPI_SWIGLU(3); RUN_GEMM(H16, ws + WS_WFI + 2 * WFI_SZ, MALL, 5632, 1024); CONV_TAIL(3); } SEAM(14);
    if (IN(15)) { EPI_RES(2, X, MOD + 3 * 9216 + 0 * 3072 + 2048, 0.5f, 4); RUN_GEMM(HID, ws + WS_WFO + 2 * WFO_SZ, MLAT, 1024, FH); ctx_gemm<4, 2>(F, HID, FH, (const f16*)(ws + WS_WFO + 2 * WFO_SZ), FH, E); bias_rows(F, args, 5, 5); } SEAM(15);
    if (IN(17)) { EPI_F16((f16*)(ws + WS_Q16), D, 1024, (size_t)MALL * D, 4); RUN_GEMM(H16, ws + WS_WQKV, MLAT, 3072, 1024); ctx_gemm<8, 0, 1024>(F, H16, D, (const f16*)(ws + WS_WQKV), 1024, E); } SEAM(17);
    if (IN(19)) { attn_phase(F, ws, args.in[22], args.in[20], args.in[21]); } SEAM(19);
#if REP_ATTN > 1
    if (IN(19)) { attn_phase(F, ws, args.in[22], args.in[20], args.in[21]); } SEAM(19);
#endif
    if (IN(20)) { EPI_RES(2, X, MOD + 3 * 9216 + 1 * 3072 + 2048, 1.f, 5); RUN_GEMM(ws + WS_Q16, ws + WS_WO, MLAT, 1024, 1024); } SEAM(20);
    if (IN(22)) { EPI_SWIGLU(5); RUN_GEMM(H16, ws + WS_WFI + 3 * WFI_SZ, MLAT, 5632, 1024); } SEAM(22);
    if (IN(23)) { EPI_RES(2, args.out, MOD + 3 * 9216 + 2 * 3072 + 2048, 0.5f, -1); RUN_GEMM(HID, ws + WS_WFO + 3 * WFO_SZ, MLAT, 1024, FH); }
}

extern "C" void kernel_launch(void* const* d_in, const int* in_sizes, int n_in, void* d_out, int out_size, void* d_ws, size_t ws_size, hipStream_t stream) {
    static int grid = 0;
    if (grid == 0) {
        if (n_in != 24 || ws_size < WS_END) { fprintf(stderr, "kernel_launch: unexpected n_in %d or ws_size %zu (< %zu)\n", n_in, ws_size, (size_t)WS_END); grid = -1; return; }
        int dev = 0, cus = 0, per_cu = 0;
        hipGetDevice(&dev); hipDeviceGetAttribute(&cus, hipDeviceAttributeMultiprocessorCount, dev);
        if (hipFuncSetAttribute((const void*)fwd_megakernel, hipFuncAttributeMaxDynamicSharedMemorySize, LDS_BYTES) != hipSuccess) { fprintf(stderr, "kernel_launch: hipFuncSetAttribute failed\n"); }
        if (hipOccupancyMaxActiveBlocksPerMultiprocessor(&per_cu, (const void*)fwd_megakernel, 512, LDS_BYTES) != hipSuccess || per_cu < 1) { fprintf(stderr, "kernel_launch: occupancy query says %d\n", per_cu); per_cu = 1; }
        (void)hipGetLastError();
        grid = cus * 1;
        if (grid <= 0) grid = 256;
    }
    if (grid < 0) return;
    hipMemsetAsync((char*)d_ws + WS_MOD, 0, MOD_BYTES, stream);
    Args a{};
    for (int i = 0; i < 24; ++i) a.in[i] = (const float*)d_in[i];
    a.out = (float*)d_out; a.ws = (unsigned char*)d_ws;
#if MK_COOP
    a.ph_lo = 0; a.ph_hi = NPHASE;
    void* kargs[] = {&a};
    hipError_t e = hipLaunchCooperativeKernel((const void*)fwd_megakernel, dim3(grid), dim3(512), kargs, LDS_BYTES, stream);
    if (e != hipSuccess) fprintf(stderr, "cooperative launch failed: %s (grid %d)\n", hipGetErrorString(e), grid);
#else
    for (int ph = 0; ph < NPHASE; ++ph) {
        a.ph_lo = ph; a.ph_hi = ph + 1;
        hipLaunchKernelGGL(fwd_megakernel, dim3(grid), dim3(512), LDS_BYTES, stream, a);
    }
#endif
}
```

```cpp
#include <hip/hip_runtime.h>
#include <hip/hip_cooperative_groups.h>
#include <cstdio>
#include <cstdint>
namespace cg = cooperative_groups;

#ifndef REP_S5
#define REP_S5 1
#endif
#ifndef REP_ATTN
#define REP_ATTN 1
#endif
#ifndef REP_FFNIN
#define REP_FFNIN 1
#endif
#ifndef REP_NORM
#define REP_NORM 1
#endif
#ifndef REP_CONV
#define REP_CONV 1
#endif
#ifndef MK_COOP
#define MK_COOP 1
#endif

#define LAS __attribute__((address_space(3)))
typedef _Float16 f16;
typedef f16 f16x8 __attribute__((ext_vector_type(8)));
typedef f16 f16x4 __attribute__((ext_vector_type(4)));
typedef f16 f16x2 __attribute__((ext_vector_type(2)));
typedef float f32x4 __attribute__((ext_vector_type(4)));
typedef float f32x2 __attribute__((ext_vector_type(2)));
typedef unsigned u32x4 __attribute__((ext_vector_type(4)));
typedef unsigned u32x2 __attribute__((ext_vector_type(2)));
typedef unsigned short u16;

constexpr int D = 1024, SEQ = 8192, NB = 2, CTX = 256, FH = 2816;
constexpr int MLAT = NB * SEQ;
constexpr int MALL = MLAT + NB * CTX;
constexpr int NCH = 132;
constexpr float EPS = 1e-6f;

constexpr size_t MiB = 1u << 20;
constexpr size_t WS_MOD = 0;
constexpr size_t MOD_BYTES = 262144;
constexpr size_t WS_BAR = 229376;
constexpr size_t WS_LAM = 262144;
constexpr size_t WS_LAMT = WS_LAM + 65536;
constexpr size_t WS_BMAT = WS_LAMT + 65536;
constexpr size_t WS_CMAT = WS_BMAT + 524288;
constexpr size_t WS_WFI = 2 * MiB;
constexpr size_t WFI_SZ = (size_t)5632 * 1024 * 2;
constexpr size_t WS_WFO = WS_WFI + 4 * WFI_SZ;
constexpr size_t WFO_SZ = (size_t)1024 * 2816 * 2;
constexpr size_t WS_WSI = WS_WFO + 4 * WFO_SZ;
constexpr size_t WS_WGLU = WS_WSI + 2 * MiB;
constexpr size_t WS_WQKV = WS_WGLU + 4 * MiB;
constexpr size_t WS_WO = WS_WQKV + 6 * MiB;
constexpr size_t WS_X = 82 * MiB;
constexpr size_t WS_H16 = 148 * MiB;
constexpr size_t WS_R = 181 * MiB;
constexpr size_t WS_HID = WS_R;
constexpr size_t WS_U16 = WS_R;
constexpr size_t WS_G16 = WS_R + 33 * MiB;
constexpr size_t WS_E = WS_R + 66 * MiB;
constexpr size_t WS_CIN = WS_R + 83 * MiB;
constexpr size_t WS_Q16 = WS_R;
constexpr size_t WS_K16 = WS_R + 33 * MiB;
constexpr size_t WS_V16 = WS_R + 66 * MiB;
constexpr size_t WS_VT = WS_R + 99 * MiB;
constexpr size_t WS_VTC = WS_R + 131 * MiB;
constexpr size_t WS_SS = WS_CMAT + 524288;
constexpr size_t WS_GS = WS_SS + (size_t)6 * 16896 * 4;
constexpr size_t WS_BIAS = 313 * MiB;
constexpr size_t WS_END = 314 * MiB;
static_assert(WS_GS + 6 * 3 * 1024 * 4 <= 2 * MiB, "small tables below the weights");
static_assert(WS_WO + 2 * MiB == WS_X, "weights end at X");

constexpr int LDS_BYTES = 163840;
constexpr int NPHASE = 24;

namespace pg8 {
constexpr int BM = 256, BK = 64, HALF = 128, HTB = HALF * BK * 2, STAGE_BYTES = 8 * HTB, NXCD = 8, WGM = 8;
__host__ __device__ __forceinline__ int lds_byte(int r, int c) { const int st = (r >> 4) * 2 + (c >> 5), rr = r & 15, cc = c & 31, ob = rr * 64 + cc * 2; return st * 1024 + (ob ^ (((ob >> 9) & 1) << 5)); }
__host__ __device__ __forceinline__ void stage_rc(int b, int& R, int& C) { const int st = b / 1024, sb = b % 1024, swz = sb ^ (((sb >> 9) & 1) << 5); R = (st >> 1) * 16 + swz / 64; C = (st & 1) * 32 + (swz % 64) / 2; }
__host__ __device__ __forceinline__ int perm32(int rho) { const int n = rho >> 4, i = rho & 15; return 8 * (i >> 2) + 4 * n + (i & 3); }

struct Unit { int pm, pn; };
struct Gemm { const u16* A; const u16* Bt; int M, N, K; };

struct StaticOrder {
    int nM, nN, nwg, G, c;
    __device__ void init(int M, int N, int G_, int c_) { nM = M / BM; nN = N / BM; nwg = nM * nN; G = G_; c = c_; }
    __device__ bool next(int i, Unit& u) const {
        const long L = (long)i * G + c; if (L >= nwg) return false;
        int wgid = (int)L; { const int q = nwg / NXCD, r = nwg % NXCD, xcd = wgid % NXCD, off = wgid / NXCD; wgid = (xcd < r ? xcd * (q + 1) : r * (q + 1) + (xcd - r) * q) + off; }
        const int nig = WGM * nN, gid = wgid / nig, fm = gid * WGM, gsz = (nM - fm) < WGM ? (nM - fm) : WGM;
        u.pm = fm + ((wgid % nig) % gsz); u.pn = (wgid % nig) / gsz; return true;
    }
};

__device__ __forceinline__ unsigned pk2h(float a, float b) { f16x2 v; v.x = (f16)a; v.y = (f16)b; return __builtin_bit_cast(unsigned, v); }
__device__ __forceinline__ float sigmoidf_(float x) { return __builtin_amdgcn_rcpf(1.0f + __expf(-x)); }

struct Epi {
    static constexpr bool PERM = true;
    f16* O16; size_t split_stride;
    const float* Xs; float* Xd; const float* gate;
    const float* ss; const float* bias;
    f16* An; const float* gsn; float* ssn;
    int mode;
    int ldo; int split_cols; float coef;
    __device__ __forceinline__ void operator()(const f32x4 (&acc)[2][2][4][2], const Unit& u, int wr, int wc, int fr, int fq) const {
        const int row0 = u.pm * BM + wr * 64 + fr;
        const int rowt = u.pm * BM; const int mi = rowt < SEQ ? 0 : (rowt < MLAT ? 1 : 2);
        if (mode == 0) {
            int colt = u.pn * BM; f16* base = O16;
            const float* bp = bias + mi * 5632 + colt + wc * 32 + 8 * fq;
            if (split_cols) { const int t = colt / split_cols; base += (size_t)t * split_stride; colt -= t * split_cols; }
            const int col0 = colt + wc * 32 + 8 * fq;
            f32x4 bv[2][2];
#pragma unroll
            for (int bj = 0; bj < 2; ++bj)
#pragma unroll
                for (int n = 0; n < 2; ++n) bv[bj][n] = *(const f32x4*)(bp + bj * HALF + 4 * n);
#pragma unroll
            for (int ai = 0; ai < 2; ++ai)
#pragma unroll
                for (int m = 0; m < 4; ++m) { const int row = row0 + ai * HALF + m * 16; f16* rowp = base + (size_t)row * ldo + col0;
                    const float rinv = __builtin_amdgcn_rsqf(ss[row] * (1.0f / 1024.0f) + 1e-6f);
#pragma unroll
                    for (int bj = 0; bj < 2; ++bj) { const f32x4 v0 = acc[ai][bj][m][0] * rinv + bv[bj][0], v1 = acc[ai][bj][m][1] * rinv + bv[bj][1];
                        u32x4 w; w.x = pk2h(v0[0], v0[1]); w.y = pk2h(v0[2], v0[3]); w.z = pk2h(v1[0], v1[1]); w.w = pk2h(v1[2], v1[3]);
                        *(u32x4*)(rowp + bj * HALF) = w; } }
        } else if (mode == 1) {
            const int col0 = u.pn * HALF + wc * 32 + 8 * fq;
            const float* bp = bias + mi * 5632 + u.pn * BM + wc * 32 + 8 * fq;
            f32x4 bv[2][2];
#pragma unroll
            for (int bj = 0; bj < 2; ++bj)
#pragma unroll
                for (int n = 0; n < 2; ++n) bv[bj][n] = *(const f32x4*)(bp + bj * HALF + 4 * n);
#pragma unroll
            for (int ai = 0; ai < 2; ++ai)
#pragma unroll
                for (int m = 0; m < 4; ++m) { const int row = row0 + ai * HALF + m * 16; f16* rowp = O16 + (size_t)row * ldo + col0;
                    const float rinv = __builtin_amdgcn_rsqf(ss[row] * (1.0f / 1024.0f) + 1e-6f);
                    float h[8];
#pragma unroll
                    for (int n = 0; n < 2; ++n)
#pragma unroll
                        for (int e = 0; e < 4; ++e) { const float g = acc[ai][0][m][n][e] * rinv + bv[0][n][e], up = acc[ai][1][m][n][e] * rinv + bv[1][n][e]; h[n * 4 + e] = g * sigmoidf_(g) * up; }
                    u32x4 w; w.x = pk2h(h[0], h[1]); w.y = pk2h(h[2], h[3]); w.z = pk2h(h[4], h[5]); w.w = pk2h(h[6], h[7]);
                    *(u32x4*)rowp = w; }
        } else {
            const float* gp = gate + mi * 9216;
            if (mode == 2) {
                const int col0 = u.pn * BM + wc * 32 + 8 * fq;
                f32x4 gv[2][2], gs[2][2];
#pragma unroll
                for (int bj = 0; bj < 2; ++bj)
#pragma unroll
                    for (int n = 0; n < 2; ++n) { gv[bj][n] = *(const f32x4*)(gp + col0 + bj * HALF + 4 * n) * coef;
                        gs[bj][n] = *(const f32x4*)(gsn + mi * 1024 + col0 + bj * HALF + 4 * n); }
#pragma unroll
                for (int ai = 0; ai < 2; ++ai) {
#pragma unroll
                  for (int mp = 0; mp < 2; ++mp) {
                    f32x4 xpre[4][2][2];
#pragma unroll
                    for (int m = 2 * mp; m < 2 * mp + 2; ++m)
#pragma unroll
                        for (int bj = 0; bj < 2; ++bj)
#pragma unroll
                            for (int n = 0; n < 2; ++n) xpre[m][bj][n] = *(const f32x4*)(Xs + (size_t)(row0 + ai * HALF + m * 16) * D + col0 + bj * HALF + 4 * n);
                    asm volatile("" ::: "memory");
#pragma unroll
                    for (int m = 2 * mp; m < 2 * mp + 2; ++m) { const int row = row0 + ai * HALF + m * 16; const size_t off = (size_t)row * D + col0; float sq = 0.f;
#pragma unroll
                        for (int bj = 0; bj < 2; ++bj) { f32x4 xn[2];
#pragma unroll
                            for (int n = 0; n < 2; ++n) { const f32x4 xs = xpre[m][bj][n];
                                xn[n] = xs + gv[bj][n] * acc[ai][bj][m][n];
                                *(f32x4*)(Xd + off + bj * HALF + 4 * n) = xn[n];
                                sq += (xn[n][0] * xn[n][0] + xn[n][1] * xn[n][1]) + (xn[n][2] * xn[n][2] + xn[n][3] * xn[n][3]); }
                            if (An) { const f32x4 a0 = xn[0] * gs[bj][0], a1 = xn[1] * gs[bj][1];
                                u32x4 w; w.x = pk2h(a0[0], a0[1]); w.y = pk2h(a0[2], a0[3]); w.z = pk2h(a1[0], a1[1]); w.w = pk2h(a1[2], a1[3]);
                                *(u32x4*)(An + off + bj * HALF) = w; } }
                        if (An) { sq += __shfl_xor(sq, 16); sq += __shfl_xor(sq, 32); if (fq == 0) atomicAdd(ssn + row, sq); } }
                  }
                }
            } else {
                const int col0 = u.pn * HALF + wc * 32 + 8 * fq;
                f32x4 gv[2], gs[2];
#pragma unroll
                for (int n = 0; n < 2; ++n) { gv[n] = *(const f32x4*)(gp + col0 + 4 * n); gs[n] = *(const f32x4*)(gsn + mi * 1024 + col0 + 4 * n); }
#pragma unroll
                for (int ai = 0; ai < 2; ++ai) {
                    f32x4 xpre[4][2];
#pragma unroll
                    for (int m = 0; m < 4; ++m)
#pragma unroll
                        for (int n = 0; n < 2; ++n) xpre[m][n] = *(const f32x4*)(Xs + (size_t)(row0 + ai * HALF + m * 16) * D + col0 + 4 * n);
                    asm volatile("" ::: "memory");
#pragma unroll
                    for (int m = 0; m < 4; ++m) { const int row = row0 + ai * HALF + m * 16; const size_t off = (size_t)row * D + col0; float sq = 0.f; f32x4 xn[2];
#pragma unroll
                        for (int n = 0; n < 2; ++n) { const f32x4 xs = xpre[m][n]; const f32x4 a = acc[ai][0][m][n], b = acc[ai][1][m][n];
#pragma unroll
                            for (int e = 0; e < 4; ++e) xn[n][e] = xs[e] + gv[n][e] * a[e] * sigmoidf_(b[e]);
                            *(f32x4*)(Xd + off + 4 * n) = xn[n];
                            sq += (xn[n][0] * xn[n][0] + xn[n][1] * xn[n][1]) + (xn[n][2] * xn[n][2] + xn[n][3] * xn[n][3]); }
                        const f32x4 a0 = xn[0] * gs[0], a1 = xn[1] * gs[1];
                        u32x4 w; w.x = pk2h(a0[0], a0[1]); w.y = pk2h(a0[2], a0[3]); w.z = pk2h(a1[0], a1[1]); w.w = pk2h(a1[2], a1[3]);
                        *(u32x4*)(An + off) = w;
                        sq += __shfl_xor(sq, 16); sq += __shfl_xor(sq, 32); if (fq == 0) atomicAdd(ssn + row, sq); }
                }
            }
        }
    }
};

__device__ __forceinline__ void gemm_phase(LAS unsigned char* lds, const Gemm g, const StaticOrder& S, const Epi& E) {
    int tid_ = threadIdx.x; asm volatile("" : "+v"(tid_));
    const int tid = tid_, wid = __builtin_amdgcn_readfirstlane(tid >> 6), lane = tid & 63, wr = wid >> 2, wc = wid & 3, fr = lane & 15, fq = lane >> 4;
    const int K = g.K, nt = K / BK;
    unsigned voffA[2], voffB[2];
#pragma unroll
    for (int i = 0; i < 2; ++i) { int R, C; stage_rc(tid * 16 + i * 8192, R, C); const int Rb = Epi::PERM ? ((R & ~31) + perm32(R & 31)) : R;
        voffA[i] = (unsigned)(R * K + C) * 2u; voffB[i] = (unsigned)(Rb * K + C) * 2u; }
    const size_t kstep = (size_t)(BK * 2);
    const size_t hstep = (size_t)HALF * K * 2;
    const size_t tstep = 2 * hstep;
    const unsigned ldsw = (unsigned)wid * 1024u;
    const int aoff = lds_byte(wr * 64 + fr, fq * 8), boff = lds_byte(wc * 32 + fr, fq * 8);
#define PG8_SA(b, h) (((b) * 2 + (h)) * HTB)
#define PG8_SB(b, h) ((4 + (b) * 2 + (h)) * HTB)
#define PG8_STAGE(bufoff, gbase, voff) do { _Pragma("unroll") for (int _i = 0; _i < 2; ++_i) \
        __builtin_amdgcn_global_load_lds((const unsigned*)((const char*)(gbase) + (voff)[_i]), (LAS unsigned*)(lds + (bufoff) + ldsw + _i * 8192), 16, 0, 0); } while (0)
#define PG8_LDA(dst, b, h) do { _Pragma("unroll") for (int m = 0; m < 4; ++m) _Pragma("unroll") for (int k = 0; k < 2; ++k) dst[m][k] = *(const LAS f16x8*)(lds + PG8_SA(b, h) + aoff + m * 2048 + k * 1024); } while (0)
#define PG8_LDB(dst, b, h) do { _Pragma("unroll") for (int n = 0; n < 2; ++n) _Pragma("unroll") for (int k = 0; k < 2; ++k) dst[n][k] = *(const LAS f16x8*)(lds + PG8_SB(b, h) + boff + n * 2048 + k * 1024); } while (0)
#define PG8_MMA(ai, bj, At, Bt) do { __builtin_amdgcn_s_setprio(1); _Pragma("unroll") for (int m = 0; m < 4; ++m) _Pragma("unroll") for (int n = 0; n < 2; ++n) _Pragma("unroll") for (int k = 0; k < 2; ++k) \
        acc[ai][bj][m][n] = __builtin_amdgcn_mfma_f32_16x16x32_f16(Bt[n][k], At[m][k], acc[ai][bj][m][n], 0, 0, 0); __builtin_amdgcn_s_setprio(0); } while (0)
#define PG8_WAIT_V(n) asm volatile("s_waitcnt vmcnt(" #n ")" ::: "memory")
#define PG8_WAIT_L(n) asm volatile("s_waitcnt lgkmcnt(" #n ")" ::: "memory")
#define PG8_BAR __builtin_amdgcn_s_barrier()
#define PG8_SCHED __builtin_amdgcn_sched_barrier(0)
    Unit cur, nxt; int ui = 0;
    if (!S.next(0, cur)) return;
    f32x4 acc[2][2][4][2];
#pragma unroll
    for (int a = 0; a < 2; ++a)
#pragma unroll
        for (int b = 0; b < 2; ++b)
#pragma unroll
            for (int m = 0; m < 4; ++m)
#pragma unroll
                for (int n = 0; n < 2; ++n) acc[a][b][m][n] = (f32x4){0.f, 0.f, 0.f, 0.f};
    f16x8 At[4][2], B0[2][2], B1[2][2];
    const char* cA = (const char*)g.A + (size_t)cur.pm * tstep; const char* cB = (const char*)g.Bt + (size_t)cur.pn * tstep;
    PG8_STAGE(PG8_SB(0, 0), cB, voffB); PG8_STAGE(PG8_SB(0, 1), cB + hstep, voffB); PG8_STAGE(PG8_SA(0, 0), cA, voffA); PG8_STAGE(PG8_SA(0, 1), cA + hstep, voffA);
    if (wr == 1) PG8_BAR;
    PG8_WAIT_V(2); PG8_BAR;
    PG8_STAGE(PG8_SB(1, 0), cB + kstep, voffB); PG8_STAGE(PG8_SA(1, 0), cA + kstep, voffA); PG8_STAGE(PG8_SB(1, 1), cB + hstep + kstep, voffB);
    PG8_WAIT_V(6); PG8_BAR;
    for (;;) {
        const bool has_next = S.next(ui + 1, nxt);
        const char* nA = has_next ? (const char*)g.A + (size_t)nxt.pm * tstep : cA; const char* nB = has_next ? (const char*)g.Bt + (size_t)nxt.pn * tstep : cB;
        for (int t = 0; t < nt; t += 2) {
            const bool last = (t == nt - 2);
            const char* a1 = cA + (size_t)(t + 1) * kstep;
            const char* a2 = last ? nA : cA + (size_t)(t + 2) * kstep; const char* b2 = last ? nB : cB + (size_t)(t + 2) * kstep;
            const char* a3 = a2 + kstep; const char* b3 = b2 + kstep;
            PG8_LDB(B0, 0, 0); PG8_LDB(B1, 0, 1); PG8_SCHED; PG8_LDA(At, 0, 0); PG8_STAGE(PG8_SA(1, 1), a1 + hstep, voffA);
            PG8_WAIT_V(8); PG8_WAIT_L(0); PG8_BAR; PG8_MMA(0, 0, At, B0); PG8_MMA(0, 1, At, B1); PG8_BAR; PG8_SCHED;
            PG8_LDA(At, 0, 1); PG8_STAGE(PG8_SB(0, 0), b2, voffB); PG8_STAGE(PG8_SB(0, 1), b2 + hstep, voffB); PG8_STAGE(PG8_SA(0, 0), a2, voffA);
            PG8_WAIT_V(8); PG8_WAIT_L(0); PG8_BAR; PG8_MMA(1, 0, At, B0); PG8_MMA(1, 1, At, B1); PG8_BAR; PG8_SCHED;
            PG8_LDB(B0, 1, 0); PG8_LDB(B1, 1, 1); PG8_SCHED; PG8_LDA(At, 1, 0); PG8_STAGE(PG8_SA(0, 1), a2 + hstep, voffA);
            PG8_WAIT_V(8); PG8_WAIT_L(0); PG8_BAR; PG8_MMA(0, 0, At, B0); PG8_MMA(0, 1, At, B1); PG8_BAR; PG8_SCHED;
            PG8_LDA(At, 1, 1); PG8_STAGE(PG8_SB(1, 0), b3, voffB); PG8_STAGE(PG8_SB(1, 1), b3 + hstep, voffB); PG8_STAGE(PG8_SA(1, 0), a3, voffA);
            PG8_WAIT_V(8); PG8_WAIT_L(0); PG8_BAR; PG8_MMA(1, 0, At, B0); PG8_MMA(1, 1, At, B1); PG8_BAR; PG8_SCHED;
        }
        if (wr == 0) PG8_BAR;
        E(acc, cur, wr, wc, fr, fq);
        if (!has_next) break;
#pragma unroll
        for (int a = 0; a < 2; ++a)
#pragma unroll
            for (int b = 0; b < 2; ++b)
#pragma unroll
                for (int m = 0; m < 4; ++m)
#pragma unroll
                    for (int n = 0; n < 2; ++n) acc[a][b][m][n] = (f32x4){0.f, 0.f, 0.f, 0.f};
        cur = nxt; cA = nA; cB = nB; ++ui;
        if (wr == 1) PG8_BAR;
    }
    PG8_WAIT_V(0);
    PG8_BAR;
#undef PG8_SA
#undef PG8_SB
#undef PG8_STAGE
#undef PG8_LDA
#undef PG8_LDB
#undef PG8_MMA
#undef PG8_WAIT_V
#undef PG8_WAIT_L
#undef PG8_BAR
#undef PG8_SCHED
}
}
using pg8::pk2h;
using pg8::sigmoidf_;

#define LDS_WAIT() asm volatile("s_waitcnt lgkmcnt(0)" ::: "memory")
#define CFENCE() asm volatile("" ::: "memory")

struct Args {
    const float* in[24]; float* out; unsigned char* ws; int ph_lo, ph_hi;
};

struct Frame {
    LAS unsigned char* lds; int tid, lane, wave, vcu, G;
};

__device__ __forceinline__ float wave_sum(float v) {
#pragma unroll
    for (int o = 1; o < 64; o <<= 1) v += __shfl_xor(v, o);
    return v;
}

__device__ __forceinline__ void p0_transpose_item(const float* W, int K, int N, int half_n, f16* WT, LAS float* scr, int item, int lane) {
    const int nblk = N / 32, kb = item / nblk, nb = item % nblk, k0 = 64 * kb, n0 = 32 * nb;
    int d0 = n0;
    if (half_n) { const int j = n0 < half_n ? n0 : n0 - half_n; d0 = (j >> 7) * 256 + (n0 < half_n ? 0 : 128) + (j & 127); }
#pragma unroll 8
    for (int i = 0; i < 32; ++i) { const int kk = 2 * i + (lane >> 5); scr[kk * 33 + (lane & 31)] = W[(size_t)(k0 + kk) * N + n0 + (lane & 31)]; }
    LDS_WAIT();
    const int c = lane & 7;
#pragma unroll
    for (int j = 0; j < 4; ++j) { const int n = (lane >> 3) + 8 * j; const LAS float* s = scr + (8 * c) * 33 + n;
        u32x4 o; o.x = pk2h(s[0 * 33], s[1 * 33]); o.y = pk2h(s[2 * 33], s[3 * 33]); o.z = pk2h(s[4 * 33], s[5 * 33]); o.w = pk2h(s[6 * 33], s[7 * 33]);
        *(u32x4*)(WT + (size_t)(d0 + n) * K + k0 + 8 * c) = o; }
    LDS_WAIT();
}

__device__ __forceinline__ void dsincos(double r, double& s, double& c) {
    const double r2 = r * r; double ts = r, tc = 1.0; s = r; c = 1.0;
#pragma unroll
    for (int i = 1; i <= 14; ++i) { tc = -tc * r2 / (double)((2 * i - 1) * (2 * i)); c += tc; ts = -ts * r2 / (double)((2 * i) * (2 * i + 1)); s += ts; }
}
__device__ __forceinline__ double dexp_small(double x) {
    double t = 1.0, s = 1.0;
#pragma unroll
    for (int i = 1; i <= 14; ++i) { t = t * x / (double)i; s += t; }
    return s;
}

__device__ __forceinline__ void conv_job(Frame& F, const Args& a, int job, int worker, int nworkers) {
    unsigned char* ws = a.ws;
    LAS float* scr = (LAS float*)(F.lds + 8192 + F.wave * 16384);
    constexpr int I_FI = (1024 / 64) * (5632 / 32), I_FO = (2816 / 64) * (1024 / 32), I_SQ = 16 * 32, I_GLU = 16 * 64, I_QKV = 16 * 96;
    const int q = job == 0 ? 0 : (job == 1 ? 1 : (job == 2 ? 2 : 3));
    const int nextra = job == 1 ? I_SQ + I_GLU : (job == 2 ? I_QKV + I_SQ : 0);
    const int nitems = I_FI + I_FO + nextra;
    for (int it = worker; it < nitems; it += nworkers) {
        int r = it;
        if (r < I_FI) { p0_transpose_item(a.in[7] + (size_t)q * 1024 * 5632, 1024, 5632, 2816, (f16*)(ws + WS_WFI + q * WFI_SZ), scr, r, F.lane); continue; } r -= I_FI;
        if (r < I_FO) { p0_transpose_item(a.in[8] + (size_t)q * 2816 * 1024, 2816, 1024, 0, (f16*)(ws + WS_WFO + q * WFO_SZ), scr, r, F.lane); continue; } r -= I_FO;
        if (job == 1) {
            if (r < I_SQ) { p0_transpose_item(a.in[9], 1024, 1024, 0, (f16*)(ws + WS_WSI), scr, r, F.lane); continue; } r -= I_SQ;
            p0_transpose_item(a.in[18], 1024, 2048, 1024, (f16*)(ws + WS_WGLU), scr, r, F.lane);
        } else {
            if (r < I_QKV) { p0_transpose_item(a.in[19], 1024, 3072, 0, (f16*)(ws + WS_WQKV), scr, r, F.lane); continue; } r -= I_QKV;
            p0_transpose_item(a.in[23], 1024, 1024, 0, (f16*)(ws + WS_WO), scr, r, F.lane);
        }
    }
}
__device__ __forceinline__ void bias_rows(Frame& F, const Args& a, int sl_lo, int sl_hi) {
    unsigned char* ws = a.ws;
    const float* MOD = (const float*)(ws + WS_MOD); float* BIAS = (float*)(ws + WS_BIAS);
    const int gw = F.vcu * 8 + F.wave, NGW = F.G * 8;
    for (int sl = sl_lo; sl <= sl_hi; ++sl) {
        const int nrows = sl == 1 ? 1024 : (sl == 4 ? 3072 : 5632);
        const f16* Wt = sl == 0 ? (const f16*)(ws + WS_WFI) : sl == 1 ? (const f16*)(ws + WS_WSI) : sl == 2 ? (const f16*)(ws + WS_WFI + 1 * WFI_SZ)
                      : sl == 3 ? (const f16*)(ws + WS_WFI + 2 * WFI_SZ) : sl == 4 ? (const f16*)(ws + WS_WQKV) : (const f16*)(ws + WS_WFI + 3 * WFI_SZ);
        const int l = sl / 3, sb = sl % 3;
        for (int n = gw; n < nrows; n += NGW) {
            const f16x8 w0 = *(const f16x8*)(Wt + (size_t)n * D + 16 * F.lane), w1 = *(const f16x8*)(Wt + (size_t)n * D + 16 * F.lane + 8);
            float d[3];
#pragma unroll
            for (int mi = 0; mi < 3; ++mi) { const float* sh = MOD + (l * 3 + mi) * 9216 + sb * 3072 + 16 * F.lane; float acc = 0.f;
#pragma unroll
                for (int q = 0; q < 4; ++q) { const f32x4 sv = *(const f32x4*)(sh + 4 * q);
#pragma unroll
                    for (int e = 0; e < 4; ++e) { const int k = 4 * q + e; acc += sv[e] * (float)(k < 8 ? w0[k & 7] : w1[k & 7]); } }
                d[mi] = wave_sum(acc); }
            if (F.lane == 0) { BIAS[(sl * 3 + 0) * 5632 + n] = d[0]; BIAS[(sl * 3 + 1) * 5632 + n] = d[1]; BIAS[(sl * 3 + 2) * 5632 + n] = d[2]; }
        }
    }
}
__device__ __forceinline__ void p0_phase(Frame& F, const Args& a) {
    unsigned char* ws = a.ws;
    float* MOD = (float*)(ws + WS_MOD);
    {
        const float* cin = a.in[1]; const float* cctx = a.in[3]; const float* ada_w = a.in[5]; const float* ada_b = a.in[6];
        LAS float* red = (LAS float*)F.lds;
        const int c4 = F.lane & 15, ko = F.lane >> 4;
        for (int u = blockIdx.x; u < 576; u += F.G) {
            const int kh = u & 1, cgl = u >> 1, l = cgl / 144, cg = cgl % 144;
            const float* Wl = ada_w + (size_t)l * 1024 * 9216 + cg * 64 + c4 * 4;
            const int kbase = kh * 512 + F.wave * 64 + ko;
            float acc[3][4];
#pragma unroll
            for (int m = 0; m < 3; ++m)
#pragma unroll
                for (int e = 0; e < 4; ++e) acc[m][e] = 0.f;
#pragma unroll 4
            for (int i = 0; i < 16; ++i) { const int k = kbase + 4 * i; const f32x4 w = *(const f32x4*)(Wl + (size_t)k * 9216);
                const float c0 = cin[k], c1 = cin[1024 + k], c2 = cctx[k];
                const float s0 = c0 * sigmoidf_(c0), s1 = c1 * sigmoidf_(c1), s2 = c2 * sigmoidf_(c2);
#pragma unroll
                for (int e = 0; e < 4; ++e) { acc[0][e] += s0 * w[e]; acc[1][e] += s1 * w[e]; acc[2][e] += s2 * w[e]; } }
#pragma unroll
            for (int m = 0; m < 3; ++m)
#pragma unroll
                for (int e = 0; e < 4; ++e) { float v = acc[m][e]; v += __shfl_xor(v, 16); v += __shfl_xor(v, 32); acc[m][e] = v; }
            if (F.lane < 16) {
#pragma unroll
                for (int m = 0; m < 3; ++m)
#pragma unroll
                    for (int e = 0; e < 4; ++e) red[(F.wave * 3 + m) * 64 + c4 * 4 + e] = acc[m][e];
            }
            __syncthreads();
            if (F.tid < 192) { const int m = F.tid >> 6, col = F.tid & 63; float s = 0.f;
#pragma unroll
                for (int w = 0; w < 8; ++w) s += red[(w * 3 + m) * 64 + col];
                if (kh == 0) s += ada_b[l * 9216 + cg * 64 + col];
                atomicAdd(MOD + (size_t)(l * 3 + m) * 9216 + cg * 64 + col, s); }
            __syncthreads();
        }
    }
    conv_job(F, a, 0, F.vcu * 8 + F.wave, F.G * 8);
    { float* SS = (float*)(ws + WS_SS); for (int i = blockIdx.x * 512 + F.tid; i < 5 * MALL; i += F.G * 512) SS[MALL + i] = 0.f; }
    {
        const float* lam_re = a.in[10]; const float* lam_im = a.in[11]; const float* lstep = a.in[12];
        const float* b_re = a.in[13]; const float* b_im = a.in[14]; const float* c_re = a.in[15]; const float* c_im = a.in[16];
        float* Lam = (float*)(ws + WS_LAM); float* LamT = (float*)(ws + WS_LAMT); f16* Bm = (f16*)(ws + WS_BMAT); f16* Cm = (f16*)(ws + WS_CMAT);
        for (int idx = blockIdx.x * 512 + F.tid; idx < 8192; idx += F.G * 512) {
            const int p = idx & 63, g = (idx >> 6) & 63, dir = idx >> 12;
            const double lr = fmin((double)lam_re[idx], -1e-4), li = (double)lam_im[idx];
            const double dt = (double)expf(lstep[dir * 64 + g]);
            const double mag = dexp_small(lr * dt);
            double th = li * dt; const double twopi = 6.283185307179586476925287;
            th -= twopi * rint(th / twopi);
            double sn, cs; dsincos(th, sn, cs);
            const double ar = mag * cs, ai = mag * sn;
            const double den = lr * lr + li * li;
            const double cr = ((ar - 1.0) * lr + ai * li) / den, ci = (ai * lr - (ar - 1.0) * li) / den;
            Lam[idx * 2] = (float)ar; Lam[idx * 2 + 1] = (float)ai;
            double pr = ar, pi = ai;
#pragma unroll
            for (int q = 0; q < 6; ++q) { const double nr = pr * pr - pi * pi, ni = 2.0 * pr * pi; pr = nr; pi = ni; }
            LamT[idx * 2] = (float)pr; LamT[idx * 2 + 1] = (float)pi;
            const float* br = b_re + (size_t)idx * 16; const float* bi = b_im + (size_t)idx * 16;
            f16* bo = Bm + ((size_t)(g * 2 + dir) * 128 + 2 * p) * 16;
#pragma unroll
            for (int h = 0; h < 16; ++h) { bo[h] = (f16)br[h]; bo[16 + h] = (f16)bi[h]; }
#pragma unroll
            for (int h = 0; h < 16; ++h) {
                const double Cr = (double)c_re[((size_t)(dir * 64 + g) * 16 + h) * 64 + p], Ci = (double)c_im[((size_t)(dir * 64 + g) * 16 + h) * 64 + p];
                const double er = Cr * cr - Ci * ci, ei = Cr * ci + Ci * cr;
                f16* co = Cm + ((size_t)(g * 2 + dir) * 16 + h) * 128 + 2 * p;
                co[0] = (f16)(float)(er * 1024.0); co[1] = (f16)(float)(-ei * 1024.0);
            }
        }
    }
}

__device__ __forceinline__ void p1_phase(Frame& F, const Args& a) {
    unsigned char* ws = a.ws;
    const float* MOD = (const float*)(ws + WS_MOD); const float* norm_g = a.in[4];
    float* X = (float*)(ws + WS_X); f16* H16 = (f16*)(ws + WS_H16); float* SS = (float*)(ws + WS_SS); float* GS = (float*)(ws + WS_GS); float* BIAS = (float*)(ws + WS_BIAS);
    const int gw = F.vcu * 8 + F.wave, NGW = F.G * 8;
    for (int rowb = gw; rowb < MALL; rowb += 3 * NGW) {
        f32x4 v[3][4];
#pragma unroll
        for (int r = 0; r < 3; ++r) { const int row = rowb + r * NGW;
            if (row < MALL) { const float* xr = row < MLAT ? a.in[0] + (size_t)row * D : a.in[2] + (size_t)(row - MLAT) * D;
#pragma unroll
                for (int j = 0; j < 4; ++j) v[r][j] = *((const f32x4*)xr + F.lane + 64 * j); } }
        asm volatile("" ::: "memory");
#pragma unroll
        for (int r = 0; r < 3; ++r) { const int row = rowb + r * NGW;
            if (row < MALL) {
                const int mi = row < SEQ ? 0 : (row < MLAT ? 1 : 2);
                const float* sc = MOD + mi * 9216 + 1024;
                float sq = 0.f;
#pragma unroll
                for (int j = 0; j < 4; ++j) sq += (v[r][j].x * v[r][j].x + v[r][j].y * v[r][j].y) + (v[r][j].z * v[r][j].z + v[r][j].w * v[r][j].w);
                sq = wave_sum(sq);
                if (F.lane == 0) SS[row] = sq;
#pragma unroll
                for (int j = 0; j < 4; ++j) { const int col = 4 * (F.lane + 64 * j);
                    const f32x4 gg = *(const f32x4*)(norm_g + col), s1 = *(const f32x4*)(sc + col);
                    const f32x4 h = v[r][j] * gg * (s1 + 1.0f);
                    u32x2 w; w.x = pk2h(h.x, h.y); w.y = pk2h(h.z, h.w);
                    *(u32x2*)(H16 + (size_t)row * D + col) = w;
                    *(f32x4*)(X + (size_t)row * D + col) = v[r][j]; } } }
    }
    for (int i = blockIdx.x * 512 + F.tid; i < 6 * 3 * 1024; i += F.G * 512) { const int col = i & 1023, mi = (i >> 10) % 3, sl = i / 3072, l = sl / 3, sb = sl % 3;
        GS[i] = norm_g[sl * 1024 + col] * (1.0f + MOD[(l * 3 + mi) * 9216 + sb * 3072 + 1024 + col]); }
    bias_rows(F, a, 0, 0);
}

__device__ __forceinline__ void s5_unit_decode(int unit, int w, int& gq, int& c, int& b, int& g, int& rowbase) {
    gq = unit & 15; c = (unit >> 4) % NCH; b = unit / (16 * NCH); g = gq * 4 + (w >> 1);
    rowbase = c < 4 ? MLAT + b * CTX + 64 * c : b * SEQ + 64 * (c - 4);
}
template <bool P2>
__device__ __forceinline__ void s5_load_unit(int unit, int w, int dir, int l, const f16* U16, const f32x2* Cin, f16x4 (&af)[4], f32x2& st) {
    int gq, c, b, g, rowbase; s5_unit_decode(unit, w, gq, c, b, g, rowbase);
    const int fq = l >> 4, fr = l & 15;
#pragma unroll
    for (int s = 0; s < 4; ++s) af[s] = *(const f16x4*)(U16 + (size_t)(rowbase + 16 * (dir ? 3 - s : s) + fr) * D + 16 * g + 4 * fq);
    if (P2) st = Cin[((size_t)((dir * 2 + b) * NCH + c) * 64 + g) * 64 + l];
}
__device__ __forceinline__ float fma_s(float a, float b, float c) { float r; asm("v_fma_f32 %0, %1, %2, %3" : "=v"(r) : "v"(a), "v"(b), "v"(c)); return r; }
template <bool P2>
__device__ __forceinline__ void s5_pass(Frame& F, unsigned char* ws, const float* ssm_d) {
    int l_ = F.lane; asm volatile("" : "+v"(l_));
    const int w = F.wave, l = l_, fq = l >> 4, fr = l & 15;
    LAS float* W = (LAS float*)(F.lds + w * 8448);
    LAS f16* XS = (LAS f16*)(F.lds + 67584 + w * 4352);
    LAS float* YBall = (LAS float*)(F.lds + 67584 + 34816);
    LAS float* YB = YBall + w * 1024;
    const float* Lam = (const float*)(ws + WS_LAM); const f16* Bm = (const f16*)(ws + WS_BMAT); const f16* Cm = (const f16*)(ws + WS_CMAT);
    const f16* U16 = (const f16*)(ws + WS_U16); f16* G16 = (f16*)(ws + WS_G16);
    f32x2* Eb = (f32x2*)(ws + WS_E); const f32x2* Cin = (const f32x2*)(ws + WS_CIN);
    const int dir = w & 1;
    int wstep = dir ? -132 : 132, xstep = dir ? -136 : 136, w0 = dir ? 15 * 132 : 0, x0 = dir ? 15 * 136 : 0;
    asm volatile("" : "+s"(wstep), "+s"(xstep), "+s"(w0), "+s"(x0));
    const LAS float* Wl = W + w0 + 2 * l; LAS f16* XSl = XS + x0 + 2 * l;
    constexpr int NU = NB * NCH * 16;
    int gcur = -1; float ar = 0.f, ai = 0.f;
    f16x4 bf[8]; f16x8 cfr[4];
    f16x4 af[4], afn[4]; f32x2 st = (f32x2){0.f, 0.f}, stn = (f32x2){0.f, 0.f};
    int unit = blockIdx.x;
    if (unit < NU) s5_load_unit<P2>(unit, w, dir, l, U16, Cin, af, st);
    for (; unit < NU; unit += F.G) {
        int gq, c, b, g, rowbase; s5_unit_decode(unit, w, gq, c, b, g, rowbase);
        if (g != gcur) {
            gcur = g;
            ar = Lam[((dir * 64 + g) * 64 + l) * 2]; ai = Lam[((dir * 64 + g) * 64 + l) * 2 + 1];
#pragma unroll
            for (int j = 0; j < 8; ++j) bf[j] = *(const f16x4*)(Bm + ((size_t)(g * 2 + dir) * 128 + 16 * j + fr) * 16 + 4 * fq);
            if (P2) {
#pragma unroll
                for (int kk = 0; kk < 4; ++kk) cfr[kk] = *(const f16x8*)(Cm + ((size_t)(g * 2 + dir) * 16 + fr) * 128 + 32 * kk + 8 * fq);
            }
        }
        if (unit + F.G < NU) s5_load_unit<P2>(unit + F.G, w, dir, l, U16, Cin, afn, stn);
        const size_t sidx = ((size_t)((dir * 2 + b) * NCH + c) * 64 + g) * 64 + l;
        float xr = st.x, xi = st.y; const float nai = -ai;
        const int cgl = F.tid >> 7, ct = (F.tid >> 1) & 63, chb = F.tid & 1, cgg = gq * 4 + cgl;
        const size_t co = (size_t)(rowbase + ct) * D + 16 * cgg + 8 * chb;
        f16x8 uu; f32x4 dv0, dv1;
        if (P2) { uu = *(const f16x8*)(U16 + co); dv0 = *(const f32x4*)(ssm_d + 16 * cgg + 8 * chb); dv1 = *(const f32x4*)(ssm_d + 16 * cgg + 8 * chb + 4); }
#pragma unroll
        for (int s = 0; s < 4; ++s) {
            const int sc = dir ? 3 - s : s;
            const f16x4 a4 = af[s];
#pragma unroll
            for (int j = 0; j < 8; ++j) { const f32x4 dd = __builtin_amdgcn_mfma_f32_16x16x16f16(bf[j], a4, (f32x4){0.f, 0.f, 0.f, 0.f}, 0, 0, 0);
                *(LAS f32x4*)(W + fr * 132 + 16 * j + 4 * fq) = dd; }
            CFENCE();
#pragma unroll
            for (int k = 0; k < 16; ++k) {
                const f32x2 bu = *(const LAS f32x2*)(Wl + k * wstep);
                const float nr = fma_s(nai, xi, fma_s(ar, xr, bu.x)), ni = fma_s(ai, xr, fma_s(ar, xi, bu.y)); xr = nr; xi = ni;
                if (P2) { f16x2 hv; hv.x = (f16)xr; hv.y = (f16)xi; *(LAS f16x2*)(XSl + k * xstep) = hv; } }
            if (P2) {
                CFENCE();
                f32x4 Y = (f32x4){0.f, 0.f, 0.f, 0.f};
#pragma unroll
                for (int kk = 0; kk < 4; ++kk) { const f16x8 xa = *(const LAS f16x8*)(XS + fr * 136 + 32 * kk + 8 * fq); Y = __builtin_amdgcn_mfma_f32_16x16x32_f16(cfr[kk], xa, Y, 0, 0, 0); }
                *(LAS f32x4*)(YB + (16 * sc + fr) * 16 + 4 * fq) = Y;
            }
            CFENCE();
        }
        if (!P2) { Eb[sidx] = (f32x2){xr, xi}; }
        else {
            __syncthreads();
            const LAS float* y0 = YBall + (cgl * 2) * 1024 + ct * 16 + 8 * chb; const LAS float* y1 = y0 + 1024;
            const size_t o = co;
            float hv[8];
#pragma unroll
            for (int e = 0; e < 8; ++e) { const float dd = e < 4 ? dv0[e & 3] : dv1[e & 3];
                const float y = (y0[e] + y1[e]) * (1.0f / 1024.0f) + (float)uu[e] * dd;
                const float z = 1.5957691216057308f * (y + 0.044715f * y * y * y);
                hv[e] = y * sigmoidf_(z); }
            u32x4 wv; wv.x = pk2h(hv[0], hv[1]); wv.y = pk2h(hv[2], hv[3]); wv.z = pk2h(hv[4], hv[5]); wv.w = pk2h(hv[6], hv[7]);
            *(u32x4*)(G16 + o) = wv;
            __syncthreads();
        }
#pragma unroll
        for (int s = 0; s < 4; ++s) af[s] = afn[s];
        st = stn;
    }
}

__device__ __forceinline__ void s5_carry(Frame& F, unsigned char* ws) {
    const float* LamT = (const float*)(ws + WS_LAMT); const f32x2* Eb = (const f32x2*)(ws + WS_E); f32x2* Cin = (f32x2*)(ws + WS_CIN);
    for (int wv = F.wave * F.G + blockIdx.x; wv < 256; wv += F.G * 8) {
        const int idx = wv * 64 + F.lane;
        const int p = idx & 63, g = (idx >> 6) & 63, b = (idx >> 12) & 1, dir = idx >> 13;
        const float lr = LamT[((dir * 64 + g) * 64 + p) * 2], li = LamT[((dir * 64 + g) * 64 + p) * 2 + 1];
        float sr = 0.f, si = 0.f;
        for (int k0 = 0; k0 < NCH; k0 += 12) {
            f32x2 e[12]; size_t ad[12];
#pragma unroll
            for (int j = 0; j < 12; ++j) { const int k = k0 + j; const int c = dir ? (k < 4 ? 3 - k : 135 - k) : k;
                ad[j] = ((size_t)((dir * 2 + b) * NCH + c) * 64 + g) * 64 + p; e[j] = Eb[ad[j]]; }
#pragma unroll
            for (int j = 0; j < 12; ++j) { Cin[ad[j]] = (f32x2){sr, si};
                const float nr = lr * sr - li * si + e[j].x, ni = lr * si + li * sr + e[j].y; sr = nr; si = ni; }
        }
    }
}

__device__ __forceinline__ void qknorm_phase(Frame& F, unsigned char* ws, const float* qg, const float* kg) {
    f16* Q = (f16*)(ws + WS_Q16); f16* Kp = (f16*)(ws + WS_K16); const f16* V = (const f16*)(ws + WS_V16); f16* VT = (f16*)(ws + WS_VT); f16* VTC = (f16*)(ws + WS_VTC);
    LAS f16* T = (LAS f16*)(F.lds + F.wave * 9216);
    const int gw = F.vcu * 8 + F.wave, NGW = F.G * 8, l = F.lane;
    const int dchunk = (l & 7) * 8;
    float qgv[8], kgv[8];
#pragma unroll
    for (int e = 0; e < 8; ++e) { qgv[e] = qg[dchunk + e] * 0.125f; kgv[e] = kg[dchunk + e]; }
    for (int u = gw; u < 264 * 16; u += NGW) {
        const int h = u & 15, tb = u >> 4, R0 = tb * 64;
#pragma unroll
        for (int which = 0; which < 2; ++which) {
            if (which == 0 && tb >= 256) continue;
            f16* P = which ? Kp : Q;
#pragma unroll 2
            for (int it = 0; it < 8; ++it) { f16* p = P + (size_t)(R0 + it * 8 + (l >> 3)) * D + h * 64 + dchunk;
                const f16x8 v = *(const f16x8*)p; float f[8], ss = 0.f;
#pragma unroll
                for (int e = 0; e < 8; ++e) { f[e] = (float)v[e]; ss += f[e] * f[e]; }
                ss += __shfl_xor(ss, 1); ss += __shfl_xor(ss, 2); ss += __shfl_xor(ss, 4);
                const float rinv = __builtin_amdgcn_rsqf(ss * (1.0f / 64.0f) + EPS);
                u32x4 o;
                if (which) { o.x = pk2h(f[0] * rinv * kgv[0], f[1] * rinv * kgv[1]); o.y = pk2h(f[2] * rinv * kgv[2], f[3] * rinv * kgv[3]); o.z = pk2h(f[4] * rinv * kgv[4], f[5] * rinv * kgv[5]); o.w = pk2h(f[6] * rinv * kgv[6], f[7] * rinv * kgv[7]); }
                else { o.x = pk2h(f[0] * rinv * qgv[0], f[1] * rinv * qgv[1]); o.y = pk2h(f[2] * rinv * qgv[2], f[3] * rinv * qgv[3]); o.z = pk2h(f[4] * rinv * qgv[4], f[5] * rinv * qgv[5]); o.w = pk2h(f[6] * rinv * qgv[6], f[7] * rinv * qgv[7]); }
                *(u32x4*)p = o; }
        }
#pragma unroll 2
        for (int it = 0; it < 8; ++it) { const int tok = it * 8 + (l >> 3);
            *(LAS u32x4*)(T + tok * 72 + dchunk) = *(const u32x4*)(V + (size_t)(R0 + tok) * D + h * 64 + dchunk); }
        LDS_WAIT();
        f16* dst; int ldt;
        if (tb < 256) { const int b = tb >> 7, t0 = (tb & 127) * 64; dst = VT + ((size_t)(b * 16 + h) * 64) * SEQ + t0; ldt = SEQ; }
        else { const int b = (tb - 256) >> 2, t0 = ((tb - 256) & 3) * 64; dst = VTC + ((size_t)(b * 16 + h) * 64) * CTX + t0; ldt = CTX; }
#pragma unroll 2
        for (int it = 0; it < 8; ++it) { const int d = it * 8 + (l >> 3), tc = (l & 7) * 8; f16x8 o;
#pragma unroll
            for (int e = 0; e < 8; ++e) o[e] = T[(tc + e) * 72 + d];
            *(f16x8*)(dst + (size_t)d * ldt + tc) = o; }
        LDS_WAIT();
    }
}

constexpr int AT_KROW = 144, AT_KC = 82944, AT_VC = 119808, AT_TAB = 156672;
#define AT_BAR() do { asm volatile("s_waitcnt lgkmcnt(0)" ::: "memory"); __builtin_amdgcn_s_barrier(); asm volatile("" ::: "memory"); } while (0)
typedef short v4i16_t __attribute__((ext_vector_type(4)));
__device__ __forceinline__ f16x4 at_vtr(const LAS unsigned char* p) { return __builtin_bit_cast(f16x4, __builtin_amdgcn_ds_read_tr16_b64_v4i16((LAS v4i16_t*)p)); }
__device__ __forceinline__ void attn_decode(int up, int G, int& rp, int& bh, int& rs0) {
    if (G == 256) { const int i = up & 255, k = up >> 8; bh = i >> 3; rp = (i & 7) * 8 + k; } else { rp = up & 63; bh = up >> 6; }
    rs0 = min(max(2 * rp - 4, 0), 120);
}
constexpr int AT_NPF = 5;
template <int I0, int I1, int NT>
__device__ __forceinline__ void attn_load_band(const f16* Src, int bh, int rs0, int tid, u32x4 (&tk)[NT]) {
    const int b = bh >> 4, h = bh & 15;
#pragma unroll
    for (int it = I0; it < I1; ++it) { const int q = it * 512 + tid, row = q >> 3, c16 = q & 7;
        const int gr = min(rs0 + (row >> 6), 127);
        tk[it - I0] = *(const u32x4*)(Src + (size_t)(b * SEQ + gr * 64 + (row & 63)) * D + h * 64 + c16 * 8); }
}
__device__ __forceinline__ u32x4 at_knorm(u32x4 raw, const float (&kgv)[8]) {
    const f16x8 v = __builtin_bit_cast(f16x8, raw); float f[8], ss = 0.f;
#pragma unroll
    for (int e = 0; e < 8; ++e) { f[e] = (float)v[e]; ss += f[e] * f[e]; }
    ss += __builtin_bit_cast(float, __builtin_amdgcn_update_dpp(0, __builtin_bit_cast(int, ss), 0xB1, 0xf, 0xf, true));
    ss += __builtin_bit_cast(float, __builtin_amdgcn_update_dpp(0, __builtin_bit_cast(int, ss), 0x4E, 0xf, 0xf, true));
    ss += __builtin_bit_cast(float, __builtin_amdgcn_update_dpp(0, __builtin_bit_cast(int, ss), 0x141, 0xf, 0xf, true));
    const float rinv = __builtin_amdgcn_rsqf(ss * (1.0f / 64.0f) + EPS);
    u32x4 o; o.x = pk2h(f[0] * rinv * kgv[0], f[1] * rinv * kgv[1]); o.y = pk2h(f[2] * rinv * kgv[2], f[3] * rinv * kgv[3]);
    o.z = pk2h(f[4] * rinv * kgv[4], f[5] * rinv * kgv[5]); o.w = pk2h(f[6] * rinv * kgv[6], f[7] * rinv * kgv[7]); return o;
}
__device__ __forceinline__ void attn_phase(Frame& F, unsigned char* ws, const float* rpb, const float* qg, const float* kg) {
    f16* Q = (f16*)(ws + WS_Q16); const f16* Kp = (const f16*)(ws + WS_K16); const f16* Vp = (const f16*)(ws + WS_V16);
    const int w = F.wave;
    LAS unsigned char* SM = F.lds;
    constexpr int NUP = NB * 16 * 64;
    u32x4 tk[AT_NPF];
    int bh_cur = -1;
    { int rp, bh, rs0; if ((int)blockIdx.x < NUP) { attn_decode(blockIdx.x, F.G, rp, bh, rs0); attn_load_band<0, AT_NPF, AT_NPF>(Kp, bh, rs0, F.tid, tk); } }
    for (int up = blockIdx.x; up < NUP; up += F.G) {
        int l_ = F.lane; asm volatile("" : "+v"(l_));
        const int l = l_, fr = l & 15, fq = l >> 4, tid = w * 64 + l;
        int rp, bh, rs0; attn_decode(up, F.G, rp, bh, rs0);
        const int b = bh >> 4, h = bh & 15;
        const int r0 = 2 * rp;
        const int r = r0 + (w >> 2), qt = w & 3;
        const int rs = min(max(r - 4, 0), 120), i0 = rs - rs0;
        const int cw = qt == 0 ? 0 : (qt == 1 ? 8 : (qt == 2 ? 24 : 32));
        const int qc = 16 * qt + fr, cs = min(max(qc - 8, 0), 48);
        const size_t qrow = (size_t)(b * SEQ + r * 64 + qc) * D + h * 64;
        float kgv[8];
#pragma unroll
        for (int e = 0; e < 8; ++e) kgv[e] = kg[(tid & 7) * 8 + e];
        u32x4 trk[9 - AT_NPF]; attn_load_band<AT_NPF, 9, 9 - AT_NPF>(Kp, bh, rs0, tid, trk);
        f16x8 q0, q1;
        { const f16x8 r0v = *(const f16x8*)(Q + qrow + 8 * fq), r1v = *(const f16x8*)(Q + qrow + 32 + 8 * fq); float f0[8], f1[8], ss = 0.f;
#pragma unroll
            for (int e = 0; e < 8; ++e) { f0[e] = (float)r0v[e]; f1[e] = (float)r1v[e]; ss += f0[e] * f0[e] + f1[e] * f1[e]; }
            ss += __shfl_xor(ss, 16); ss += __shfl_xor(ss, 32);
            const float rinv = __builtin_amdgcn_rsqf(ss * (1.0f / 64.0f) + EPS) * (0.125f * 1.4426950408889634f);
#pragma unroll
            for (int e = 0; e < 8; ++e) { q0[e] = (f16)(f0[e] * rinv * qg[8 * fq + e]); q1[e] = (f16)(f1[e] * rinv * qg[32 + 8 * fq + e]); } }
        {
#pragma unroll
        for (int it = 0; it < 9; ++it) { const int q = it * 512 + tid, row = q >> 3, c16 = q & 7; *(LAS u32x4*)(SM + row * AT_KROW + c16 * 16) = at_knorm(it < AT_NPF ? tk[it < AT_NPF ? it : 0] : trk[it >= AT_NPF ? it - AT_NPF : 0], kgv); } }
        if (bh != bh_cur) {
            bh_cur = bh;
#pragma unroll
            for (int it = 0; it < 4; ++it) { const int q = it * 512 + tid, row = q >> 3, c16 = q & 7; const size_t go = (size_t)(MLAT + b * CTX + row) * D + h * 64 + c16 * 8;
                *(LAS u32x4*)(SM + AT_KC + row * AT_KROW + c16 * 16) = at_knorm(*(const u32x4*)(Kp + go), kgv);
                *(LAS u32x4*)(SM + AT_VC + row * AT_KROW + c16 * 16) = *(const u32x4*)(Vp + go); }
            if (tid < 465) ((LAS float*)(SM + AT_TAB))[tid] = rpb[h * 465 + tid] * 1.4426950408889634f;
        }
        const LAS float* rp_ = (const LAS float*)(SM + AT_TAB);
        AT_BAR();
        f32x4 S[32];
        float mx = -INFINITY;
#pragma unroll
        for (int i = 0; i < 8; ++i)
#pragma unroll
            for (int hf = 0; hf < 2; ++hf) {
                const LAS unsigned char* kr = SM + ((i0 + i) * 64 + cw + 16 * hf + fr) * AT_KROW + 16 * fq;
                const f16x8 k0 = *(const LAS f16x8*)kr, k1 = *(const LAS f16x8*)(kr + 64);
                f32x4 sv = __builtin_amdgcn_mfma_f32_16x16x32_f16(k0, q0, (f32x4){0.f, 0.f, 0.f, 0.f}, 0, 0, 0);
                sv = __builtin_amdgcn_mfma_f32_16x16x32_f16(k1, q1, sv, 0, 0, 0);
                const int ri = rs + i - r + 7;
#pragma unroll
                for (int e = 0; e < 4; ++e) { const int kc = cw + 16 * hf + 4 * fq + e; const bool valid = (kc >= cs) && (kc < cs + 16);
                    const int ci = min(max(kc - qc + 15, 0), 30);
                    const float bz = rp_[ri * 31 + ci];
                    const float z = (sv[e] + bz) + (valid ? 0.f : -INFINITY); sv[e] = z; mx = fmaxf(mx, z); }
                S[i * 2 + hf] = sv;
            }
#pragma unroll
        for (int j = 0; j < 16; ++j) {
            const LAS unsigned char* kr = SM + AT_KC + (16 * j + fr) * AT_KROW + 16 * fq;
            const f16x8 k0 = *(const LAS f16x8*)kr, k1 = *(const LAS f16x8*)(kr + 64);
            f32x4 sv = __builtin_amdgcn_mfma_f32_16x16x32_f16(k0, q0, (f32x4){0.f, 0.f, 0.f, 0.f}, 0, 0, 0);
            sv = __builtin_amdgcn_mfma_f32_16x16x32_f16(k1, q1, sv, 0, 0, 0);
#pragma unroll
            for (int e = 0; e < 4; ++e) mx = fmaxf(mx, sv[e]);
            S[16 + j] = sv;
        }
        mx = fmaxf(mx, __shfl_xor(mx, 16)); mx = fmaxf(mx, __shfl_xor(mx, 32));
        float sum = 0.f;
        f16x4 P[32];
#pragma unroll
        for (int t = 0; t < 32; ++t) {
#pragma unroll
            for (int e = 0; e < 4; ++e) { const float p = __builtin_amdgcn_exp2f(S[t][e] - mx); sum += p; P[t][e] = (f16)p; } }
        sum += __shfl_xor(sum, 16); sum += __shfl_xor(sum, 32);
        const float rsum = __builtin_amdgcn_rcpf(sum);
        __builtin_amdgcn_sched_barrier(0);
        u32x4 tv[9];
        attn_load_band<0, 9, 9>(Vp, bh, rs0, tid, tv);
        __builtin_amdgcn_sched_barrier(0);
        AT_BAR();
#pragma unroll
        for (int it = 0; it < 9; ++it) { const int q = it * 512 + tid, row = q >> 3, c16 = q & 7; *(LAS u32x4*)(SM + row * AT_KROW + c16 * 16) = tv[it]; }
        AT_BAR();
        if (up + F.G < NUP) { int rp2, bh2, rs2; attn_decode(up + F.G, F.G, rp2, bh2, rs2); attn_load_band<0, AT_NPF, AT_NPF>(Kp, bh2, rs2, tid, tk); }
        __builtin_amdgcn_sched_barrier(0);
        f32x4 O[4];
#pragma unroll
        for (int dt = 0; dt < 4; ++dt) O[dt] = (f32x4){0.f, 0.f, 0.f, 0.f};
        const int trq = fr >> 2, trp = fr & 3;
#pragma unroll
        for (int i = 0; i < 8; ++i) {
            f16x8 pf;
#pragma unroll
            for (int e = 0; e < 4; ++e) { pf[e] = P[2 * i][e]; pf[4 + e] = P[2 * i + 1][e]; }
            const LAS unsigned char* vb_ = SM + ((i0 + i) * 64 + cw + 4 * fq + trq) * AT_KROW + 8 * trp;
#pragma unroll
            for (int dt = 0; dt < 4; ++dt) { const f16x4 va = at_vtr(vb_ + 32 * dt), vb = at_vtr(vb_ + 16 * AT_KROW + 32 * dt); f16x8 vf;
#pragma unroll
                for (int e = 0; e < 4; ++e) { vf[e] = va[e]; vf[4 + e] = vb[e]; }
                O[dt] = __builtin_amdgcn_mfma_f32_16x16x32_f16(vf, pf, O[dt], 0, 0, 0); }
        }
#pragma unroll
        for (int jp = 0; jp < 8; ++jp) {
            f16x8 pf;
#pragma unroll
            for (int e = 0; e < 4; ++e) { pf[e] = P[16 + 2 * jp][e]; pf[4 + e] = P[17 + 2 * jp][e]; }
            const LAS unsigned char* vb_ = SM + AT_VC + (32 * jp + 4 * fq + trq) * AT_KROW + 8 * trp;
#pragma unroll
            for (int dt = 0; dt < 4; ++dt) { const f16x4 va = at_vtr(vb_ + 32 * dt), vb = at_vtr(vb_ + 16 * AT_KROW + 32 * dt); f16x8 vf;
#pragma unroll
                for (int e = 0; e < 4; ++e) { vf[e] = va[e]; vf[4 + e] = vb[e]; }
                O[dt] = __builtin_amdgcn_mfma_f32_16x16x32_f16(vf, pf, O[dt], 0, 0, 0); }
        }
#pragma unroll
        for (int dt = 0; dt < 4; ++dt) { u32x2 o; o.x = pk2h(O[dt][0] * rsum, O[dt][1] * rsum); o.y = pk2h(O[dt][2] * rsum, O[dt][3] * rsum);
            *(u32x2*)(Q + qrow + 16 * dt + 4 * fq) = o; }
        AT_BAR();
    }
}

template <int NT, int MODE, int CB = 0>
__device__ __forceinline__ void ctx_gemm(Frame& F, const f16* A, int lda, const f16* Bt, int K, const pg8::Epi& E) {
    constexpr int KC = 256, PITCH = KC * 2 + 16, NROWS = 32 + 16 * NT, NLD = NROWS / 16;
    LAS unsigned char* SM = F.lds;
    const int w = F.wave, rt = w >> 2, kq = w & 3;
    for (int tile = blockIdx.x; tile < 256; tile += F.G) {
        int l_ = F.lane; asm volatile("" : "+v"(l_));
        const int l = l_, fr = l & 15, fq = l >> 4, tid = w * 64 + l;
        const int rb = tile & 15, cb = tile >> 4;
        const int row = MLAT + rb * 32 + 16 * rt + fr;
        const f16* src[NLD];
#pragma unroll
        for (int it = 0; it < NLD; ++it) { const int q = it * 512 + tid, srow = q >> 5, c16 = q & 31;
            if (srow < 32) src[it] = A + (size_t)(MLAT + rb * 32 + srow) * lda + c16 * 8;
            else { const int j = srow - 32; int brow;
                if (MODE == 3) { const int jj = cb * 64 + 16 * ((j >> 4) & 3) + (j & 15); brow = (jj >> 7) * 256 + (jj & 127) + ((j >> 4) >= 4 ? 128 : 0); }
                else brow = CB + cb * (16 * NT) + j;
                src[it] = Bt + (size_t)brow * K + c16 * 8; } }
        f32x4 fin[NT / 4];
#pragma unroll
        for (int i = 0; i < NT / 4; ++i) fin[i] = (f32x4){0.f, 0.f, 0.f, 0.f};
        u32x4 tr[NLD];
#pragma unroll
        for (int it = 0; it < NLD; ++it) tr[it] = *(const u32x4*)src[it];
        for (int kc = 0; kc < K; kc += KC) {
            __syncthreads();
#pragma unroll
            for (int it = 0; it < NLD; ++it) { const int q = it * 512 + tid; *(LAS u32x4*)(SM + (q >> 5) * PITCH + (q & 31) * 16) = tr[it]; }
            __syncthreads();
            if (kc + KC < K) {
#pragma unroll
                for (int it = 0; it < NLD; ++it) tr[it] = *(const u32x4*)(src[it] + kc + KC);
            }
#pragma unroll
            for (int ks = 0; ks < KC / 32; ++ks) { const f16x8 av = *(const LAS f16x8*)(SM + (16 * rt + fr) * PITCH + ks * 64 + 16 * fq);
#pragma unroll
                for (int i = 0; i < NT / 4; ++i) { const f16x8 bv = *(const LAS f16x8*)(SM + (32 + 16 * (kq + 4 * i) + fr) * PITCH + ks * 64 + 16 * fq);
                    fin[i] = __builtin_amdgcn_mfma_f32_16x16x32_f16(bv, av, fin[i], 0, 0, 0); } }
        }
        if (MODE == 0) {
            const float rinv = __builtin_amdgcn_rsqf(E.ss[row] * (1.0f / 1024.0f) + 1e-6f);
#pragma unroll
            for (int i = 0; i < NT / 4; ++i) { int col = CB + cb * (16 * NT) + 16 * (kq + 4 * i) + 4 * fq; f16* base = E.O16;
                const f32x4 v = fin[i] * rinv + *(const f32x4*)(E.bias + 2 * 5632 + col);
                if (E.split_cols) { const int t = col / E.split_cols; base += (size_t)t * E.split_stride; col -= t * E.split_cols; }
                u32x2 o; o.x = pk2h(v[0], v[1]); o.y = pk2h(v[2], v[3]);
                *(u32x2*)(base + (size_t)row * E.ldo + col) = o; }
        } else {
            const int col = cb * 64 + 16 * kq + 4 * fq; const size_t off = (size_t)row * D + col;
            const f32x4 xs = *(const f32x4*)(E.Xs + off); f32x4 xn;
            if (MODE == 2) { const f32x4 gv = *(const f32x4*)(E.gate + 2 * 9216 + col) * E.coef; xn = xs + gv * fin[0]; }
            else { const f32x4 gv = *(const f32x4*)(E.gate + 2 * 9216 + col);
#pragma unroll
                for (int e = 0; e < 4; ++e) xn[e] = xs[e] + gv[e] * fin[0][e] * sigmoidf_(fin[NT / 4 - 1][e]); }
            *(f32x4*)(E.Xd + off) = xn;
            if (E.An) { const f32x4 a0 = xn * *(const f32x4*)(E.gsn + 2 * 1024 + col);
                u32x2 o; o.x = pk2h(a0[0], a0[1]); o.y = pk2h(a0[2], a0[3]);
                *(u32x2*)(E.An + off) = o;
                float sq = (xn[0] * xn[0] + xn[1] * xn[1]) + (xn[2] * xn[2] + xn[3] * xn[3]);
                sq += __shfl_xor(sq, 16); sq += __shfl_xor(sq, 32); if (fq == 0) atomicAdd(E.ssn + row, sq); }
        }
        __syncthreads();
    }
}

#define XB_TMO      128
#define XB_XCNT(j)  (256  + 64 * (j))
#define XB_XSUB(j)  (1280 + 64 * (j))
#define XB_XGEN(j)  (2304 + 64 * (j))
#define XB_TOP      3328
#define XB_TOPGEN   3392
#define XCD_BAR_WORDS 3456
#define XB_SPIN_CAP (1u << 18)

__device__ __forceinline__ unsigned xb_ld(unsigned* p)              { return __hip_atomic_load(p, __ATOMIC_RELAXED, __HIP_MEMORY_SCOPE_AGENT); }
__device__ __forceinline__ unsigned xb_add(unsigned* p, unsigned v) { return __hip_atomic_fetch_add(p, v, __ATOMIC_RELAXED, __HIP_MEMORY_SCOPE_AGENT); }
__device__ __forceinline__ unsigned xb_xcc_id() { return (unsigned)__builtin_amdgcn_s_getreg((3 << 11) | 20) & 0xFu; }
#define XB_SPIN(cond, bar) do { unsigned _sp = 0; while (cond) { __builtin_amdgcn_s_sleep(1); \
    if ((++_sp & 255u) == 0u) { if (xb_ld(&(bar)[XB_TMO])) break; if (_sp > XB_SPIN_CAP) { atomicAdd(&(bar)[XB_TMO], 1u); break; } } } } while (0)

struct XcdBarrier {
    unsigned* bar; unsigned x;
    volatile LAS unsigned* st;
};

__device__ __forceinline__ XcdBarrier xcd_barrier_post(unsigned* bar, volatile LAS unsigned* st) {
    XcdBarrier b; b.bar = bar; b.x = xb_xcc_id(); b.st = st;
    if (threadIdx.x == 0) (void)xb_add(&bar[XB_XCNT(b.x)], 1u);
    return b;
}
__device__ __forceinline__ void xcd_barrier_complete(unsigned* bar, unsigned x, unsigned& nloc, unsigned& nx) {
    const unsigned G = gridDim.x * gridDim.y * gridDim.z;
    unsigned sum, cnt, mine, sp = 0u;
    for (;;) {
        sum = 0u; cnt = 0u; mine = 0u;
#pragma unroll
        for (unsigned j = 0; j < 16; ++j) { const unsigned c = xb_ld(&bar[XB_XCNT(j)]); sum += c; cnt += (c > 0u) ? 1u : 0u; mine = (j == x) ? c : mine; }
        if (sum == G) break;
        __builtin_amdgcn_s_sleep(1);
        if ((++sp & 255u) == 0u) { if (xb_ld(&bar[XB_TMO])) break; if (sp > XB_SPIN_CAP) { atomicAdd(&bar[XB_TMO], 1u); break; } }
    }
    nloc = mine > 0u ? mine : 1u; nx = cnt > 0u ? cnt : 1u;
}

__device__ __forceinline__ void xcd_barrier(const XcdBarrier& b) {
    asm volatile("s_waitcnt vmcnt(0)" ::: "memory");
    __syncthreads();
    if (threadIdx.x == 0) {
        unsigned* bar = b.bar;
        __builtin_amdgcn_s_waitcnt(0);
        unsigned nloc = b.st[0], nx = b.st[1];
        if (nloc == 0u) { xcd_barrier_complete(bar, b.x, nloc, nx); b.st[0] = nloc; b.st[1] = nx; }
        const unsigned old = xb_add(&bar[XB_XSUB(b.x)], 1u);
        const unsigned gen = old / nloc;
        if (old + 1u == (gen + 1u) * nloc) {
            __builtin_amdgcn_fence(__ATOMIC_RELEASE, "agent");
            asm volatile("s_waitcnt vmcnt(0)" ::: "memory");
            const unsigned og = xb_add(&bar[XB_TOP], 1u);
            const unsigned tg = og / nx;
            if (og + 1u == (tg + 1u) * nx) xb_add(&bar[XB_TOPGEN], 1u);
            else XB_SPIN(xb_ld(&bar[XB_TOPGEN]) == tg, bar);
            __builtin_amdgcn_fence(__ATOMIC_ACQUIRE, "agent");
            xb_add(&bar[XB_XGEN(b.x)], 1u);
            asm volatile("s_waitcnt vmcnt(0)" ::: "memory");
        } else {
            XB_SPIN(xb_ld(&bar[XB_XGEN(b.x)]) == gen, bar);
            __builtin_amdgcn_fence(__ATOMIC_ACQUIRE, "agent");
            asm volatile("s_waitcnt vmcnt(0)" ::: "memory");
        }
    }
    __syncthreads();
}

__global__ void __launch_bounds__(512, 2) fwd_megakernel(Args args) {
    extern __shared__ __attribute__((aligned(16))) unsigned char lds_raw[];
    Frame F;
    F.lds = (LAS unsigned char*)lds_raw;
    F.tid = threadIdx.x; F.lane = F.tid & 63; F.wave = __builtin_amdgcn_readfirstlane(F.tid >> 6);
    F.G = gridDim.x; { const int bx = blockIdx.x; F.vcu = (F.G % 8 == 0) ? (bx % 8) * (F.G / 8) + bx / 8 : bx; }
    unsigned char* ws = args.ws;
    float* MOD = (float*)(ws + WS_MOD); float* X = (float*)(ws + WS_X); f16* H16 = (f16*)(ws + WS_H16); f16* HID = (f16*)(ws + WS_HID);
    const float* norm_g = args.in[4];
    cg::grid_group grid = cg::this_grid();
    volatile LAS unsigned* bst = (volatile LAS unsigned*)(F.lds + LDS_BYTES - 16);
    if (F.tid < 4) bst[F.tid] = 0u;
    __syncthreads();
    XcdBarrier xbar = xcd_barrier_post((unsigned*)(ws + WS_BAR), bst);

    const int lo = args.ph_lo, hi = args.ph_hi;
    if (hi > (1 << 20)) grid.sync();
#define IN(k) (lo <= (k) && (k) < hi)
#define SEAM(k) do { if (IN(k) && IN((k) + 1)) xcd_barrier(xbar); asm volatile("" : "+v"(F.tid), "+v"(F.lane)); } while (0)
#define RUN_GEMM(Ap, Bp, Mr, Nc, Kc) do { pg8::Gemm g{(const u16*)(Ap), (const u16*)(Bp), (Mr), (Nc), (Kc)}; pg8::StaticOrder S; S.init(g.M, g.N, F.G, (int)blockIdx.x); pg8::gemm_phase(F.lds, g, S, E); } while (0)
#define CONV_TAIL(job) do { const int rem_ = (66 * 22) % F.G; \
        if (rem_ == 0) conv_job(F, args, (job), F.vcu * 8 + F.wave, F.G * 8); \
        else if ((int)blockIdx.x >= rem_) conv_job(F, args, (job), ((int)blockIdx.x - rem_) * 8 + F.wave, (F.G - rem_) * 8); } while (0)
#define SSP(sl) ((float*)(ws + WS_SS) + (size_t)(sl) * MALL)
#define GSP(sl) ((const float*)(ws + WS_GS) + (sl) * 3072)
#define BIASP(sl) ((const float*)(ws + WS_BIAS) + (sl) * 3 * 5632)
#define EPI_F16(dst, ld, sc, sst, sl) pg8::Epi E{(dst), (sst), nullptr, nullptr, nullptr, SSP(sl), BIASP(sl), nullptr, nullptr, nullptr, 0, (ld), (sc), 0.f}
#define EPI_SWIGLU(sl) pg8::Epi E{HID, 0, nullptr, nullptr, nullptr, SSP(sl), BIASP(sl), nullptr, nullptr, nullptr, 1, FH, 0, 0.f}
#define EPI_RES(md, dst, gt, cf, nsl) pg8::Epi E{nullptr, 0, X, (dst), (gt), nullptr, nullptr, (nsl) >= 0 ? H16 : nullptr, GSP((nsl) >= 0 ? (nsl) : 0), SSP((nsl) >= 0 ? (nsl) : 0), (md), 0, 0, (cf)}
    if (IN(0)) { p0_phase(F, args); } SEAM(0);
    if (IN(1)) { p1_phase(F, args); } SEAM(1);
    if (IN(2)) { EPI_SWIGLU(0); RUN_GEMM(H16, ws + WS_WFI + 0 * WFI_SZ, MALL, 5632, 1024); CONV_TAIL(1); } SEAM(2);
#if REP_FFNIN > 1
    if (IN(2)) { EPI_SWIGLU(0); RUN_GEMM(H16, ws + WS_WFI + 0 * WFI_SZ, MALL, 5632, 1024); } SEAM(2);
#endif
    if (IN(3)) { EPI_RES(2, X, MOD + 0 * 3072 + 2048, 0.5f, 1); RUN_GEMM(HID, ws + WS_WFO + 0 * WFO_SZ, MLAT, 1024, FH); ctx_gemm<4, 2>(F, HID, FH, (const f16*)(ws + WS_WFO + 0 * WFO_SZ), FH, E); bias_rows(F, args, 1, 2); } SEAM(3);
    if (IN(5)) { EPI_F16((f16*)(ws + WS_U16), D, 0, 0, 1); RUN_GEMM(H16, ws + WS_WSI, MLAT, 1024, 1024); ctx_gemm<4, 0>(F, H16, D, (const f16*)(ws + WS_WSI), 1024, E); } SEAM(5);
    if (IN(6)) { s5_pass<false>(F, ws, args.in[17]); } SEAM(6);
#if REP_S5 == 2
    if (IN(6)) { s5_pass<false>(F, ws, args.in[17]); } SEAM(6);
#endif
    if (IN(7)) { s5_carry(F, ws); } SEAM(7);
    if (IN(8)) { s5_pass<true>(F, ws, args.in[17]); } SEAM(8);
#if REP_S5 == 4
    if (IN(8)) { s5_pass<true>(F, ws, args.in[17]); } SEAM(8);
#endif
    if (IN(9)) { EPI_RES(3, X, MOD + 1 * 3072 + 2048, 1.f, 2); RUN_GEMM(ws + WS_G16, ws + WS_WGLU, MLAT, 2048, 1024); ctx_gemm<8, 3>(F, (const f16*)(ws + WS_G16), D, (const f16*)(ws + WS_WGLU), 1024, E); } SEAM(9);
    if (IN(11)) { EPI_SWIGLU(2); RUN_GEMM(H16, ws + WS_WFI + 1 * WFI_SZ, MALL, 5632, 1024); CONV_TAIL(2); } SEAM(11);
    if (IN(12)) { EPI_RES(2, X, MOD + 2 * 3072 + 2048, 0.5f, 3); RUN_GEMM(HID, ws + WS_WFO + 1 * WFO_SZ, MLAT, 1024, FH); ctx_gemm<4, 2>(F, HID, FH, (const f16*)(ws + WS_WFO + 1 * WFO_SZ), FH, E); bias_rows(F, args, 3, 4); } SEAM(12);
    if (IN(14)) { EPI_SWIGLU(3); RUN_GEMM(H16, ws + WS_WFI + 2 * WFI_SZ, MALL, 5632, 1024); CONV_TAIL(3); } SEAM(14);
    if (IN(15)) { EPI_RES(2, X, MOD + 3 * 9216 + 0 * 3072 + 2048, 0.5f, 4); RUN_GEMM(HID, ws + WS_WFO + 2 * WFO_SZ, MLAT, 1024, FH); ctx_gemm<4, 2>(F, HID, FH, (const f16*)(ws + WS_WFO + 2 * WFO_SZ), FH, E); bias_rows(F, args, 5, 5); } SEAM(15);
    if (IN(17)) { EPI_F16((f16*)(ws + WS_Q16), D, 1024, (size_t)MALL * D, 4); RUN_GEMM(H16, ws + WS_WQKV, MLAT, 3072, 1024); ctx_gemm<8, 0, 1024>(F, H16, D, (const f16*)(ws + WS_WQKV), 1024, E); } SEAM(17);
    if (IN(19)) { attn_phase(F, ws, args.in[22], args.in[20], args.in[21]); } SEAM(19);
#if REP_ATTN > 1
    if (IN(19)) { attn_phase(F, ws, args.in[22], args.in[20], args.in[21]); } SEAM(19);
#endif
    if (IN(20)) { EPI_RES(2, X, MOD + 3 * 9216 + 1 * 3072 + 2048, 1.f, 5); RUN_GEMM(ws + WS_Q16, ws + WS_WO, MLAT, 1024, 1024); } SEAM(20);
    if (IN(22)) { EPI_SWIGLU(5); RUN_GEMM(H16, ws + WS_WFI + 3 * WFI_SZ, MLAT, 5632, 1024); } SEAM(22);
    if (IN(23)) { EPI_RES(2, args.out, MOD + 3 * 9216 + 2 * 3072 + 2048, 0.5f, -1); RUN_GEMM(HID, ws + WS_WFO + 3 * WFO_SZ, MLAT, 1024, FH); }
}

extern "C" void kernel_launch(void* const* d_in, const int* in_sizes, int n_in, void* d_out, int out_size, void* d_ws, size_t ws_size, hipStream_t stream) {
    static int grid = 0;
    if (grid == 0) {
        if (n_in != 24 || ws_size < WS_END) { fprintf(stderr, "kernel_launch: unexpected n_in %d or ws_size %zu (< %zu)\n", n_in, ws_size, (size_t)WS_END); grid = -1; return; }
        int dev = 0, cus = 0, per_cu = 0;
        hipGetDevice(&dev); hipDeviceGetAttribute(&cus, hipDeviceAttributeMultiprocessorCount, dev);
        if (hipFuncSetAttribute((const void*)fwd_megakernel, hipFuncAttributeMaxDynamicSharedMemorySize, LDS_BYTES) != hipSuccess) { fprintf(stderr, "kernel_launch: hipFuncSetAttribute failed\n"); }
        if (hipOccupancyMaxActiveBlocksPerMultiprocessor(&per_cu, (const void*)fwd_megakernel, 512, LDS_BYTES) != hipSuccess || per_cu < 1) { fprintf(stderr, "kernel_launch: occupancy query says %d\n", per_cu); per_cu = 1; }
        (void)hipGetLastError();
        grid = cus * 1;
        if (grid <= 0) grid = 256;
    }
    if (grid < 0) return;
    hipMemsetAsync((char*)d_ws + WS_MOD, 0, MOD_BYTES, stream);
    Args a{};
    for (int i = 0; i < 24; ++i) a.in[i] = (const float*)d_in[i];
    a.out = (float*)d_out; a.ws = (unsigned char*)d_ws;
#if MK_COOP
    a.ph_lo = 0; a.ph_hi = NPHASE;
    void* kargs[] = {&a};
    hipError_t e = hipLaunchCooperativeKernel((const void*)fwd_megakernel, dim3(grid), dim3(512), kargs, LDS_BYTES, stream);
    if (e != hipSuccess) fprintf(stderr, "cooperative launch failed: %s (grid %d)\n", hipGetErrorString(e), grid);
#else
    for (int ph = 0; ph < NPHASE; ++ph) {
        a.ph_lo = ph; a.ph_hi = ph + 1;
        hipLaunchKernelGGL(fwd_megakernel, dim3(grid), dim3(512), LDS_BYTES, stream, a);
    }
#endif
}
```

```cpp
#include <hip/hip_runtime.h>
#include <hip/hip_cooperative_groups.h>
#include <cstdio>
#include <cstdint>
namespace cg = cooperative_groups;

#ifndef REP_S5
#define REP_S5 1
#endif
#ifndef REP_ATTN
#define REP_ATTN 1
#endif
#ifndef REP_FFNIN
#define REP_FFNIN 1
#endif
#ifndef REP_NORM
#define REP_NORM 1
#endif
#ifndef REP_CONV
#define REP_CONV 1
#endif
#ifndef MK_COOP
#define MK_COOP 1
#endif

#define LAS __attribute__((address_space(3)))
typedef _Float16 f16;
typedef f16 f16x8 __attribute__((ext_vector_type(8)));
typedef f16 f16x4 __attribute__((ext_vector_type(4)));
typedef f16 f16x2 __attribute__((ext_vector_type(2)));
typedef float f32x4 __attribute__((ext_vector_type(4)));
typedef float f32x2 __attribute__((ext_vector_type(2)));
typedef unsigned u32x4 __attribute__((ext_vector_type(4)));
typedef unsigned u32x2 __attribute__((ext_vector_type(2)));
typedef unsigned short u16;

constexpr int D = 1024, SEQ = 8192, NB = 2, CTX = 256, FH = 2816;
constexpr int MLAT = NB * SEQ;
constexpr int MALL = MLAT + NB * CTX;
constexpr int NCH = 132;
constexpr float EPS = 1e-6f;

constexpr size_t MiB = 1u << 20;
constexpr size_t WS_MOD = 0;
constexpr size_t MOD_BYTES = 262144;
constexpr size_t WS_BAR = 229376;
constexpr size_t WS_LAM = 262144;
constexpr size_t WS_LAMT = WS_LAM + 65536;
constexpr size_t WS_BMAT = WS_LAMT + 65536;
constexpr size_t WS_CMAT = WS_BMAT + 524288;
constexpr size_t WS_WFI = 2 * MiB;
constexpr size_t WFI_SZ = (size_t)5632 * 1024 * 2;
constexpr size_t WS_WFO = WS_WFI + 4 * WFI_SZ;
constexpr size_t WFO_SZ = (size_t)1024 * 2816 * 2;
constexpr size_t WS_WSI = WS_WFO + 4 * WFO_SZ;
constexpr size_t WS_WGLU = WS_WSI + 2 * MiB;
constexpr size_t WS_WQKV = WS_WGLU + 4 * MiB;
constexpr size_t WS_WO = WS_WQKV + 6 * MiB;
constexpr size_t WS_X = 82 * MiB;
constexpr size_t WS_H16 = 148 * MiB;
constexpr size_t WS_R = 181 * MiB;
constexpr size_t WS_HID = WS_R;
constexpr size_t WS_U16 = WS_R;
constexpr size_t WS_G16 = WS_R + 33 * MiB;
constexpr size_t WS_E = WS_R + 66 * MiB;
constexpr size_t WS_CIN = WS_R + 83 * MiB;
constexpr size_t WS_Q16 = WS_R;
constexpr size_t WS_K16 = WS_R + 33 * MiB;
constexpr size_t WS_V16 = WS_R + 66 * MiB;
constexpr size_t WS_VT = WS_R + 99 * MiB;
constexpr size_t WS_VTC = WS_R + 131 * MiB;
constexpr size_t WS_SS = WS_CMAT + 524288;
constexpr size_t WS_GS = WS_SS + (size_t)6 * 16896 * 4;
constexpr size_t WS_BIAS = 313 * MiB;
constexpr size_t WS_END = 314 * MiB;
static_assert(WS_GS + 6 * 3 * 1024 * 4 <= 2 * MiB, "small tables below the weights");
static_assert(WS_WO + 2 * MiB == WS_X, "weights end at X");

constexpr int LDS_BYTES = 163840;
constexpr int NPHASE = 24;

namespace pg8 {
constexpr int BM = 256, BK = 64, HALF = 128, HTB = HALF * BK * 2, STAGE_BYTES = 8 * HTB, NXCD = 8, WGM = 8;
__host__ __device__ __forceinline__ int lds_byte(int r, int c) { const int st = (r >> 4) * 2 + (c >> 5), rr = r & 15, cc = c & 31, ob = rr * 64 + cc * 2; return st * 1024 + (ob ^ (((ob >> 9) & 1) << 5)); }
__host__ __device__ __forceinline__ void stage_rc(int b, int& R, int& C) { const int st = b / 1024, sb = b % 1024, swz = sb ^ (((sb >> 9) & 1) << 5); R = (st >> 1) * 16 + swz / 64; C = (st & 1) * 32 + (swz % 64) / 2; }
__host__ __device__ __forceinline__ int perm32(int rho) { const int n = rho >> 4, i = rho & 15; return 8 * (i >> 2) + 4 * n + (i & 3); }

struct Unit { int pm, pn; };
struct Gemm { const u16* A; const u16* Bt; int M, N, K; };

struct StaticOrder {
    int nM, nN, nwg, G, c;
    __device__ void init(int M, int N, int G_, int c_) { nM = M / BM; nN = N / BM; nwg = nM * nN; G = G_; c = c_; }
    __device__ bool next(int i, Unit& u) const {
        const long L = (long)i * G + c; if (L >= nwg) return false;
        int wgid = (int)L; { const int q = nwg / NXCD, r = nwg % NXCD, xcd = wgid % NXCD, off = wgid / NXCD; wgid = (xcd < r ? xcd * (q + 1) : r * (q + 1) + (xcd - r) * q) + off; }
        const int nig = WGM * nN, gid = wgid / nig, fm = gid * WGM, gsz = (nM - fm) < WGM ? (nM - fm) : WGM;
        u.pm = fm + ((wgid % nig) % gsz); u.pn = (wgid % nig) / gsz; return true;
    }
};

__device__ __forceinline__ unsigned pk2h(float a, float b) { f16x2 v; v.x = (f16)a; v.y = (f16)b; return __builtin_bit_cast(unsigned, v); }
__device__ __forceinline__ float sigmoidf_(float x) { return __builtin_amdgcn_rcpf(1.0f + __expf(-x)); }

struct Epi {
    static constexpr bool PERM = true;
    f16* O16; size_t split_stride;
    const float* Xs; float* Xd; const float* gate;
    const float* ss; const float* bias;
    f16* An; const float* gsn; float* ssn;
    int mode;
    int ldo; int split_cols; float coef;
    __device__ __forceinline__ void operator()(const f32x4 (&acc)[2][2][4][2], const Unit& u, int wr, int wc, int fr, int fq) const {
        const int row0 = u.pm * BM + wr * 64 + fr;
        const int rowt = u.pm * BM; const int mi = rowt < SEQ ? 0 : (rowt < MLAT ? 1 : 2);
        if (mode == 0) {
            int colt = u.pn * BM; f16* base = O16;
            const float* bp = bias + mi * 5632 + colt + wc * 32 + 8 * fq;
            if (split_cols) { const int t = colt / split_cols; base += (size_t)t * split_stride; colt -= t * split_cols; }
            const int col0 = colt + wc * 32 + 8 * fq;
            f32x4 bv[2][2];
#pragma unroll
            for (int bj = 0; bj < 2; ++bj)
#pragma unroll
                for (int n = 0; n < 2; ++n) bv[bj][n] = *(const f32x4*)(bp + bj * HALF + 4 * n);
#pragma unroll
            for (int ai = 0; ai < 2; ++ai)
#pragma unroll
                for (int m = 0; m < 4; ++m) { const int row = row0 + ai * HALF + m * 16; f16* rowp = base + (size_t)row * ldo + col0;
                    const float rinv = __builtin_amdgcn_rsqf(ss[row] * (1.0f / 1024.0f) + 1e-6f);
#pragma unroll
                    for (int bj = 0; bj < 2; ++bj) { const f32x4 v0 = acc[ai][bj][m][0] * rinv + bv[bj][0], v1 = acc[ai][bj][m][1] * rinv + bv[bj][1];
                        u32x4 w; w.x = pk2h(v0[0], v0[1]); w.y = pk2h(v0[2], v0[3]); w.z = pk2h(v1[0], v1[1]); w.w = pk2h(v1[2], v1[3]);
                        *(u32x4*)(rowp + bj * HALF) = w; } }
        } else if (mode == 1) {
            const int col0 = u.pn * HALF + wc * 32 + 8 * fq;
            const float* bp = bias + mi * 5632 + u.pn * BM + wc * 32 + 8 * fq;
            f32x4 bv[2][2];
#pragma unroll
            for (int bj = 0; bj < 2; ++bj)
#pragma unroll
                for (int n = 0; n < 2; ++n) bv[bj][n] = *(const f32x4*)(bp + bj * HALF + 4 * n);
#pragma unroll
            for (int ai = 0; ai < 2; ++ai)
#pragma unroll
                for (int m = 0; m < 4; ++m) { const int row = row0 + ai * HALF + m * 16; f16* rowp = O16 + (size_t)row * ldo + col0;
                    const float rinv = __builtin_amdgcn_rsqf(ss[row] * (1.0f / 1024.0f) + 1e-6f);
                    float h[8];
#pragma unroll
                    for (int n = 0; n < 2; ++n)
#pragma unroll
                        for (int e = 0; e < 4; ++e) { const float g = acc[ai][0][m][n][e] * rinv + bv[0][n][e], up = acc[ai][1][m][n][e] * rinv + bv[1][n][e]; h[n * 4 + e] = g * sigmoidf_(g) * up; }
                    u32x4 w; w.x = pk2h(h[0], h[1]); w.y = pk2h(h[2], h[3]); w.z = pk2h(h[4], h[5]); w.w = pk2h(h[6], h[7]);
                    *(u32x4*)rowp = w; }
        } else {
            const float* gp = gate + mi * 9216;
            if (mode == 2) {
                const int col0 = u.pn * BM + wc * 32 + 8 * fq;
                f32x4 gv[2][2], gs[2][2];
#pragma unroll
                for (int bj = 0; bj < 2; ++bj)
#pragma unroll
                    for (int n = 0; n < 2; ++n) { gv[bj][n] = *(const f32x4*)(gp + col0 + bj * HALF + 4 * n) * coef;
                        gs[bj][n] = *(const f32x4*)(gsn + mi * 1024 + col0 + bj * HALF + 4 * n); }
#pragma unroll
                for (int ai = 0; ai < 2; ++ai) {
#pragma unroll
                  for (int mp = 0; mp < 2; ++mp) {
                    f32x4 xpre[4][2][2];
#pragma unroll
                    for (int m = 2 * mp; m < 2 * mp + 2; ++m)
#pragma unroll
                        for (int bj = 0; bj < 2; ++bj)
#pragma unroll
                            for (int n = 0; n < 2; ++n) xpre[m][bj][n] = *(const f32x4*)(Xs + (size_t)(row0 + ai * HALF + m * 16) * D + col0 + bj * HALF + 4 * n);
                    asm volatile("" ::: "memory");
#pragma unroll
                    for (int m = 2 * mp; m < 2 * mp + 2; ++m) { const int row = row0 + ai * HALF + m * 16; const size_t off = (size_t)row * D + col0; float sq = 0.f;
#pragma unroll
                        for (int bj = 0; bj < 2; ++bj) { f32x4 xn[2];
#pragma unroll
                            for (int n = 0; n < 2; ++n) { const f32x4 xs = xpre[m][bj][n];
                                xn[n] = xs + gv[bj][n] * acc[ai][bj][m][n];
                                *(f32x4*)(Xd + off + bj * HALF + 4 * n) = xn[n];
                                sq += (xn[n][0] * xn[n][0] + xn[n][1] * xn[n][1]) + (xn[n][2] * xn[n][2] + xn[n][3] * xn[n][3]); }
                            if (An) { const f32x4 a0 = xn[0] * gs[bj][0], a1 = xn[1] * gs[bj][1];
                                u32x4 w; w.x = pk2h(a0[0], a0[1]); w.y = pk2h(a0[2], a0[3]); w.z = pk2h(a1[0], a1[1]); w.w = pk2h(a1[2], a1[3]);
                                *(u32x4*)(An + off + bj * HALF) = w; } }
                        if (An) { sq += __shfl_xor(sq, 16); sq += __shfl_xor(sq, 32); if (fq == 0) atomicAdd(ssn + row, sq); } }
                  }
                }
            } else {
                const int col0 = u.pn * HALF + wc * 32 + 8 * fq;
                f32x4 gv[2], gs[2];
#pragma unroll
                for (int n = 0; n < 2; ++n) { gv[n] = *(const f32x4*)(gp + col0 + 4 * n); gs[n] = *(const f32x4*)(gsn + mi * 1024 + col0 + 4 * n); }
#pragma unroll
                for (int ai = 0; ai < 2; ++ai) {
                    f32x4 xpre[4][2];
#pragma unroll
                    for (int m = 0; m < 4; ++m)
#pragma unroll
                        for (int n = 0; n < 2; ++n) xpre[m][n] = *(const f32x4*)(Xs + (size_t)(row0 + ai * HALF + m * 16) * D + col0 + 4 * n);
                    asm volatile("" ::: "memory");
#pragma unroll
                    for (int m = 0; m < 4; ++m) { const int row = row0 + ai * HALF + m * 16; const size_t off = (size_t)row * D + col0; float sq = 0.f; f32x4 xn[2];
#pragma unroll
                        for (int n = 0; n < 2; ++n) { const f32x4 xs = xpre[m][n]; const f32x4 a = acc[ai][0][m][n], b = acc[ai][1][m][n];
#pragma unroll
                            for (int e = 0; e < 4; ++e) xn[n][e] = xs[e] + gv[n][e] * a[e] * sigmoidf_(b[e]);
                            *(f32x4*)(Xd + off + 4 * n) = xn[n];
                            sq += (xn[n][0] * xn[n][0] + xn[n][1] * xn[n][1]) + (xn[n][2] * xn[n][2] + xn[n][3] * xn[n][3]); }
                        const f32x4 a0 = xn[0] * gs[0], a1 = xn[1] * gs[1];
                        u32x4 w; w.x = pk2h(a0[0], a0[1]); w.y = pk2h(a0[2], a0[3]); w.z = pk2h(a1[0], a1[1]); w.w = pk2h(a1[2], a1[3]);
                        *(u32x4*)(An + off) = w;
                        sq += __shfl_xor(sq, 16); sq += __shfl_xor(sq, 32); if (fq == 0) atomicAdd(ssn + row, sq); }
                }
            }
        }
    }
};

__device__ __forceinline__ void gemm_phase(LAS unsigned char* lds, const Gemm g, const StaticOrder& S, const Epi& E) {
    int tid_ = threadIdx.x; asm volatile("" : "+v"(tid_));
    const int tid = tid_, wid = __builtin_amdgcn_readfirstlane(tid >> 6), lane = tid & 63, wr = wid >> 2, wc = wid & 3, fr = lane & 15, fq = lane >> 4;
    const int K = g.K, nt = K / BK;
    unsigned voffA[2], voffB[2];
#pragma unroll
    for (int i = 0; i < 2; ++i) { int R, C; stage_rc(tid * 16 + i * 8192, R, C); const int Rb = Epi::PERM ? ((R & ~31) + perm32(R & 31)) : R;
        voffA[i] = (unsigned)(R * K + C) * 2u; voffB[i] = (unsigned)(Rb * K + C) * 2u; }
    const size_t kstep = (size_t)(BK * 2);
    const size_t hstep = (size_t)HALF * K * 2;
    const size_t tstep = 2 * hstep;
    const unsigned ldsw = (unsigned)wid * 1024u;
    const int aoff = lds_byte(wr * 64 + fr, fq * 8), boff = lds_byte(wc * 32 + fr, fq * 8);
#define PG8_SA(b, h) (((b) * 2 + (h)) * HTB)
#define PG8_SB(b, h) ((4 + (b) * 2 + (h)) * HTB)
#define PG8_STAGE(bufoff, gbase, voff) do { _Pragma("unroll") for (int _i = 0; _i < 2; ++_i) \
        __builtin_amdgcn_global_load_lds((const unsigned*)((const char*)(gbase) + (voff)[_i]), (LAS unsigned*)(lds + (bufoff) + ldsw + _i * 8192), 16, 0, 0); } while (0)
#define PG8_LDA(dst, b, h) do { _Pragma("unroll") for (int m = 0; m < 4; ++m) _Pragma("unroll") for (int k = 0; k < 2; ++k) dst[m][k] = *(const LAS f16x8*)(lds + PG8_SA(b, h) + aoff + m * 2048 + k * 1024); } while (0)
#define PG8_LDB(dst, b, h) do { _Pragma("unroll") for (int n = 0; n < 2; ++n) _Pragma("unroll") for (int k = 0; k < 2; ++k) dst[n][k] = *(const LAS f16x8*)(lds + PG8_SB(b, h) + boff + n * 2048 + k * 1024); } while (0)
#define PG8_MMA(ai, bj, At, Bt) do { __builtin_amdgcn_s_setprio(1); _Pragma("unroll") for (int m = 0; m < 4; ++m) _Pragma("unroll") for (int n = 0; n < 2; ++n) _Pragma("unroll") for (int k = 0; k < 2; ++k) \
        acc[ai][bj][m][n] = __builtin_amdgcn_mfma_f32_16x16x32_f16(Bt[n][k], At[m][k], acc[ai][bj][m][n], 0, 0, 0); __builtin_amdgcn_s_setprio(0); } while (0)
#define PG8_WAIT_V(n) asm volatile("s_waitcnt vmcnt(" #n ")" ::: "memory")
#define PG8_WAIT_L(n) asm volatile("s_waitcnt lgkmcnt(" #n ")" ::: "memory")
#define PG8_BAR __builtin_amdgcn_s_barrier()
#define PG8_SCHED __builtin_amdgcn_sched_barrier(0)
    Unit cur, nxt; int ui = 0;
    if (!S.next(0, cur)) return;
    f32x4 acc[2][2][4][2];
#pragma unroll
    for (int a = 0; a < 2; ++a)
#pragma unroll
        for (int b = 0; b < 2; ++b)
#pragma unroll
            for (int m = 0; m < 4; ++m)
#pragma unroll
                for (int n = 0; n < 2; ++n) acc[a][b][m][n] = (f32x4){0.f, 0.f, 0.f, 0.f};
    f16x8 At[4][2], B0[2][2], B1[2][2];
    const char* cA = (const char*)g.A + (size_t)cur.pm * tstep; const char* cB = (const char*)g.Bt + (size_t)cur.pn * tstep;
    PG8_STAGE(PG8_SB(0, 0), cB, voffB); PG8_STAGE(PG8_SB(0, 1), cB + hstep, voffB); PG8_STAGE(PG8_SA(0, 0), cA, voffA); PG8_STAGE(PG8_SA(0, 1), cA + hstep, voffA);
    if (wr == 1) PG8_BAR;
    PG8_WAIT_V(2); PG8_BAR;
    PG8_STAGE(PG8_SB(1, 0), cB + kstep, voffB); PG8_STAGE(PG8_SA(1, 0), cA + kstep, voffA); PG8_STAGE(PG8_SB(1, 1), cB + hstep + kstep, voffB);
    PG8_WAIT_V(6); PG8_BAR;
    for (;;) {
        const bool has_next = S.next(ui + 1, nxt);
        const char* nA = has_next ? (const char*)g.A + (size_t)nxt.pm * tstep : cA; const char* nB = has_next ? (const char*)g.Bt + (size_t)nxt.pn * tstep : cB;
        for (int t = 0; t < nt; t += 2) {
            const bool last = (t == nt - 2);
            const char* a1 = cA + (size_t)(t + 1) * kstep;
            const char* a2 = last ? nA : cA + (size_t)(t + 2) * kstep; const char* b2 = last ? nB : cB + (size_t)(t + 2) * kstep;
            const char* a3 = a2 + kstep; const char* b3 = b2 + kstep;
            PG8_LDB(B0, 0, 0); PG8_LDB(B1, 0, 1); PG8_SCHED; PG8_LDA(At, 0, 0); PG8_STAGE(PG8_SA(1, 1), a1 + hstep, voffA);
            PG8_WAIT_V(8); PG8_WAIT_L(0); PG8_BAR; PG8_MMA(0, 0, At, B0); PG8_MMA(0, 1, At, B1); PG8_BAR; PG8_SCHED;
            PG8_LDA(At, 0, 1); PG8_STAGE(PG8_SB(0, 0), b2, voffB); PG8_STAGE(PG8_SB(0, 1), b2 + hstep, voffB); PG8_STAGE(PG8_SA(0, 0), a2, voffA);
            PG8_WAIT_V(8); PG8_WAIT_L(0); PG8_BAR; PG8_MMA(1, 0, At, B0); PG8_MMA(1, 1, At, B1); PG8_BAR; PG8_SCHED;
            PG8_LDB(B0, 1, 0); PG8_LDB(B1, 1, 1); PG8_SCHED; PG8_LDA(At, 1, 0); PG8_STAGE(PG8_SA(0, 1), a2 + hstep, voffA);
            PG8_WAIT_V(8); PG8_WAIT_L(0); PG8_BAR; PG8_MMA(0, 0, At, B0); PG8_MMA(0, 1, At, B1); PG8_BAR; PG8_SCHED;
            PG8_LDA(At, 1, 1); PG8_STAGE(PG8_SB(1, 0), b3, voffB); PG8_STAGE(PG8_SB(1, 1), b3 + hstep, voffB); PG8_STAGE(PG8_SA(1, 0), a3, voffA);
            PG8_WAIT_V(8); PG8_WAIT_L(0); PG8_BAR; PG8_MMA(1, 0, At, B0); PG8_MMA(1, 1, At, B1); PG8_BAR; PG8_SCHED;
        }
        if (wr == 0) PG8_BAR;
        E(acc, cur, wr, wc, fr, fq);
        if (!has_next) break;
#pragma unroll
        for (int a = 0; a < 2; ++a)
#pragma unroll
            for (int b = 0; b < 2; ++b)
#pragma unroll
                for (int m = 0; m < 4; ++m)
#pragma unroll
                    for (int n = 0; n < 2; ++n) acc[a][b][m][n] = (f32x4){0.f, 0.f, 0.f, 0.f};
        cur = nxt; cA = nA; cB = nB; ++ui;
        if (wr == 1) PG8_BAR;
    }
    PG8_WAIT_V(0);
    PG8_BAR;
#undef PG8_SA
#undef PG8_SB
#undef PG8_STAGE
#undef PG8_LDA
#undef PG8_LDB
#undef PG8_MMA
#undef PG8_WAIT_V
#undef PG8_WAIT_L
#undef PG8_BAR
#undef PG8_SCHED
}
}
using pg8::pk2h;
using pg8::sigmoidf_;

#define LDS_WAIT() asm volatile("s_waitcnt lgkmcnt(0)" ::: "memory")
#define CFENCE() asm volatile("" ::: "memory")

struct Args {
    const float* in[24]; float* out; unsigned char* ws; int ph_lo, ph_hi;
};

struct Frame {
    LAS unsigned char* lds; int tid, lane, wave, vcu, G;
};

__device__ __forceinline__ float wave_sum(float v) {
#pragma unroll
    for (int o = 1; o < 64; o <<= 1) v += __shfl_xor(v, o);
    return v;
}

__device__ __forceinline__ void p0_transpose_item(const float* W, int K, int N, int half_n, f16* WT, LAS float* scr, int item, int lane) {
    const int nblk = N / 32, kb = item / nblk, nb = item % nblk, k0 = 64 * kb, n0 = 32 * nb;
    int d0 = n0;
    if (half_n) { const int j = n0 < half_n ? n0 : n0 - half_n; d0 = (j >> 7) * 256 + (n0 < half_n ? 0 : 128) + (j & 127); }
    float tv_[32];
#pragma unroll
    for (int i = 0; i < 32; ++i) tv_[i] = W[(size_t)(k0 + 2 * i + (lane >> 5)) * N + n0 + (lane & 31)];
#pragma unroll
    for (int i = 0; i < 32; ++i) { const int kk = 2 * i + (lane >> 5); scr[kk * 33 + (lane & 31)] = tv_[i]; }
    LDS_WAIT();
    const int c = lane & 7;
#pragma unroll
    for (int j = 0; j < 4; ++j) { const int n = (lane >> 3) + 8 * j; const LAS float* s = scr + (8 * c) * 33 + n;
        u32x4 o; o.x = pk2h(s[0 * 33], s[1 * 33]); o.y = pk2h(s[2 * 33], s[3 * 33]); o.z = pk2h(s[4 * 33], s[5 * 33]); o.w = pk2h(s[6 * 33], s[7 * 33]);
        *(u32x4*)(WT + (size_t)(d0 + n) * K + k0 + 8 * c) = o; }
    LDS_WAIT();
}

__device__ __forceinline__ void dsincos(double r, double& s, double& c) {
    const double r2 = r * r; double ts = r, tc = 1.0; s = r; c = 1.0;
#pragma unroll
    for (int i = 1; i <= 14; ++i) { tc = -tc * r2 / (double)((2 * i - 1) * (2 * i)); c += tc; ts = -ts * r2 / (double)((2 * i) * (2 * i + 1)); s += ts; }
}
__device__ __forceinline__ double dexp_small(double x) {
    double t = 1.0, s = 1.0;
#pragma unroll
    for (int i = 1; i <= 14; ++i) { t = t * x / (double)i; s += t; }
    return s;
}

__device__ __forceinline__ void conv_job(Frame& F, const Args& a, int job, int worker, int nworkers) {
    unsigned char* ws = a.ws;
    LAS float* scr = (LAS float*)(F.lds + 8192 + F.wave * 16384);
    constexpr int I_FI = (1024 / 64) * (5632 / 32), I_FO = (2816 / 64) * (1024 / 32), I_SQ = 16 * 32, I_GLU = 16 * 64, I_QKV = 16 * 96;
    const int q = job == 0 ? 0 : (job == 1 ? 1 : (job == 2 ? 2 : 3));
    const int nextra = job == 1 ? I_SQ + I_GLU : (job == 2 ? I_QKV + I_SQ : 0);
    const int nitems = I_FI + I_FO + nextra;
    for (int it = worker; it < nitems; it += nworkers) {
        int r = it;
        if (r < I_FI) { p0_transpose_item(a.in[7] + (size_t)q * 1024 * 5632, 1024, 5632, 2816, (f16*)(ws + WS_WFI + q * WFI_SZ), scr, r, F.lane); continue; } r -= I_FI;
        if (r < I_FO) { p0_transpose_item(a.in[8] + (size_t)q * 2816 * 1024, 2816, 1024, 0, (f16*)(ws + WS_WFO + q * WFO_SZ), scr, r, F.lane); continue; } r -= I_FO;
        if (job == 1) {
            if (r < I_SQ) { p0_transpose_item(a.in[9], 1024, 1024, 0, (f16*)(ws + WS_WSI), scr, r, F.lane); continue; } r -= I_SQ;
            p0_transpose_item(a.in[18], 1024, 2048, 1024, (f16*)(ws + WS_WGLU), scr, r, F.lane);
        } else {
            if (r < I_QKV) { p0_transpose_item(a.in[19], 1024, 3072, 0, (f16*)(ws + WS_WQKV), scr, r, F.lane); continue; } r -= I_QKV;
            p0_transpose_item(a.in[23], 1024, 1024, 0, (f16*)(ws + WS_WO), scr, r, F.lane);
        }
    }
}
__device__ __forceinline__ void bias_rows(Frame& F, const Args& a, int sl_lo, int sl_hi) {
    unsigned char* ws = a.ws;
    const float* MOD = (const float*)(ws + WS_MOD); float* BIAS = (float*)(ws + WS_BIAS);
    const int gw = F.vcu * 8 + F.wave, NGW = F.G * 8;
    for (int sl = sl_lo; sl <= sl_hi; ++sl) {
        const int nrows = sl == 1 ? 1024 : (sl == 4 ? 3072 : 5632);
        const f16* Wt = sl == 0 ? (const f16*)(ws + WS_WFI) : sl == 1 ? (const f16*)(ws + WS_WSI) : sl == 2 ? (const f16*)(ws + WS_WFI + 1 * WFI_SZ)
                      : sl == 3 ? (const f16*)(ws + WS_WFI + 2 * WFI_SZ) : sl == 4 ? (const f16*)(ws + WS_WQKV) : (const f16*)(ws + WS_WFI + 3 * WFI_SZ);
        const int l = sl / 3, sb = sl % 3;
        for (int n = gw; n < nrows; n += NGW) {
            const f16x8 w0 = *(const f16x8*)(Wt + (size_t)n * D + 16 * F.lane), w1 = *(const f16x8*)(Wt + (size_t)n * D + 16 * F.lane + 8);
            float d[3];
#pragma unroll
            for (int mi = 0; mi < 3; ++mi) { const float* sh = MOD + (l * 3 + mi) * 9216 + sb * 3072 + 16 * F.lane; float acc = 0.f;
#pragma unroll
                for (int q = 0; q < 4; ++q) { const f32x4 sv = *(const f32x4*)(sh + 4 * q);
#pragma unroll
                    for (int e = 0; e < 4; ++e) { const int k = 4 * q + e; acc += sv[e] * (float)(k < 8 ? w0[k & 7] : w1[k & 7]); } }
                d[mi] = wave_sum(acc); }
            if (F.lane == 0) { BIAS[(sl * 3 + 0) * 5632 + n] = d[0]; BIAS[(sl * 3 + 1) * 5632 + n] = d[1]; BIAS[(sl * 3 + 2) * 5632 + n] = d[2]; }
        }
    }
}
__device__ __forceinline__ void p0_phase(Frame& F, const Args& a) {
    unsigned char* ws = a.ws;
    float* MOD = (float*)(ws + WS_MOD);
    {
        const float* cin = a.in[1]; const float* cctx = a.in[3]; const float* ada_w = a.in[5]; const float* ada_b = a.in[6];
        LAS float* red = (LAS float*)F.lds;
        const int c4 = F.lane & 15, ko = F.lane >> 4;
        for (int u = blockIdx.x; u < 576; u += F.G) {
            const int kh = u & 1, cgl = u >> 1, l = cgl / 144, cg = cgl % 144;
            const float* Wl = ada_w + (size_t)l * 1024 * 9216 + cg * 64 + c4 * 4;
            const int kbase = kh * 512 + F.wave * 64 + ko;
            float acc[3][4];
#pragma unroll
            for (int m = 0; m < 3; ++m)
#pragma unroll
                for (int e = 0; e < 4; ++e) acc[m][e] = 0.f;
#pragma unroll 4
            for (int i = 0; i < 16; ++i) { const int k = kbase + 4 * i; const f32x4 w = *(const f32x4*)(Wl + (size_t)k * 9216);
                const float c0 = cin[k], c1 = cin[1024 + k], c2 = cctx[k];
                const float s0 = c0 * sigmoidf_(c0), s1 = c1 * sigmoidf_(c1), s2 = c2 * sigmoidf_(c2);
#pragma unroll
                for (int e = 0; e < 4; ++e) { acc[0][e] += s0 * w[e]; acc[1][e] += s1 * w[e]; acc[2][e] += s2 * w[e]; } }
#pragma unroll
            for (int m = 0; m < 3; ++m)
#pragma unroll
                for (int e = 0; e < 4; ++e) { float v = acc[m][e]; v += __shfl_xor(v, 16); v += __shfl_xor(v, 32); acc[m][e] = v; }
            if (F.lane < 16) {
#pragma unroll
                for (int m = 0; m < 3; ++m)
#pragma unroll
                    for (int e = 0; e < 4; ++e) red[(F.wave * 3 + m) * 64 + c4 * 4 + e] = acc[m][e];
            }
            __syncthreads();
            if (F.tid < 192) { const int m = F.tid >> 6, col = F.tid & 63; float s = 0.f;
#pragma unroll
                for (int w = 0; w < 8; ++w) s += red[(w * 3 + m) * 64 + col];
                if (kh == 0) s += ada_b[l * 9216 + cg * 64 + col];
                atomicAdd(MOD + (size_t)(l * 3 + m) * 9216 + cg * 64 + col, s); }
            __syncthreads();
        }
    }
    conv_job(F, a, 0, F.vcu * 8 + F.wave, F.G * 8);
    { float* SS = (float*)(ws + WS_SS); for (int i = blockIdx.x * 512 + F.tid; i < 5 * MALL; i += F.G * 512) SS[MALL + i] = 0.f; }
    {
        const float* lam_re = a.in[10]; const float* lam_im = a.in[11]; const float* lstep = a.in[12];
        const float* b_re = a.in[13]; const float* b_im = a.in[14]; const float* c_re = a.in[15]; const float* c_im = a.in[16];
        float* Lam = (float*)(ws + WS_LAM); float* LamT = (float*)(ws + WS_LAMT); f16* Bm = (f16*)(ws + WS_BMAT); f16* Cm = (f16*)(ws + WS_CMAT);
        for (int idx = blockIdx.x * 512 + F.tid; idx < 8192; idx += F.G * 512) {
            const int p = idx & 63, g = (idx >> 6) & 63, dir = idx >> 12;
            const double lr = fmin((double)lam_re[idx], -1e-4), li = (double)lam_im[idx];
            const double dt = (double)expf(lstep[dir * 64 + g]);
            const double mag = dexp_small(lr * dt);
            double th = li * dt; const double twopi = 6.283185307179586476925287;
            th -= twopi * rint(th / twopi);
            double sn, cs; dsincos(th, sn, cs);
            const double ar = mag * cs, ai = mag * sn;
            const double den = lr * lr + li * li;
            const double cr = ((ar - 1.0) * lr + ai * li) / den, ci = (ai * lr - (ar - 1.0) * li) / den;
            Lam[idx * 2] = (float)ar; Lam[idx * 2 + 1] = (float)ai;
            double pr = ar, pi = ai;
#pragma unroll
            for (int q = 0; q < 6; ++q) { const double nr = pr * pr - pi * pi, ni = 2.0 * pr * pi; pr = nr; pi = ni; }
            LamT[idx * 2] = (float)pr; LamT[idx * 2 + 1] = (float)pi;
            const float* br = b_re + (size_t)idx * 16; const float* bi = b_im + (size_t)idx * 16;
            f16* bo = Bm + ((size_t)(g * 2 + dir) * 128 + 2 * p) * 16;
#pragma unroll
            for (int h = 0; h < 16; ++h) { bo[h] = (f16)br[h]; bo[16 + h] = (f16)bi[h]; }
#pragma unroll
            for (int h = 0; h < 16; ++h) {
                const double Cr = (double)c_re[((size_t)(dir * 64 + g) * 16 + h) * 64 + p], Ci = (double)c_im[((size_t)(dir * 64 + g) * 16 + h) * 64 + p];
                const double er = Cr * cr - Ci * ci, ei = Cr * ci + Ci * cr;
                f16* co = Cm + ((size_t)(g * 2 + dir) * 16 + h) * 128 + 2 * p;
                co[0] = (f16)(float)(er * 1024.0); co[1] = (f16)(float)(-ei * 1024.0);
            }
        }
    }
}

__device__ __forceinline__ void p1_phase(Frame& F, const Args& a) {
    unsigned char* ws = a.ws;
    const float* MOD = (const float*)(ws + WS_MOD); const float* norm_g = a.in[4];
    float* X = (float*)(ws + WS_X); f16* H16 = (f16*)(ws + WS_H16); float* SS = (float*)(ws + WS_SS); float* GS = (float*)(ws + WS_GS); float* BIAS = (float*)(ws + WS_BIAS);
    const int gw = F.vcu * 8 + F.wave, NGW = F.G * 8;
    for (int rowb = gw; rowb < MALL; rowb += 3 * NGW) {
        f32x4 v[3][4];
#pragma unroll
        for (int r = 0; r < 3; ++r) { const int row = rowb + r * NGW;
            if (row < MALL) { const float* xr = row < MLAT ? a.in[0] + (size_t)row * D : a.in[2] + (size_t)(row - MLAT) * D;
#pragma unroll
                for (int j = 0; j < 4; ++j) v[r][j] = *((const f32x4*)xr + F.lane + 64 * j); } }
        asm volatile("" ::: "memory");
#pragma unroll
        for (int r = 0; r < 3; ++r) { const int row = rowb + r * NGW;
            if (row < MALL) {
                const int mi = row < SEQ ? 0 : (row < MLAT ? 1 : 2);
                const float* sc = MOD + mi * 9216 + 1024;
                float sq = 0.f;
#pragma unroll
                for (int j = 0; j < 4; ++j) sq += (v[r][j].x * v[r][j].x + v[r][j].y * v[r][j].y) + (v[r][j].z * v[r][j].z + v[r][j].w * v[r][j].w);
                sq = wave_sum(sq);
                if (F.lane == 0) SS[row] = sq;
#pragma unroll
                for (int j = 0; j < 4; ++j) { const int col = 4 * (F.lane + 64 * j);
                    const f32x4 gg = *(const f32x4*)(norm_g + col), s1 = *(const f32x4*)(sc + col);
                    const f32x4 h = v[r][j] * gg * (s1 + 1.0f);
                    u32x2 w; w.x = pk2h(h.x, h.y); w.y = pk2h(h.z, h.w);
                    *(u32x2*)(H16 + (size_t)row * D + col) = w;
                    *(f32x4*)(X + (size_t)row * D + col) = v[r][j]; } } }
    }
    for (int i = blockIdx.x * 512 + F.tid; i < 6 * 3 * 1024; i += F.G * 512) { const int col = i & 1023, mi = (i >> 10) % 3, sl = i / 3072, l = sl / 3, sb = sl % 3;
        GS[i] = norm_g[sl * 1024 + col] * (1.0f + MOD[(l * 3 + mi) * 9216 + sb * 3072 + 1024 + col]); }
    bias_rows(F, a, 0, 0);
}

__device__ __forceinline__ void s5_unit_decode(int unit, int w, int& gq, int& c, int& b, int& g, int& rowbase) {
    gq = unit & 15; c = (unit >> 4) % NCH; b = unit / (16 * NCH); g = gq * 4 + (w >> 1);
    rowbase = c < 4 ? MLAT + b * CTX + 64 * c : b * SEQ + 64 * (c - 4);
}
template <bool P2>
__device__ __forceinline__ void s5_load_unit(int unit, int w, int dir, int l, const f16* U16, const f32x2* Cin, f16x4 (&af)[4], f32x2& st) {
    int gq, c, b, g, rowbase; s5_unit_decode(unit, w, gq, c, b, g, rowbase);
    const int fq = l >> 4, fr = l & 15;
#pragma unroll
    for (int s = 0; s < 4; ++s) af[s] = *(const f16x4*)(U16 + (size_t)(rowbase + 16 * (dir ? 3 - s : s) + fr) * D + 16 * g + 4 * fq);
    if (P2) st = Cin[((size_t)((dir * 2 + b) * NCH + c) * 64 + g) * 64 + l];
}
__device__ __forceinline__ float fma_s(float a, float b, float c) { float r; asm("v_fma_f32 %0, %1, %2, %3" : "=v"(r) : "v"(a), "v"(b), "v"(c)); return r; }
template <bool P2>
__device__ __forceinline__ void s5_pass(Frame& F, unsigned char* ws, const float* ssm_d) {
    int l_ = F.lane; asm volatile("" : "+v"(l_));
    const int w = F.wave, l = l_, fq = l >> 4, fr = l & 15;
    LAS float* W = (LAS float*)(F.lds + w * 8448);
    LAS f16* XS = (LAS f16*)(F.lds + 67584 + w * 4352);
    LAS float* YBall = (LAS float*)(F.lds + 67584 + 34816);
    LAS float* YB = YBall + w * 1024;
    const float* Lam = (const float*)(ws + WS_LAM); const f16* Bm = (const f16*)(ws + WS_BMAT); const f16* Cm = (const f16*)(ws + WS_CMAT);
    const f16* U16 = (const f16*)(ws + WS_U16); f16* G16 = (f16*)(ws + WS_G16);
    f32x2* Eb = (f32x2*)(ws + WS_E); const f32x2* Cin = (const f32x2*)(ws + WS_CIN);
    const int dir = w & 1;
    int wstep = dir ? -132 : 132, xstep = dir ? -136 : 136, w0 = dir ? 15 * 132 : 0, x0 = dir ? 15 * 136 : 0;
    asm volatile("" : "+s"(wstep), "+s"(xstep), "+s"(w0), "+s"(x0));
    const LAS float* Wl = W + w0 + 2 * l; LAS f16* XSl = XS + x0 + 2 * l;
    constexpr int NU = NB * NCH * 16;
    int gcur = -1; float ar = 0.f, ai = 0.f;
    f16x4 bf[8]; f16x8 cfr[4];
    f16x4 af[4], afn[4]; f32x2 st = (f32x2){0.f, 0.f}, stn = (f32x2){0.f, 0.f};
    int unit = blockIdx.x;
    if (unit < NU) s5_load_unit<P2>(unit, w, dir, l, U16, Cin, af, st);
    for (; unit < NU; unit += F.G) {
        int gq, c, b, g, rowbase; s5_unit_decode(unit, w, gq, c, b, g, rowbase);
        if (g != gcur) {
            gcur = g;
            ar = Lam[((dir * 64 + g) * 64 + l) * 2]; ai = Lam[((dir * 64 + g) * 64 + l) * 2 + 1];
#pragma unroll
            for (int j = 0; j < 8; ++j) bf[j] = *(const f16x4*)(Bm + ((size_t)(g * 2 + dir) * 128 + 16 * j + fr) * 16 + 4 * fq);
            if (P2) {
#pragma unroll
                for (int kk = 0; kk < 4; ++kk) cfr[kk] = *(const f16x8*)(Cm + ((size_t)(g * 2 + dir) * 16 + fr) * 128 + 32 * kk + 8 * fq);
            }
        }
        if (unit + F.G < NU) s5_load_unit<P2>(unit + F.G, w, dir, l, U16, Cin, afn, stn);
        const size_t sidx = ((size_t)((dir * 2 + b) * NCH + c) * 64 + g) * 64 + l;
        float xr = st.x, xi = st.y; const float nai = -ai;
        const int cgl = F.tid >> 7, ct = (F.tid >> 1) & 63, chb = F.tid & 1, cgg = gq * 4 + cgl;
        const size_t co = (size_t)(rowbase + ct) * D + 16 * cgg + 8 * chb;
        f16x8 uu; f32x4 dv0, dv1;
        if (P2) { uu = *(const f16x8*)(U16 + co); dv0 = *(const f32x4*)(ssm_d + 16 * cgg + 8 * chb); dv1 = *(const f32x4*)(ssm_d + 16 * cgg + 8 * chb + 4); }
#pragma unroll
        for (int s = 0; s < 4; ++s) {
            const int sc = dir ? 3 - s : s;
            const f16x4 a4 = af[s];
#pragma unroll
            for (int j = 0; j < 8; ++j) { const f32x4 dd = __builtin_amdgcn_mfma_f32_16x16x16f16(bf[j], a4, (f32x4){0.f, 0.f, 0.f, 0.f}, 0, 0, 0);
                *(LAS f32x4*)(W + fr * 132 + 16 * j + 4 * fq) = dd; }
            CFENCE();
#pragma unroll
            for (int k = 0; k < 16; ++k) {
                const f32x2 bu = *(const LAS f32x2*)(Wl + k * wstep);
                const float nr = fma_s(nai, xi, fma_s(ar, xr, bu.x)), ni = fma_s(ai, xr, fma_s(ar, xi, bu.y)); xr = nr; xi = ni;
                if (P2) { f16x2 hv; hv.x = (f16)xr; hv.y = (f16)xi; *(LAS f16x2*)(XSl + k * xstep) = hv; } }
            if (P2) {
                CFENCE();
                f32x4 Y = (f32x4){0.f, 0.f, 0.f, 0.f};
#pragma unroll
                for (int kk = 0; kk < 4; ++kk) { const f16x8 xa = *(const LAS f16x8*)(XS + fr * 136 + 32 * kk + 8 * fq); Y = __builtin_amdgcn_mfma_f32_16x16x32_f16(cfr[kk], xa, Y, 0, 0, 0); }
                *(LAS f32x4*)(YB + (16 * sc + fr) * 16 + 4 * fq) = Y;
            }
            CFENCE();
        }
        if (!P2) { Eb[sidx] = (f32x2){xr, xi}; }
        else {
            __syncthreads();
            const LAS float* y0 = YBall + (cgl * 2) * 1024 + ct * 16 + 8 * chb; const LAS float* y1 = y0 + 1024;
            const size_t o = co;
            float hv[8];
#pragma unroll
            for (int e = 0; e < 8; ++e) { const float dd = e < 4 ? dv0[e & 3] : dv1[e & 3];
                const float y = (y0[e] + y1[e]) * (1.0f / 1024.0f) + (float)uu[e] * dd;
                const float z = 1.5957691216057308f * (y + 0.044715f * y * y * y);
                hv[e] = y * sigmoidf_(z); }
            u32x4 wv; wv.x = pk2h(hv[0], hv[1]); wv.y = pk2h(hv[2], hv[3]); wv.z = pk2h(hv[4], hv[5]); wv.w = pk2h(hv[6], hv[7]);
            *(u32x4*)(G16 + o) = wv;
            __syncthreads();
        }
#pragma unroll
        for (int s = 0; s < 4; ++s) af[s] = afn[s];
        st = stn;
    }
}

__device__ __forceinline__ void s5_carry(Frame& F, unsigned char* ws) {
    const float* LamT = (const float*)(ws + WS_LAMT); const f32x2* Eb = (const f32x2*)(ws + WS_E); f32x2* Cin = (f32x2*)(ws + WS_CIN);
    for (int wv = F.wave * F.G + blockIdx.x; wv < 256; wv += F.G * 8) {
        const int idx = wv * 64 + F.lane;
        const int p = idx & 63, g = (idx >> 6) & 63, b = (idx >> 12) & 1, dir = idx >> 13;
        const float lr = LamT[((dir * 64 + g) * 64 + p) * 2], li = LamT[((dir * 64 + g) * 64 + p) * 2 + 1];
        float sr = 0.f, si = 0.f;
        for (int k0 = 0; k0 < NCH; k0 += 12) {
            f32x2 e[12]; size_t ad[12];
#pragma unroll
            for (int j = 0; j < 12; ++j) { const int k = k0 + j; const int c = dir ? (k < 4 ? 3 - k : 135 - k) : k;
                ad[j] = ((size_t)((dir * 2 + b) * NCH + c) * 64 + g) * 64 + p; e[j] = Eb[ad[j]]; }
#pragma unroll
            for (int j = 0; j < 12; ++j) { Cin[ad[j]] = (f32x2){sr, si};
                const float nr = lr * sr - li * si + e[j].x, ni = lr * si + li * sr + e[j].y; sr = nr; si = ni; }
        }
    }
}

__device__ __forceinline__ void qknorm_phase(Frame& F, unsigned char* ws, const float* qg, const float* kg) {
    f16* Q = (f16*)(ws + WS_Q16); f16* Kp = (f16*)(ws + WS_K16); const f16* V = (const f16*)(ws + WS_V16); f16* VT = (f16*)(ws + WS_VT); f16* VTC = (f16*)(ws + WS_VTC);
    LAS f16* T = (LAS f16*)(F.lds + F.wave * 9216);
    const int gw = F.vcu * 8 + F.wave, NGW = F.G * 8, l = F.lane;
    const int dchunk = (l & 7) * 8;
    float qgv[8], kgv[8];
#pragma unroll
    for (int e = 0; e < 8; ++e) { qgv[e] = qg[dchunk + e] * 0.125f; kgv[e] = kg[dchunk + e]; }
    for (int u = gw; u < 264 * 16; u += NGW) {
        const int h = u & 15, tb = u >> 4, R0 = tb * 64;
#pragma unroll
        for (int which = 0; which < 2; ++which) {
            if (which == 0 && tb >= 256) continue;
            f16* P = which ? Kp : Q;
#pragma unroll 2
            for (int it = 0; it < 8; ++it) { f16* p = P + (size_t)(R0 + it * 8 + (l >> 3)) * D + h * 64 + dchunk;
                const f16x8 v = *(const f16x8*)p; float f[8], ss = 0.f;
#pragma unroll
                for (int e = 0; e < 8; ++e) { f[e] = (float)v[e]; ss += f[e] * f[e]; }
                ss += __shfl_xor(ss, 1); ss += __shfl_xor(ss, 2); ss += __shfl_xor(ss, 4);
                const float rinv = __builtin_amdgcn_rsqf(ss * (1.0f / 64.0f) + EPS);
                u32x4 o;
                if (which) { o.x = pk2h(f[0] * rinv * kgv[0], f[1] * rinv * kgv[1]); o.y = pk2h(f[2] * rinv * kgv[2], f[3] * rinv * kgv[3]); o.z = pk2h(f[4] * rinv * kgv[4], f[5] * rinv * kgv[5]); o.w = pk2h(f[6] * rinv * kgv[6], f[7] * rinv * kgv[7]); }
                else { o.x = pk2h(f[0] * rinv * qgv[0], f[1] * rinv * qgv[1]); o.y = pk2h(f[2] * rinv * qgv[2], f[3] * rinv * qgv[3]); o.z = pk2h(f[4] * rinv * qgv[4], f[5] * rinv * qgv[5]); o.w = pk2h(f[6] * rinv * qgv[6], f[7] * rinv * qgv[7]); }
                *(u32x4*)p = o; }
        }
#pragma unroll 2
        for (int it = 0; it < 8; ++it) { const int tok = it * 8 + (l >> 3);
            *(LAS u32x4*)(T + tok * 72 + dchunk) = *(const u32x4*)(V + (size_t)(R0 + tok) * D + h * 64 + dchunk); }
        LDS_WAIT();
        f16* dst; int ldt;
        if (tb < 256) { const int b = tb >> 7, t0 = (tb & 127) * 64; dst = VT + ((size_t)(b * 16 + h) * 64) * SEQ + t0; ldt = SEQ; }
        else { const int b = (tb - 256) >> 2, t0 = ((tb - 256) & 3) * 64; dst = VTC + ((size_t)(b * 16 + h) * 64) * CTX + t0; ldt = CTX; }
#pragma unroll 2
        for (int it = 0; it < 8; ++it) { const int d = it * 8 + (l >> 3), tc = (l & 7) * 8; f16x8 o;
#pragma unroll
            for (int e = 0; e < 8; ++e) o[e] = T[(tc + e) * 72 + d];
            *(f16x8*)(dst + (size_t)d * ldt + tc) = o; }
        LDS_WAIT();
    }
}

constexpr int AT_KROW = 144, AT_KC = 82944, AT_VC = 119808, AT_TAB = 156672;
#define AT_BAR() do { asm volatile("s_waitcnt lgkmcnt(0)" ::: "memory"); __builtin_amdgcn_s_barrier(); asm volatile("" ::: "memory"); } while (0)
typedef short v4i16_t __attribute__((ext_vector_type(4)));
__device__ __forceinline__ f16x4 at_vtr(const LAS unsigned char* p) { return __builtin_bit_cast(f16x4, __builtin_amdgcn_ds_read_tr16_b64_v4i16((LAS v4i16_t*)p)); }
__device__ __forceinline__ void attn_decode(int up, int G, int& rp, int& bh, int& rs0) {
    if (G == 256) { const int i = up & 255, k = up >> 8; bh = i >> 3; rp = (i & 7) * 8 + k; } else { rp = up & 63; bh = up >> 6; }
    rs0 = min(max(2 * rp - 4, 0), 120);
}
constexpr int AT_NPF = 5;
template <int I0, int I1, int NT>
__device__ __forceinline__ void attn_load_band(const f16* Src, int bh, int rs0, int tid, u32x4 (&tk)[NT]) {
    const int b = bh >> 4, h = bh & 15;
#pragma unroll
    for (int it = I0; it < I1; ++it) { const int q = it * 512 + tid, row = q >> 3, c16 = q & 7;
        const int gr = min(rs0 + (row >> 6), 127);
        tk[it - I0] = *(const u32x4*)(Src + (size_t)(b * SEQ + gr * 64 + (row & 63)) * D + h * 64 + c16 * 8); }
}
__device__ __forceinline__ u32x4 at_knorm(u32x4 raw, const float (&kgv)[8]) {
    const f16x8 v = __builtin_bit_cast(f16x8, raw); float f[8], ss = 0.f;
#pragma unroll
    for (int e = 0; e < 8; ++e) { f[e] = (float)v[e]; ss += f[e] * f[e]; }
    ss += __builtin_bit_cast(float, __builtin_amdgcn_update_dpp(0, __builtin_bit_cast(int, ss), 0xB1, 0xf, 0xf, true));
    ss += __builtin_bit_cast(float, __builtin_amdgcn_update_dpp(0, __builtin_bit_cast(int, ss), 0x4E, 0xf, 0xf, true));
    ss += __builtin_bit_cast(float, __builtin_amdgcn_update_dpp(0, __builtin_bit_cast(int, ss), 0x141, 0xf, 0xf, true));
    const float rinv = __builtin_amdgcn_rsqf(ss * (1.0f / 64.0f) + EPS);
    u32x4 o; o.x = pk2h(f[0] * rinv * kgv[0], f[1] * rinv * kgv[1]); o.y = pk2h(f[2] * rinv * kgv[2], f[3] * rinv * kgv[3]);
    o.z = pk2h(f[4] * rinv * kgv[4], f[5] * rinv * kgv[5]); o.w = pk2h(f[6] * rinv * kgv[6], f[7] * rinv * kgv[7]); return o;
}
__device__ __forceinline__ void attn_phase(Frame& F, unsigned char* ws, const float* rpb, const float* qg, const float* kg) {
    f16* Q = (f16*)(ws + WS_Q16); const f16* Kp = (const f16*)(ws + WS_K16); const f16* Vp = (const f16*)(ws + WS_V16);
    const int w = F.wave;
    LAS unsigned char* SM = F.lds;
    constexpr int NUP = NB * 16 * 64;
    u32x4 tk[AT_NPF];
    int bh_cur = -1;
    { int rp, bh, rs0; if ((int)blockIdx.x < NUP) { attn_decode(blockIdx.x, F.G, rp, bh, rs0); attn_load_band<0, AT_NPF, AT_NPF>(Kp, bh, rs0, F.tid, tk); } }
    for (int up = blockIdx.x; up < NUP; up += F.G) {
        int l_ = F.lane; asm volatile("" : "+v"(l_));
        const int l = l_, fr = l & 15, fq = l >> 4, tid = w * 64 + l;
        int rp, bh, rs0; attn_decode(up, F.G, rp, bh, rs0);
        const int b = bh >> 4, h = bh & 15;
        const int r0 = 2 * rp;
        const int r = r0 + (w >> 2), qt = w & 3;
        const int rs = min(max(r - 4, 0), 120), i0 = rs - rs0;
        const int cw = qt == 0 ? 0 : (qt == 1 ? 8 : (qt == 2 ? 24 : 32));
        const int qc = 16 * qt + fr, cs = min(max(qc - 8, 0), 48);
        const size_t qrow = (size_t)(b * SEQ + r * 64 + qc) * D + h * 64;
        float kgv[8];
#pragma unroll
        for (int e = 0; e < 8; ++e) kgv[e] = kg[(tid & 7) * 8 + e];
        u32x4 trk[9 - AT_NPF]; attn_load_band<AT_NPF, 9, 9 - AT_NPF>(Kp, bh, rs0, tid, trk);
        f16x8 q0, q1;
        { const f16x8 r0v = *(const f16x8*)(Q + qrow + 8 * fq), r1v = *(const f16x8*)(Q + qrow + 32 + 8 * fq); float f0[8], f1[8], ss = 0.f;
#pragma unroll
            for (int e = 0; e < 8; ++e) { f0[e] = (float)r0v[e]; f1[e] = (float)r1v[e]; ss += f0[e] * f0[e] + f1[e] * f1[e]; }
            ss += __shfl_xor(ss, 16); ss += __shfl_xor(ss, 32);
            const float rinv = __builtin_amdgcn_rsqf(ss * (1.0f / 64.0f) + EPS) * (0.125f * 1.4426950408889634f);
#pragma unroll
            for (int e = 0; e < 8; ++e) { q0[e] = (f16)(f0[e] * rinv * qg[8 * fq + e]); q1[e] = (f16)(f1[e] * rinv * qg[32 + 8 * fq + e]); } }
        {
#pragma unroll
        for (int it = 0; it < 9; ++it) { const int q = it * 512 + tid, row = q >> 3, c16 = q & 7; *(LAS u32x4*)(SM + row * AT_KROW + c16 * 16) = at_knorm(it < AT_NPF ? tk[it < AT_NPF ? it : 0] : trk[it >= AT_NPF ? it - AT_NPF : 0], kgv); } }
        if (bh != bh_cur) {
            bh_cur = bh;
#pragma unroll
            for (int it = 0; it < 4; ++it) { const int q = it * 512 + tid, row = q >> 3, c16 = q & 7; const size_t go = (size_t)(MLAT + b * CTX + row) * D + h * 64 + c16 * 8;
                *(LAS u32x4*)(SM + AT_KC + row * AT_KROW + c16 * 16) = at_knorm(*(const u32x4*)(Kp + go), kgv);
                *(LAS u32x4*)(SM + AT_VC + row * AT_KROW + c16 * 16) = *(const u32x4*)(Vp + go); }
            if (tid < 465) ((LAS float*)(SM + AT_TAB))[tid] = rpb[h * 465 + tid] * 1.4426950408889634f;
        }
        const LAS float* rp_ = (const LAS float*)(SM + AT_TAB);
        AT_BAR();
        f32x4 S[32];
        float mx = -INFINITY;
#pragma unroll
        for (int i = 0; i < 8; ++i)
#pragma unroll
            for (int hf = 0; hf < 2; ++hf) {
                const LAS unsigned char* kr = SM + ((i0 + i) * 64 + cw + 16 * hf + fr) * AT_KROW + 16 * fq;
                const f16x8 k0 = *(const LAS f16x8*)kr, k1 = *(const LAS f16x8*)(kr + 64);
                f32x4 sv = __builtin_amdgcn_mfma_f32_16x16x32_f16(k0, q0, (f32x4){0.f, 0.f, 0.f, 0.f}, 0, 0, 0);
                sv = __builtin_amdgcn_mfma_f32_16x16x32_f16(k1, q1, sv, 0, 0, 0);
                const int ri = rs + i - r + 7;
#pragma unroll
                for (int e = 0; e < 4; ++e) { const int kc = cw + 16 * hf + 4 * fq + e; const bool valid = (kc >= cs) && (kc < cs + 16);
                    const int ci = min(max(kc - qc + 15, 0), 30);
                    const float bz = rp_[ri * 31 + ci];
                    const float z = (sv[e] + bz) + (valid ? 0.f : -INFINITY); sv[e] = z; mx = fmaxf(mx, z); }
                S[i * 2 + hf] = sv;
            }
#pragma unroll
        for (int j = 0; j < 16; ++j) {
            const LAS unsigned char* kr = SM + AT_KC + (16 * j + fr) * AT_KROW + 16 * fq;
            const f16x8 k0 = *(const LAS f16x8*)kr, k1 = *(const LAS f16x8*)(kr + 64);
            f32x4 sv = __builtin_amdgcn_mfma_f32_16x16x32_f16(k0, q0, (f32x4){0.f, 0.f, 0.f, 0.f}, 0, 0, 0);
            sv = __builtin_amdgcn_mfma_f32_16x16x32_f16(k1, q1, sv, 0, 0, 0);
#pragma unroll
            for (int e = 0; e < 4; ++e) mx = fmaxf(mx, sv[e]);
            S[16 + j] = sv;
        }
        mx = fmaxf(mx, __shfl_xor(mx, 16)); mx = fmaxf(mx, __shfl_xor(mx, 32));
        float sum = 0.f;
        f16x4 P[32];
#pragma unroll
        for (int t = 0; t < 32; ++t) {
#pragma unroll
            for (int e = 0; e < 4; ++e) { const float p = __builtin_amdgcn_exp2f(S[t][e] - mx); sum += p; P[t][e] = (f16)p; } }
        sum += __shfl_xor(sum, 16); sum += __shfl_xor(sum, 32);
        const float rsum = __builtin_amdgcn_rcpf(sum);
        __builtin_amdgcn_sched_barrier(0);
        u32x4 tv[9];
        attn_load_band<0, 9, 9>(Vp, bh, rs0, tid, tv);
        __builtin_amdgcn_sched_barrier(0);
        AT_BAR();
#pragma unroll
        for (int it = 0; it < 9; ++it) { const int q = it * 512 + tid, row = q >> 3, c16 = q & 7; *(LAS u32x4*)(SM + row * AT_KROW + c16 * 16) = tv[it]; }
        AT_BAR();
        if (up + F.G < NUP) { int rp2, bh2, rs2; attn_decode(up + F.G, F.G, rp2, bh2, rs2); attn_load_band<0, AT_NPF, AT_NPF>(Kp, bh2, rs2, tid, tk); }
        __builtin_amdgcn_sched_barrier(0);
        f32x4 O[4];
#pragma unroll
        for (int dt = 0; dt < 4; ++dt) O[dt] = (f32x4){0.f, 0.f, 0.f, 0.f};
        const int trq = fr >> 2, trp = fr & 3;
#pragma unroll
        for (int i = 0; i < 8; ++i) {
            f16x8 pf;
#pragma unroll
            for (int e = 0; e < 4; ++e) { pf[e] = P[2 * i][e]; pf[4 + e] = P[2 * i + 1][e]; }
            const LAS unsigned char* vb_ = SM + ((i0 + i) * 64 + cw + 4 * fq + trq) * AT_KROW + 8 * trp;
#pragma unroll
            for (int dt = 0; dt < 4; ++dt) { const f16x4 va = at_vtr(vb_ + 32 * dt), vb = at_vtr(vb_ + 16 * AT_KROW + 32 * dt); f16x8 vf;
#pragma unroll
                for (int e = 0; e < 4; ++e) { vf[e] = va[e]; vf[4 + e] = vb[e]; }
                O[dt] = __builtin_amdgcn_mfma_f32_16x16x32_f16(vf, pf, O[dt], 0, 0, 0); }
        }
#pragma unroll
        for (int jp = 0; jp < 8; ++jp) {
            f16x8 pf;
#pragma unroll
            for (int e = 0; e < 4; ++e) { pf[e] = P[16 + 2 * jp][e]; pf[4 + e] = P[17 + 2 * jp][e]; }
            const LAS unsigned char* vb_ = SM + AT_VC + (32 * jp + 4 * fq + trq) * AT_KROW + 8 * trp;
#pragma unroll
            for (int dt = 0; dt < 4; ++dt) { const f16x4 va = at_vtr(vb_ + 32 * dt), vb = at_vtr(vb_ + 16 * AT_KROW + 32 * dt); f16x8 vf;
#pragma unroll
                for (int e = 0; e < 4; ++e) { vf[e] = va[e]; vf[4 + e] = vb[e]; }
                O[dt] = __builtin_amdgcn_mfma_f32_16x16x32_f16(vf, pf, O[dt], 0, 0, 0); }
        }
#pragma unroll
        for (int dt = 0; dt < 4; ++dt) { u32x2 o; o.x = pk2h(O[dt][0] * rsum, O[dt][1] * rsum); o.y = pk2h(O[dt][2] * rsum, O[dt][3] * rsum);
            *(u32x2*)(Q + qrow + 16 * dt + 4 * fq) = o; }
        AT_BAR();
    }
}

template <int NT, int MODE, int CB = 0>
__device__ __forceinline__ void ctx_gemm(Frame& F, const f16* A, int lda, const f16* Bt, int K, const pg8::Epi& E) {
    constexpr int KC = 256, PITCH = KC * 2 + 16, NROWS = 32 + 16 * NT, NLD = NROWS / 16;
    LAS unsigned char* SM = F.lds;
    const int w = F.wave, rt = w >> 2, kq = w & 3;
    for (int tile = blockIdx.x; tile < 256; tile += F.G) {
        int l_ = F.lane; asm volatile("" : "+v"(l_));
        const int l = l_, fr = l & 15, fq = l >> 4, tid = w * 64 + l;
        const int rb = tile & 15, cb = tile >> 4;
        const int row = MLAT + rb * 32 + 16 * rt + fr;
        const f16* src[NLD];
#pragma unroll
        for (int it = 0; it < NLD; ++it) { const int q = it * 512 + tid, srow = q >> 5, c16 = q & 31;
            if (srow < 32) src[it] = A + (size_t)(MLAT + rb * 32 + srow) * lda + c16 * 8;
            else { const int j = srow - 32; int brow;
                if (MODE == 3) { const int jj = cb * 64 + 16 * ((j >> 4) & 3) + (j & 15); brow = (jj >> 7) * 256 + (jj & 127) + ((j >> 4) >= 4 ? 128 : 0); }
                else brow = CB + cb * (16 * NT) + j;
                src[it] = Bt + (size_t)brow * K + c16 * 8; } }
        f32x4 fin[NT / 4];
#pragma unroll
        for (int i = 0; i < NT / 4; ++i) fin[i] = (f32x4){0.f, 0.f, 0.f, 0.f};
        u32x4 tr[NLD];
#pragma unroll
        for (int it = 0; it < NLD; ++it) tr[it] = *(const u32x4*)src[it];
        for (int kc = 0; kc < K; kc += KC) {
            __syncthreads();
#pragma unroll
            for (int it = 0; it < NLD; ++it) { const int q = it * 512 + tid; *(LAS u32x4*)(SM + (q >> 5) * PITCH + (q & 31) * 16) = tr[it]; }
            __syncthreads();
            if (kc + KC < K) {
#pragma unroll
                for (int it = 0; it < NLD; ++it) tr[it] = *(const u32x4*)(src[it] + kc + KC);
            }
#pragma unroll
            for (int ks = 0; ks < KC / 32; ++ks) { const f16x8 av = *(const LAS f16x8*)(SM + (16 * rt + fr) * PITCH + ks * 64 + 16 * fq);
#pragma unroll
                for (int i = 0; i < NT / 4; ++i) { const f16x8 bv = *(const LAS f16x8*)(SM + (32 + 16 * (kq + 4 * i) + fr) * PITCH + ks * 64 + 16 * fq);
                    fin[i] = __builtin_amdgcn_mfma_f32_16x16x32_f16(bv, av, fin[i], 0, 0, 0); } }
        }
        if (MODE == 0) {
            const float rinv = __builtin_amdgcn_rsqf(E.ss[row] * (1.0f / 1024.0f) + 1e-6f);
#pragma unroll
            for (int i = 0; i < NT / 4; ++i) { int col = CB + cb * (16 * NT) + 16 * (kq + 4 * i) + 4 * fq; f16* base = E.O16;
                const f32x4 v = fin[i] * rinv + *(const f32x4*)(E.bias + 2 * 5632 + col);
                if (E.split_cols) { const int t = col / E.split_cols; base += (size_t)t * E.split_stride; col -= t * E.split_cols; }
                u32x2 o; o.x = pk2h(v[0], v[1]); o.y = pk2h(v[2], v[3]);
                *(u32x2*)(base + (size_t)row * E.ldo + col) = o; }
        } else {
            const int col = cb * 64 + 16 * kq + 4 * fq; const size_t off = (size_t)row * D + col;
            const f32x4 xs = *(const f32x4*)(E.Xs + off); f32x4 xn;
            if (MODE == 2) { const f32x4 gv = *(const f32x4*)(E.gate + 2 * 9216 + col) * E.coef; xn = xs + gv * fin[0]; }
            else { const f32x4 gv = *(const f32x4*)(E.gate + 2 * 9216 + col);
#pragma unroll
                for (int e = 0; e < 4; ++e) xn[e] = xs[e] + gv[e] * fin[0][e] * sigmoidf_(fin[NT / 4 - 1][e]); }
            *(f32x4*)(E.Xd + off) = xn;
            if (E.An) { const f32x4 a0 = xn * *(const f32x4*)(E.gsn + 2 * 1024 + col);
                u32x2 o; o.x = pk2h(a0[0], a0[1]); o.y = pk2h(a0[2], a0[3]);
                *(u32x2*)(E.An + off) = o;
                float sq = (xn[0] * xn[0] + xn[1] * xn[1]) + (xn[2] * xn[2] + xn[3] * xn[3]);
                sq += __shfl_xor(sq, 16); sq += __shfl_xor(sq, 32); if (fq == 0) atomicAdd(E.ssn + row, sq); }
        }
        __syncthreads();
    }
}

#define XB_TMO      128
#define XB_XCNT(j)  (256  + 64 * (j))
#define XB_XSUB(j)  (1280 + 64 * (j))
#define XB_XGEN(j)  (2304 + 64 * (j))
#define XB_TOP      3328
#define XB_TOPGEN   3392
#define XCD_BAR_WORDS 3456
#define XB_SPIN_CAP (1u << 18)

__device__ __forceinline__ unsigned xb_ld(unsigned* p)              { return __hip_atomic_load(p, __ATOMIC_RELAXED, __HIP_MEMORY_SCOPE_AGENT); }
__device__ __forceinline__ unsigned xb_add(unsigned* p, unsigned v) { return __hip_atomic_fetch_add(p, v, __ATOMIC_RELAXED, __HIP_MEMORY_SCOPE_AGENT); }
__device__ __forceinline__ unsigned xb_xcc_id() { return (unsigned)__builtin_amdgcn_s_getreg((3 << 11) | 20) & 0xFu; }
#define XB_SPIN(cond, bar) do { unsigned _sp = 0; while (cond) { __builtin_amdgcn_s_sleep(1); \
    if ((++_sp & 255u) == 0u) { if (xb_ld(&(bar)[XB_TMO])) break; if (_sp > XB_SPIN_CAP) { atomicAdd(&(bar)[XB_TMO], 1u); break; } } } } while (0)

struct XcdBarrier {
    unsigned* bar; unsigned x;
    volatile LAS unsigned* st;
};

__device__ __forceinline__ XcdBarrier xcd_barrier_post(unsigned* bar, volatile LAS unsigned* st) {
    XcdBarrier b; b.bar = bar; b.x = xb_xcc_id(); b.st = st;
    if (threadIdx.x == 0) (void)xb_add(&bar[XB_XCNT(b.x)], 1u);
    return b;
}
__device__ __forceinline__ void xcd_barrier_complete(unsigned* bar, unsigned x, unsigned& nloc, unsigned& nx) {
    const unsigned G = gridDim.x * gridDim.y * gridDim.z;
    unsigned sum, cnt, mine, sp = 0u;
    for (;;) {
        sum = 0u; cnt = 0u; mine = 0u;
#pragma unroll
        for (unsigned j = 0; j < 16; ++j) { const unsigned c = xb_ld(&bar[XB_XCNT(j)]); sum += c; cnt += (c > 0u) ? 1u : 0u; mine = (j == x) ? c : mine; }
        if (sum == G) break;
        __builtin_amdgcn_s_sleep(1);
        if ((++sp & 255u) == 0u) { if (xb_ld(&bar[XB_TMO])) break; if (sp > XB_SPIN_CAP) { atomicAdd(&bar[XB_TMO], 1u); break; } }
    }
    nloc = mine > 0u ? mine : 1u; nx = cnt > 0u ? cnt : 1u;
}

__device__ __forceinline__ void xcd_barrier(const XcdBarrier& b) {
    asm volatile("s_waitcnt vmcnt(0)" ::: "memory");
    __syncthreads();
    if (threadIdx.x == 0) {
        unsigned* bar = b.bar;
        __builtin_amdgcn_s_waitcnt(0);
        unsigned nloc = b.st[0], nx = b.st[1];
        if (nloc == 0u) { xcd_barrier_complete(bar, b.x, nloc, nx); b.st[0] = nloc; b.st[1] = nx; }
        const unsigned old = xb_add(&bar[XB_XSUB(b.x)], 1u);
        const unsigned gen = old / nloc;
        if (old + 1u == (gen + 1u) * nloc) {
            __builtin_amdgcn_fence(__ATOMIC_RELEASE, "agent");
            asm volatile("s_waitcnt vmcnt(0)" ::: "memory");
            const unsigned og = xb_add(&bar[XB_TOP], 1u);
            const unsigned tg = og / nx;
            if (og + 1u == (tg + 1u) * nx) xb_add(&bar[XB_TOPGEN], 1u);
            else XB_SPIN(xb_ld(&bar[XB_TOPGEN]) == tg, bar);
            __builtin_amdgcn_fence(__ATOMIC_ACQUIRE, "agent");
            xb_add(&bar[XB_XGEN(b.x)], 1u);
            asm volatile("s_waitcnt vmcnt(0)" ::: "memory");
        } else {
            XB_SPIN(xb_ld(&bar[XB_XGEN(b.x)]) == gen, bar);
            __builtin_amdgcn_fence(__ATOMIC_ACQUIRE, "agent");
            asm volatile("s_waitcnt vmcnt(0)" ::: "memory");
        }
    }
    __syncthreads();
}

__global__ void __launch_bounds__(512, 2) fwd_megakernel(Args args) {
    extern __shared__ __attribute__((aligned(16))) unsigned char lds_raw[];
    Frame F;
    F.lds = (LAS unsigned char*)lds_raw;
    F.tid = threadIdx.x; F.lane = F.tid & 63; F.wave = __builtin_amdgcn_readfirstlane(F.tid >> 6);
    F.G = gridDim.x; { const int bx = blockIdx.x; F.vcu = (F.G % 8 == 0) ? (bx % 8) * (F.G / 8) + bx / 8 : bx; }
    unsigned char* ws = args.ws;
    float* MOD = (float*)(ws + WS_MOD); float* X = (float*)(ws + WS_X); f16* H16 = (f16*)(ws + WS_H16); f16* HID = (f16*)(ws + WS_HID);
    const float* norm_g = args.in[4];
    cg::grid_group grid = cg::this_grid();
    volatile LAS unsigned* bst = (volatile LAS unsigned*)(F.lds + LDS_BYTES - 16);
    if (F.tid < 4) bst[F.tid] = 0u;
    __syncthreads();
    XcdBarrier xbar = xcd_barrier_post((unsigned*)(ws + WS_BAR), bst);

    const int lo = args.ph_lo, hi = args.ph_hi;
    if (hi > (1 << 20)) grid.sync();
#define IN(k) (lo <= (k) && (k) < hi)
#define SEAM(k) do { if (IN(k) && IN((k) + 1)) xcd_barrier(xbar); asm volatile("" : "+v"(F.tid), "+v"(F.lane)); } while (0)
#define RUN_GEMM(Ap, Bp, Mr, Nc, Kc) do { pg8::Gemm g{(const u16*)(Ap), (const u16*)(Bp), (Mr), (Nc), (Kc)}; pg8::StaticOrder S; S.init(g.M, g.N, F.G, (int)blockIdx.x); pg8::gemm_phase(F.lds, g, S, E); } while (0)
#define CONV_TAIL(job) do { const int rem_ = (66 * 22) % F.G; \
        if (rem_ == 0) conv_job(F, args, (job), F.vcu * 8 + F.wave, F.G * 8); \
        else if ((int)blockIdx.x >= rem_) conv_job(F, args, (job), ((int)blockIdx.x - rem_) * 8 + F.wave, (F.G - rem_) * 8); } while (0)
#define SSP(sl) ((float*)(ws + WS_SS) + (size_t)(sl) * MALL)
#define GSP(sl) ((const float*)(ws + WS_GS) + (sl) * 3072)
#define BIASP(sl) ((const float*)(ws + WS_BIAS) + (sl) * 3 * 5632)
#define EPI_F16(dst, ld, sc, sst, sl) pg8::Epi E{(dst), (sst), nullptr, nullptr, nullptr, SSP(sl), BIASP(sl), nullptr, nullptr, nullptr, 0, (ld), (sc), 0.f}
#define EPI_SWIGLU(sl) pg8::Epi E{HID, 0, nullptr, nullptr, nullptr, SSP(sl), BIASP(sl), nullptr, nullptr, nullptr, 1, FH, 0, 0.f}
#define EPI_RES(md, dst, gt, cf, nsl) pg8::Epi E{nullptr, 0, X, (dst), (gt), nullptr, nullptr, (nsl) >= 0 ? H16 : nullptr, GSP((nsl) >= 0 ? (nsl) : 0), SSP((nsl) >= 0 ? (nsl) : 0), (md), 0, 0, (cf)}
    if (IN(0)) { p0_phase(F, args); } SEAM(0);
    if (IN(1)) { p1_phase(F, args); } SEAM(1);
    if (IN(2)) { EPI_SWIGLU(0); RUN_GEMM(H16, ws + WS_WFI + 0 * WFI_SZ, MALL, 5632, 1024); CONV_TAIL(1); } SEAM(2);
#if REP_FFNIN > 1
    if (IN(2)) { EPI_SWIGLU(0); RUN_GEMM(H16, ws + WS_WFI + 0 * WFI_SZ, MALL, 5632, 1024); } SEAM(2);
#endif
    if (IN(3)) { EPI_RES(2, X, MOD + 0 * 3072 + 2048, 0.5f, 1); RUN_GEMM(HID, ws + WS_WFO + 0 * WFO_SZ, MLAT, 1024, FH); ctx_gemm<4, 2>(F, HID, FH, (const f16*)(ws + WS_WFO + 0 * WFO_SZ), FH, E); bias_rows(F, args, 1, 2); } SEAM(3);
    if (IN(5)) { EPI_F16((f16*)(ws + WS_U16), D, 0, 0, 1); RUN_GEMM(H16, ws + WS_WSI, MLAT, 1024, 1024); ctx_gemm<4, 0>(F, H16, D, (const f16*)(ws + WS_WSI), 1024, E); } SEAM(5);
    if (IN(6)) { s5_pass<false>(F, ws, args.in[17]); } SEAM(6);
#if REP_S5 == 2
    if (IN(6)) { s5_pass<false>(F, ws, args.in[17]); } SEAM(6);
#endif
    if (IN(7)) { s5_carry(F, ws); } SEAM(7);
    if (IN(8)) { s5_pass<true>(F, ws, args.in[17]); } SEAM(8);
#if REP_S5 == 4
    if (IN(8)) { s5_pass<true>(F, ws, args.in[17]); } SEAM(8);
#endif
    if (IN(9)) { EPI_RES(3, X, MOD + 1 * 3072 + 2048, 1.f, 2); RUN_GEMM(ws + WS_G16, ws + WS_WGLU, MLAT, 2048, 1024); ctx_gemm<8, 3>(F, (const f16*)(ws + WS_G16), D, (const f16*)(ws + WS_WGLU), 1024, E); } SEAM(9);
    if (IN(11)) { EPI_SWIGLU(2); RUN_GEMM(H16, ws + WS_WFI + 1 * WFI_SZ, MALL, 5632, 1024); CONV_TAIL(2); } SEAM(11);
    if (IN(12)) { EPI_RES(2, X, MOD + 2 * 3072 + 2048, 0.5f, 3); RUN_GEMM(HID, ws + WS_WFO + 1 * WFO_SZ, MLAT, 1024, FH); ctx_gemm<4, 2>(F, HID, FH, (const f16*)(ws + WS_WFO + 1 * WFO_SZ), FH, E); bias_rows(F, args, 3, 4); } SEAM(12);
    if (IN(14)) { EPI_SWIGLU(3); RUN_GEMM(H16, ws + WS_WFI + 2 * WFI_SZ, MALL, 5632, 1024); CONV_TAIL(3); } SEAM(14);
    if (IN(15)) { EPI_RES(2, X, MOD + 3 * 9216 + 0 * 3072 + 2048, 0.5f, 4); RUN_GEMM(HID, ws + WS_WFO + 2 * WFO_SZ, MLAT, 1024, FH); ctx_gemm<4, 2>(F, HID, FH, (const f16*)(ws + WS_WFO + 2 * WFO_SZ), FH, E); bias_rows(F, args, 5, 5); } SEAM(15);
    if (IN(17)) { EPI_F16((f16*)(ws + WS_Q16), D, 1024, (size_t)MALL * D, 4); RUN_GEMM(H16, ws + WS_WQKV, MLAT, 3072, 1024); ctx_gemm<8, 0, 1024>(F, H16, D, (const f16*)(ws + WS_WQKV), 1024, E); } SEAM(17);
    if (IN(19)) { attn_phase(F, ws, args.in[22], args.in[20], args.in[21]); } SEAM(19);
#if REP_ATTN > 1
    if (IN(19)) { attn_phase(F, ws, args.in[22], args.in[20], args.in[21]); } SEAM(19);
#endif
    if (IN(20)) { EPI_RES(2, X, MOD + 3 * 9216 + 1 * 3072 + 2048, 1.f, 5); RUN_GEMM(ws + WS_Q16, ws + WS_WO, MLAT, 1024, 1024); } SEAM(20);
    if (IN(22)) { EPI_SWIGLU(5); RUN_GEMM(H16, ws + WS_WFI + 3 * WFI_SZ, MLAT, 5632, 1024); } SEAM(22);
    if (IN(23)) { EPI_RES(2, args.out, MOD + 3 * 9216 + 2 * 3072 + 2048, 0.5f, -1); RUN_GEMM(HID, ws + WS_WFO + 3 * WFO_SZ, MLAT, 1024, FH); }
}

extern "C" void kernel_launch(void* const* d_in, const int* in_sizes, int n_in, void* d_out, int out_size, void* d_ws, size_t ws_size, hipStream_t stream) {
    static int grid = 0;
    if (grid == 0) {
        if (n_in != 24 || ws_size < WS_END) { fprintf(stderr, "kernel_launch: unexpected n_in %d or ws_size %zu (< %zu)\n", n_in, ws_size, (size_t)WS_END); grid = -1; return; }
        int dev = 0, cus = 0, per_cu = 0;
        hipGetDevice(&dev); hipDeviceGetAttribute(&cus, hipDeviceAttributeMultiprocessorCount, dev);
        if (hipFuncSetAttribute((const void*)fwd_megakernel, hipFuncAttributeMaxDynamicSharedMemorySize, LDS_BYTES) != hipSuccess) { fprintf(stderr, "kernel_launch: hipFuncSetAttribute failed\n"); }
        if (hipOccupancyMaxActiveBlocksPerMultiprocessor(&per_cu, (const void*)fwd_megakernel, 512, LDS_BYTES) != hipSuccess || per_cu < 1) { fprintf(stderr, "kernel_launch: occupancy query says %d\n", per_cu); per_cu = 1; }
        (void)hipGetLastError();
        grid = cus * 1;
        if (grid <= 0) grid = 256;
    }
    if (grid < 0) return;
    hipMemsetAsync((char*)d_ws + WS_MOD, 0, MOD_BYTES, stream);
    Args a{};
    for (int i = 0; i < 24; ++i) a.in[i] = (const float*)d_in[i];
    a.out = (float*)d_out; a.ws = (unsigned char*)d_ws;
#if MK_COOP
    a.ph_lo = 0; a.ph_hi = NPHASE;
    void* kargs[] = {&a};
    hipError_t e = hipLaunchCooperativeKernel((const void*)fwd_megakernel, dim3(grid), dim3(512), kargs, LDS_BYTES, stream);
    if (e != hipSuccess) fprintf(stderr, "cooperative launch failed: %s (grid %d)\n", hipGetErrorString(e), grid);
#else
    for (int ph = 0; ph < NPHASE; ++ph) {
        a.ph_lo = ph; a.ph_hi = ph + 1;
        hipLaunchKernelGGL(fwd_megakernel, dim3(grid), dim3(512), LDS_BYTES, stream, a);
    }
#endif
}
```

```cpp
#include <hip/hip_runtime.h>
#include <hip/hip_cooperative_groups.h>
#include <cstdio>
#include <cstdint>
namespace cg = cooperative_groups;

#ifndef REP_S5
#define REP_S5 1
#endif
#ifndef REP_ATTN
#define REP_ATTN 1
#endif
#ifndef REP_FFNIN
#define REP_FFNIN 1
#endif
#ifndef REP_NORM
#define REP_NORM 1
#endif
#ifndef REP_CONV
#define REP_CONV 1
#endif
#ifndef MK_COOP
#define MK_COOP 1
#endif

#define LAS __attribute__((address_space(3)))
typedef _Float16 f16;
typedef f16 f16x8 __attribute__((ext_vector_type(8)));
typedef f16 f16x4 __attribute__((ext_vector_type(4)));
typedef f16 f16x2 __attribute__((ext_vector_type(2)));
typedef float f32x4 __attribute__((ext_vector_type(4)));
typedef float f32x2 __attribute__((ext_vector_type(2)));
typedef unsigned u32x4 __attribute__((ext_vector_type(4)));
typedef unsigned u32x2 __attribute__((ext_vector_type(2)));
typedef unsigned short u16;

constexpr int D = 1024, SEQ = 8192, NB = 2, CTX = 256, FH = 2816;
constexpr int MLAT = NB * SEQ;
constexpr int MALL = MLAT + NB * CTX;
constexpr int NCH = 132;
constexpr float EPS = 1e-6f;

constexpr size_t MiB = 1u << 20;
constexpr size_t WS_MOD = 0;
constexpr size_t MOD_BYTES = 262144;
constexpr size_t WS_BAR = 229376;
constexpr size_t WS_LAM = 262144;
constexpr size_t WS_LAMT = WS_LAM + 65536;
constexpr size_t WS_BMAT = WS_LAMT + 65536;
constexpr size_t WS_CMAT = WS_BMAT + 524288;
constexpr size_t WS_WFI = 2 * MiB;
constexpr size_t WFI_SZ = (size_t)5632 * 1024 * 2;
constexpr size_t WS_WFO = WS_WFI + 4 * WFI_SZ;
constexpr size_t WFO_SZ = (size_t)1024 * 2816 * 2;
constexpr size_t WS_WSI = WS_WFO + 4 * WFO_SZ;
constexpr size_t WS_WGLU = WS_WSI + 2 * MiB;
constexpr size_t WS_WQKV = WS_WGLU + 4 * MiB;
constexpr size_t WS_WO = WS_WQKV + 6 * MiB;
constexpr size_t WS_X = 82 * MiB;
constexpr size_t WS_H16 = 148 * MiB;
constexpr size_t WS_R = 181 * MiB;
constexpr size_t WS_HID = WS_R;
constexpr size_t WS_U16 = WS_R;
constexpr size_t WS_G16 = WS_R + 33 * MiB;
constexpr size_t WS_E = WS_R + 66 * MiB;
constexpr size_t WS_CIN = WS_R + 83 * MiB;
constexpr size_t WS_Q16 = WS_R;
constexpr size_t WS_K16 = WS_R + 33 * MiB;
constexpr size_t WS_V16 = WS_R + 66 * MiB;
constexpr size_t WS_VT = WS_R + 99 * MiB;
constexpr size_t WS_VTC = WS_R + 131 * MiB;
constexpr size_t WS_SS = WS_CMAT + 524288;
constexpr size_t WS_GS = WS_SS + (size_t)6 * 16896 * 4;
constexpr size_t WS_BIAS = 313 * MiB;
constexpr size_t WS_END = 314 * MiB;
static_assert(WS_GS + 6 * 3 * 1024 * 4 <= 2 * MiB, "small tables below the weights");
static_assert(WS_WO + 2 * MiB == WS_X, "weights end at X");

constexpr int LDS_BYTES = 163840;
constexpr int NPHASE = 24;

namespace pg8 {
constexpr int BM = 256, BK = 64, HALF = 128, HTB = HALF * BK * 2, STAGE_BYTES = 8 * HTB, NXCD = 8, WGM = 8;
__host__ __device__ __forceinline__ int lds_byte(int r, int c) { const int st = (r >> 4) * 2 + (c >> 5), rr = r & 15, cc = c & 31, ob = rr * 64 + cc * 2; return st * 1024 + (ob ^ (((ob >> 9) & 1) << 5)); }
__host__ __device__ __forceinline__ void stage_rc(int b, int& R, int& C) { const int st = b / 1024, sb = b % 1024, swz = sb ^ (((sb >> 9) & 1) << 5); R = (st >> 1) * 16 + swz / 64; C = (st & 1) * 32 + (swz % 64) / 2; }
__host__ __device__ __forceinline__ int perm32(int rho) { const int n = rho >> 4, i = rho & 15; return 8 * (i >> 2) + 4 * n + (i & 3); }

struct Unit { int pm, pn; };
struct Gemm { const u16* A; const u16* Bt; int M, N, K; };

struct StaticOrder {
    int nM, nN, nwg, G, c;
    __device__ void init(int M, int N, int G_, int c_) { nM = M / BM; nN = N / BM; nwg = nM * nN; G = G_; c = c_; }
    __device__ bool next(int i, Unit& u) const {
        const long L = (long)i * G + c; if (L >= nwg) return false;
        int wgid = (int)L; { const int q = nwg / NXCD, r = nwg % NXCD, xcd = wgid % NXCD, off = wgid / NXCD; wgid = (xcd < r ? xcd * (q + 1) : r * (q + 1) + (xcd - r) * q) + off; }
        const int nig = WGM * nN, gid = wgid / nig, fm = gid * WGM, gsz = (nM - fm) < WGM ? (nM - fm) : WGM;
        u.pm = fm + ((wgid % nig) % gsz); u.pn = (wgid % nig) / gsz; return true;
    }
};

__device__ __forceinline__ unsigned pk2h(float a, float b) { f16x2 v; v.x = (f16)a; v.y = (f16)b; return __builtin_bit_cast(unsigned, v); }
__device__ __forceinline__ float sigmoidf_(float x) { return __builtin_amdgcn_rcpf(1.0f + __expf(-x)); }

struct Epi {
    static constexpr bool PERM = true;
    f16* O16; size_t split_stride;
    const float* Xs; float* Xd; const float* gate;
    const float* ss; const float* bias;
    f16* An; const float* gsn; float* ssn;
    int mode;
    int ldo; int split_cols; float coef;
    __device__ __forceinline__ void operator()(const f32x4 (&acc)[2][2][4][2], const Unit& u, int wr, int wc, int fr, int fq) const {
        const int row0 = u.pm * BM + wr * 64 + fr;
        const int rowt = u.pm * BM; const int mi = rowt < SEQ ? 0 : (rowt < MLAT ? 1 : 2);
        if (mode == 0) {
            int colt = u.pn * BM; f16* base = O16;
            const float* bp = bias + mi * 5632 + colt + wc * 32 + 8 * fq;
            if (split_cols) { const int t = colt / split_cols; base += (size_t)t * split_stride; colt -= t * split_cols; }
            const int col0 = colt + wc * 32 + 8 * fq;
            f32x4 bv[2][2];
#pragma unroll
            for (int bj = 0; bj < 2; ++bj)
#pragma unroll
                for (int n = 0; n < 2; ++n) bv[bj][n] = *(const f32x4*)(bp + bj * HALF + 4 * n);
#pragma unroll
            for (int ai = 0; ai < 2; ++ai)
#pragma unroll
                for (int m = 0; m < 4; ++m) { const int row = row0 + ai * HALF + m * 16; f16* rowp = base + (size_t)row * ldo + col0;
                    const float rinv = __builtin_amdgcn_rsqf(ss[row] * (1.0f / 1024.0f) + 1e-6f);
#pragma unroll
                    for (int bj = 0; bj < 2; ++bj) { const f32x4 v0 = acc[ai][bj][m][0] * rinv + bv[bj][0], v1 = acc[ai][bj][m][1] * rinv + bv[bj][1];
                        u32x4 w; w.x = pk2h(v0[0], v0[1]); w.y = pk2h(v0[2], v0[3]); w.z = pk2h(v1[0], v1[1]); w.w = pk2h(v1[2], v1[3]);
                        *(u32x4*)(rowp + bj * HALF) = w; } }
        } else if (mode == 1) {
            const int col0 = u.pn * HALF + wc * 32 + 8 * fq;
            const float* bp = bias + mi * 5632 + u.pn * BM + wc * 32 + 8 * fq;
            f32x4 bv[2][2];
#pragma unroll
            for (int bj = 0; bj < 2; ++bj)
#pragma unroll
                for (int n = 0; n < 2; ++n) bv[bj][n] = *(const f32x4*)(bp + bj * HALF + 4 * n);
#pragma unroll
            for (int ai = 0; ai < 2; ++ai)
#pragma unroll
                for (int m = 0; m < 4; ++m) { const int row = row0 + ai * HALF + m * 16; f16* rowp = O16 + (size_t)row * ldo + col0;
                    const float rinv = __builtin_amdgcn_rsqf(ss[row] * (1.0f / 1024.0f) + 1e-6f);
                    float h[8];
#pragma unroll
                    for (int n = 0; n < 2; ++n)
#pragma unroll
                        for (int e = 0; e < 4; ++e) { const float g = acc[ai][0][m][n][e] * rinv + bv[0][n][e], up = acc[ai][1][m][n][e] * rinv + bv[1][n][e]; h[n * 4 + e] = g * sigmoidf_(g) * up; }
                    u32x4 w; w.x = pk2h(h[0], h[1]); w.y = pk2h(h[2], h[3]); w.z = pk2h(h[4], h[5]); w.w = pk2h(h[6], h[7]);
                    *(u32x4*)rowp = w; }
        } else {
            const float* gp = gate + mi * 9216;
            if (mode == 2) {
                const int col0 = u.pn * BM + wc * 32 + 8 * fq;
                f32x4 gv[2][2], gs[2][2];
#pragma unroll
                for (int bj = 0; bj < 2; ++bj)
#pragma unroll
                    for (int n = 0; n < 2; ++n) { gv[bj][n] = *(const f32x4*)(gp + col0 + bj * HALF + 4 * n) * coef;
                        gs[bj][n] = *(const f32x4*)(gsn + mi * 1024 + col0 + bj * HALF + 4 * n); }
#pragma unroll
                for (int ai = 0; ai < 2; ++ai) {
#pragma unroll
                  for (int mp = 0; mp < 2; ++mp) {
                    f32x4 xpre[4][2][2];
#pragma unroll
                    for (int m = 2 * mp; m < 2 * mp + 2; ++m)
#pragma unroll
                        for (int bj = 0; bj < 2; ++bj)
#pragma unroll
                            for (int n = 0; n < 2; ++n) xpre[m][bj][n] = *(const f32x4*)(Xs + (size_t)(row0 + ai * HALF + m * 16) * D + col0 + bj * HALF + 4 * n);
                    asm volatile("" ::: "memory");
#pragma unroll
                    for (int m = 2 * mp; m < 2 * mp + 2; ++m) { const int row = row0 + ai * HALF + m * 16; const size_t off = (size_t)row * D + col0; float sq = 0.f;
#pragma unroll
                        for (int bj = 0; bj < 2; ++bj) { f32x4 xn[2];
#pragma unroll
                            for (int n = 0; n < 2; ++n) { const f32x4 xs = xpre[m][bj][n];
                                xn[n] = xs + gv[bj][n] * acc[ai][bj][m][n];
                                *(f32x4*)(Xd + off + bj * HALF + 4 * n) = xn[n];
                                sq += (xn[n][0] * xn[n][0] + xn[n][1] * xn[n][1]) + (xn[n][2] * xn[n][2] + xn[n][3] * xn[n][3]); }
                            if (An) { const f32x4 a0 = xn[0] * gs[bj][0], a1 = xn[1] * gs[bj][1];
                                u32x4 w; w.x = pk2h(a0[0], a0[1]); w.y = pk2h(a0[2], a0[3]); w.z = pk2h(a1[0], a1[1]); w.w = pk2h(a1[2], a1[3]);
                                *(u32x4*)(An + off + bj * HALF) = w; } }
                        if (An) { sq += __shfl_xor(sq, 16); sq += __shfl_xor(sq, 32); if (fq == 0) atomicAdd(ssn + row, sq); } }
                  }
                }
            } else {
                const int col0 = u.pn * HALF + wc * 32 + 8 * fq;
                f32x4 gv[2], gs[2];
#pragma unroll
                for (int n = 0; n < 2; ++n) { gv[n] = *(const f32x4*)(gp + col0 + 4 * n); gs[n] = *(const f32x4*)(gsn + mi * 1024 + col0 + 4 * n); }
#pragma unroll
                for (int ai = 0; ai < 2; ++ai) {
                    f32x4 xpre[4][2];
#pragma unroll
                    for (int m = 0; m < 4; ++m)
#pragma unroll
                        for (int n = 0; n < 2; ++n) xpre[m][n] = *(const f32x4*)(Xs + (size_t)(row0 + ai * HALF + m * 16) * D + col0 + 4 * n);
                    asm volatile("" ::: "memory");
#pragma unroll
                    for (int m = 0; m < 4; ++m) { const int row = row0 + ai * HALF + m * 16; const size_t off = (size_t)row * D + col0; float sq = 0.f; f32x4 xn[2];
#pragma unroll
                        for (int n = 0; n < 2; ++n) { const f32x4 xs = xpre[m][n]; const f32x4 a = acc[ai][0][m][n], b = acc[ai][1][m][n];
#pragma unroll
                            for (int e = 0; e < 4; ++e) xn[n][e] = xs[e] + gv[n][e] * a[e] * sigmoidf_(b[e]);
                            *(f32x4*)(Xd + off + 4 * n) = xn[n];
                            sq += (xn[n][0] * xn[n][0] + xn[n][1] * xn[n][1]) + (xn[n][2] * xn[n][2] + xn[n][3] * xn[n][3]); }
                        const f32x4 a0 = xn[0] * gs[0], a1 = xn[1] * gs[1];
                        u32x4 w; w.x = pk2h(a0[0], a0[1]); w.y = pk2h(a0[2], a0[3]); w.z = pk2h(a1[0], a1[1]); w.w = pk2h(a1[2], a1[3]);
                        *(u32x4*)(An + off) = w;
                        sq += __shfl_xor(sq, 16); sq += __shfl_xor(sq, 32); if (fq == 0) atomicAdd(ssn + row, sq); }
                }
            }
        }
    }
};

__device__ __forceinline__ void gemm_phase(LAS unsigned char* lds, const Gemm g, const StaticOrder& S, const Epi& E) {
    int tid_ = threadIdx.x; asm volatile("" : "+v"(tid_));
    const int tid = tid_, wid = __builtin_amdgcn_readfirstlane(tid >> 6), lane = tid & 63, wr = wid >> 2, wc = wid & 3, fr = lane & 15, fq = lane >> 4;
    const int K = g.K, nt = K / BK;
    unsigned voffA[2], voffB[2];
#pragma unroll
    for (int i = 0; i < 2; ++i) { int R, C; stage_rc(tid * 16 + i * 8192, R, C); const int Rb = Epi::PERM ? ((R & ~31) + perm32(R & 31)) : R;
        voffA[i] = (unsigned)(R * K + C) * 2u; voffB[i] = (unsigned)(Rb * K + C) * 2u; }
    const size_t kstep = (size_t)(BK * 2);
    const size_t hstep = (size_t)HALF * K * 2;
    const size_t tstep = 2 * hstep;
    const unsigned ldsw = (unsigned)wid * 1024u;
    const int aoff = lds_byte(wr * 64 + fr, fq * 8), boff = lds_byte(wc * 32 + fr, fq * 8);
#define PG8_SA(b, h) (((b) * 2 + (h)) * HTB)
#define PG8_SB(b, h) ((4 + (b) * 2 + (h)) * HTB)
#define PG8_STAGE(bufoff, gbase, voff) do { _Pragma("unroll") for (int _i = 0; _i < 2; ++_i) \
        __builtin_amdgcn_global_load_lds((const unsigned*)((const char*)(gbase) + (voff)[_i]), (LAS unsigned*)(lds + (bufoff) + ldsw + _i * 8192), 16, 0, 0); } while (0)
#define PG8_LDA(dst, b, h) do { _Pragma("unroll") for (int m = 0; m < 4; ++m) _Pragma("unroll") for (int k = 0; k < 2; ++k) dst[m][k] = *(const LAS f16x8*)(lds + PG8_SA(b, h) + aoff + m * 2048 + k * 1024); } while (0)
#define PG8_LDB(dst, b, h) do { _Pragma("unroll") for (int n = 0; n < 2; ++n) _Pragma("unroll") for (int k = 0; k < 2; ++k) dst[n][k] = *(const LAS f16x8*)(lds + PG8_SB(b, h) + boff + n * 2048 + k * 1024); } while (0)
#define PG8_MMA(ai, bj, At, Bt) do { __builtin_amdgcn_s_setprio(1); _Pragma("unroll") for (int m = 0; m < 4; ++m) _Pragma("unroll") for (int n = 0; n < 2; ++n) _Pragma("unroll") for (int k = 0; k < 2; ++k) \
        acc[ai][bj][m][n] = __builtin_amdgcn_mfma_f32_16x16x32_f16(Bt[n][k], At[m][k], acc[ai][bj][m][n], 0, 0, 0); __builtin_amdgcn_s_setprio(0); } while (0)
#define PG8_WAIT_V(n) asm volatile("s_waitcnt vmcnt(" #n ")" ::: "memory")
#define PG8_WAIT_L(n) asm volatile("s_waitcnt lgkmcnt(" #n ")" ::: "memory")
#define PG8_BAR __builtin_amdgcn_s_barrier()
#define PG8_SCHED __builtin_amdgcn_sched_barrier(0)
    Unit cur, nxt; int ui = 0;
    if (!S.next(0, cur)) return;
    f32x4 acc[2][2][4][2];
#pragma unroll
    for (int a = 0; a < 2; ++a)
#pragma unroll
        for (int b = 0; b < 2; ++b)
#pragma unroll
            for (int m = 0; m < 4; ++m)
#pragma unroll
                for (int n = 0; n < 2; ++n) acc[a][b][m][n] = (f32x4){0.f, 0.f, 0.f, 0.f};
    f16x8 At[4][2], B0[2][2], B1[2][2];
    const char* cA = (const char*)g.A + (size_t)cur.pm * tstep; const char* cB = (const char*)g.Bt + (size_t)cur.pn * tstep;
    PG8_STAGE(PG8_SB(0, 0), cB, voffB); PG8_STAGE(PG8_SB(0, 1), cB + hstep, voffB); PG8_STAGE(PG8_SA(0, 0), cA, voffA); PG8_STAGE(PG8_SA(0, 1), cA + hstep, voffA);
    if (wr == 1) PG8_BAR;
    PG8_WAIT_V(2); PG8_BAR;
    PG8_STAGE(PG8_SB(1, 0), cB + kstep, voffB); PG8_STAGE(PG8_SA(1, 0), cA + kstep, voffA); PG8_STAGE(PG8_SB(1, 1), cB + hstep + kstep, voffB);
    PG8_WAIT_V(6); PG8_BAR;
    for (;;) {
        const bool has_next = S.next(ui + 1, nxt);
        const char* nA = has_next ? (const char*)g.A + (size_t)nxt.pm * tstep : cA; const char* nB = has_next ? (const char*)g.Bt + (size_t)nxt.pn * tstep : cB;
        for (int t = 0; t < nt; t += 2) {
            const bool last = (t == nt - 2);
            const char* a1 = cA + (size_t)(t + 1) * kstep;
            const char* a2 = last ? nA : cA + (size_t)(t + 2) * kstep; const char* b2 = last ? nB : cB + (size_t)(t + 2) * kstep;
            const char* a3 = a2 + kstep; const char* b3 = b2 + kstep;
            PG8_LDB(B0, 0, 0); PG8_LDB(B1, 0, 1); PG8_SCHED; PG8_LDA(At, 0, 0); PG8_STAGE(PG8_SA(1, 1), a1 + hstep, voffA);
            PG8_WAIT_V(8); PG8_WAIT_L(0); PG8_BAR; PG8_MMA(0, 0, At, B0); PG8_MMA(0, 1, At, B1); PG8_BAR; PG8_SCHED;
            PG8_LDA(At, 0, 1); PG8_STAGE(PG8_SB(0, 0), b2, voffB); PG8_STAGE(PG8_SB(0, 1), b2 + hstep, voffB); PG8_STAGE(PG8_SA(0, 0), a2, voffA);
            PG8_WAIT_V(8); PG8_WAIT_L(0); PG8_BAR; PG8_MMA(1, 0, At, B0); PG8_MMA(1, 1, At, B1); PG8_BAR; PG8_SCHED;
            PG8_LDB(B0, 1, 0); PG8_LDB(B1, 1, 1); PG8_SCHED; PG8_LDA(At, 1, 0); PG8_STAGE(PG8_SA(0, 1), a2 + hstep, voffA);
            PG8_WAIT_V(8); PG8_WAIT_L(0); PG8_BAR; PG8_MMA(0, 0, At, B0); PG8_MMA(0, 1, At, B1); PG8_BAR; PG8_SCHED;
            PG8_LDA(At, 1, 1); PG8_STAGE(PG8_SB(1, 0), b3, voffB); PG8_STAGE(PG8_SB(1, 1), b3 + hstep, voffB); PG8_STAGE(PG8_SA(1, 0), a3, voffA);
            PG8_WAIT_V(8); PG8_WAIT_L(0); PG8_BAR; PG8_MMA(1, 0, At, B0); PG8_MMA(1, 1, At, B1); PG8_BAR; PG8_SCHED;
        }
        if (wr == 0) PG8_BAR;
        E(acc, cur, wr, wc, fr, fq);
        if (!has_next) break;
#pragma unroll
        for (int a = 0; a < 2; ++a)
#pragma unroll
            for (int b = 0; b < 2; ++b)
#pragma unroll
                for (int m = 0; m < 4; ++m)
#pragma unroll
                    for (int n = 0; n < 2; ++n) acc[a][b][m][n] = (f32x4){0.f, 0.f, 0.f, 0.f};
        cur = nxt; cA = nA; cB = nB; ++ui;
        if (wr == 1) PG8_BAR;
    }
    PG8_WAIT_V(0);
    PG8_BAR;
#undef PG8_SA
#undef PG8_SB
#undef PG8_STAGE
#undef PG8_LDA
#undef PG8_LDB
#undef PG8_MMA
#undef PG8_WAIT_V
#undef PG8_WAIT_L
#undef PG8_BAR
#undef PG8_SCHED
}
}
using pg8::pk2h;
using pg8::sigmoidf_;

#define LDS_WAIT() asm volatile("s_waitcnt lgkmcnt(0)" ::: "memory")
#define CFENCE() asm volatile("" ::: "memory")

struct Args {
    const float* in[24]; float* out; unsigned char* ws; int ph_lo, ph_hi;
};

struct Frame {
    LAS unsigned char* lds; int tid, lane, wave, vcu, G;
};

__device__ __forceinline__ float wave_sum(float v) {
#pragma unroll
    for (int o = 1; o < 64; o <<= 1) v += __shfl_xor(v, o);
    return v;
}

__device__ __forceinline__ void p0_transpose_item(const float* W, int K, int N, int half_n, f16* WT, LAS float* scr, int item, int lane) {
    const int nblk = N / 32, kb = item / nblk, nb = item % nblk, k0 = 64 * kb, n0 = 32 * nb;
    int d0 = n0;
    if (half_n) { const int j = n0 < half_n ? n0 : n0 - half_n; d0 = (j >> 7) * 256 + (n0 < half_n ? 0 : 128) + (j & 127); }
    float tv_[32];
#pragma unroll
    for (int i = 0; i < 32; ++i) tv_[i] = W[(size_t)(k0 + 2 * i + (lane >> 5)) * N + n0 + (lane & 31)];
#pragma unroll
    for (int i = 0; i < 32; ++i) { const int kk = 2 * i + (lane >> 5); scr[kk * 33 + (lane & 31)] = tv_[i]; }
    LDS_WAIT();
    const int c = lane & 7;
#pragma unroll
    for (int j = 0; j < 4; ++j) { const int n = (lane >> 3) + 8 * j; const LAS float* s = scr + (8 * c) * 33 + n;
        u32x4 o; o.x = pk2h(s[0 * 33], s[1 * 33]); o.y = pk2h(s[2 * 33], s[3 * 33]); o.z = pk2h(s[4 * 33], s[5 * 33]); o.w = pk2h(s[6 * 33], s[7 * 33]);
        *(u32x4*)(WT + (size_t)(d0 + n) * K + k0 + 8 * c) = o; }
    LDS_WAIT();
}

__device__ __forceinline__ void dsincos(double r, double& s, double& c) {
    const double r2 = r * r; double ts = r, tc = 1.0; s = r; c = 1.0;
#pragma unroll
    for (int i = 1; i <= 14; ++i) { tc = -tc * r2 / (double)((2 * i - 1) * (2 * i)); c += tc; ts = -ts * r2 / (double)((2 * i) * (2 * i + 1)); s += ts; }
}
__device__ __forceinline__ double dexp_small(double x) {
    double t = 1.0, s = 1.0;
#pragma unroll
    for (int i = 1; i <= 14; ++i) { t = t * x / (double)i; s += t; }
    return s;
}

__device__ __forceinline__ void conv_job(Frame& F, const Args& a, int job, int worker, int nworkers) {
    unsigned char* ws = a.ws;
    LAS float* scr = (LAS float*)(F.lds + 8192 + F.wave * 16384);
    constexpr int I_FI = (1024 / 64) * (5632 / 32), I_FO = (2816 / 64) * (1024 / 32), I_SQ = 16 * 32, I_GLU = 16 * 64, I_QKV = 16 * 96;
    const int q = job == 0 ? 0 : (job == 1 ? 1 : (job == 2 ? 2 : 3));
    const int nextra = job == 1 ? I_SQ + I_GLU : (job == 2 ? I_QKV + I_SQ : 0);
    const int nitems = I_FI + I_FO + nextra;
    for (int it = worker; it < nitems; it += nworkers) {
        int r = it;
        if (r < I_FI) { p0_transpose_item(a.in[7] + (size_t)q * 1024 * 5632, 1024, 5632, 2816, (f16*)(ws + WS_WFI + q * WFI_SZ), scr, r, F.lane); continue; } r -= I_FI;
        if (r < I_FO) { p0_transpose_item(a.in[8] + (size_t)q * 2816 * 1024, 2816, 1024, 0, (f16*)(ws + WS_WFO + q * WFO_SZ), scr, r, F.lane); continue; } r -= I_FO;
        if (job == 1) {
            if (r < I_SQ) { p0_transpose_item(a.in[9], 1024, 1024, 0, (f16*)(ws + WS_WSI), scr, r, F.lane); continue; } r -= I_SQ;
            p0_transpose_item(a.in[18], 1024, 2048, 1024, (f16*)(ws + WS_WGLU), scr, r, F.lane);
        } else {
            if (r < I_QKV) { p0_transpose_item(a.in[19], 1024, 3072, 0, (f16*)(ws + WS_WQKV), scr, r, F.lane); continue; } r -= I_QKV;
            p0_transpose_item(a.in[23], 1024, 1024, 0, (f16*)(ws + WS_WO), scr, r, F.lane);
        }
    }
}
__device__ __forceinline__ void bias_rows(Frame& F, const Args& a, int sl_lo, int sl_hi) {
    unsigned char* ws = a.ws;
    const float* MOD = (const float*)(ws + WS_MOD); float* BIAS = (float*)(ws + WS_BIAS);
    const int gw = F.vcu * 8 + F.wave, NGW = F.G * 8;
    for (int sl = sl_lo; sl <= sl_hi; ++sl) {
        const int nrows = sl == 1 ? 1024 : (sl == 4 ? 3072 : 5632);
        const f16* Wt = sl == 0 ? (const f16*)(ws + WS_WFI) : sl == 1 ? (const f16*)(ws + WS_WSI) : sl == 2 ? (const f16*)(ws + WS_WFI + 1 * WFI_SZ)
                      : sl == 3 ? (const f16*)(ws + WS_WFI + 2 * WFI_SZ) : sl == 4 ? (const f16*)(ws + WS_WQKV) : (const f16*)(ws + WS_WFI + 3 * WFI_SZ);
        const int l = sl / 3, sb = sl % 3;
        f32x4 shv[3][4];
#pragma unroll
        for (int mi = 0; mi < 3; ++mi)
#pragma unroll
            for (int q = 0; q < 4; ++q) shv[mi][q] = *(const f32x4*)(MOD + (l * 3 + mi) * 9216 + sb * 3072 + 16 * F.lane + 4 * q);
        for (int nb = gw; nb < nrows; nb += 4 * NGW) {
            f16x8 w0[4], w1[4];
#pragma unroll
            for (int r = 0; r < 4; ++r) { const int n = nb + r * NGW;
                if (n < nrows) { w0[r] = *(const f16x8*)(Wt + (size_t)n * D + 16 * F.lane); w1[r] = *(const f16x8*)(Wt + (size_t)n * D + 16 * F.lane + 8); } }
            asm volatile("" ::: "memory");
#pragma unroll
            for (int r = 0; r < 4; ++r) { const int n = nb + r * NGW;
                if (n < nrows) { float d[3];
#pragma unroll
                    for (int mi = 0; mi < 3; ++mi) { float acc = 0.f;
#pragma unroll
                        for (int q = 0; q < 4; ++q)
#pragma unroll
                            for (int e = 0; e < 4; ++e) { const int k = 4 * q + e; acc += shv[mi][q][e] * (float)(k < 8 ? w0[r][k & 7] : w1[r][k & 7]); }
                        d[mi] = wave_sum(acc); }
                    if (F.lane == 0) { BIAS[(sl * 3 + 0) * 5632 + n] = d[0]; BIAS[(sl * 3 + 1) * 5632 + n] = d[1]; BIAS[(sl * 3 + 2) * 5632 + n] = d[2]; } } }
        }
    }
}
__device__ __forceinline__ void p0_phase(Frame& F, const Args& a) {
    unsigned char* ws = a.ws;
    float* MOD = (float*)(ws + WS_MOD);
    {
        const float* cin = a.in[1]; const float* cctx = a.in[3]; const float* ada_w = a.in[5]; const float* ada_b = a.in[6];
        LAS float* red = (LAS float*)F.lds;
        const int c4 = F.lane & 15, ko = F.lane >> 4;
        for (int u = blockIdx.x; u < 576; u += F.G) {
            const int kh = u & 1, cgl = u >> 1, l = cgl / 144, cg = cgl % 144;
            const float* Wl = ada_w + (size_t)l * 1024 * 9216 + cg * 64 + c4 * 4;
            const int kbase = kh * 512 + F.wave * 64 + ko;
            float acc[3][4];
#pragma unroll
            for (int m = 0; m < 3; ++m)
#pragma unroll
                for (int e = 0; e < 4; ++e) acc[m][e] = 0.f;
#pragma unroll 4
            for (int i = 0; i < 16; ++i) { const int k = kbase + 4 * i; const f32x4 w = *(const f32x4*)(Wl + (size_t)k * 9216);
                const float c0 = cin[k], c1 = cin[1024 + k], c2 = cctx[k];
                const float s0 = c0 * sigmoidf_(c0), s1 = c1 * sigmoidf_(c1), s2 = c2 * sigmoidf_(c2);
#pragma unroll
                for (int e = 0; e < 4; ++e) { acc[0][e] += s0 * w[e]; acc[1][e] += s1 * w[e]; acc[2][e] += s2 * w[e]; } }
#pragma unroll
            for (int m = 0; m < 3; ++m)
#pragma unroll
                for (int e = 0; e < 4; ++e) { float v = acc[m][e]; v += __shfl_xor(v, 16); v += __shfl_xor(v, 32); acc[m][e] = v; }
            if (F.lane < 16) {
#pragma unroll
                for (int m = 0; m < 3; ++m)
#pragma unroll
                    for (int e = 0; e < 4; ++e) red[(F.wave * 3 + m) * 64 + c4 * 4 + e] = acc[m][e];
            }
            __syncthreads();
            if (F.tid < 192) { const int m = F.tid >> 6, col = F.tid & 63; float s = 0.f;
#pragma unroll
                for (int w = 0; w < 8; ++w) s += red[(w * 3 + m) * 64 + col];
                if (kh == 0) s += ada_b[l * 9216 + cg * 64 + col];
                atomicAdd(MOD + (size_t)(l * 3 + m) * 9216 + cg * 64 + col, s); }
            __syncthreads();
        }
    }
    conv_job(F, a, 0, F.vcu * 8 + F.wave, F.G * 8);
    { float* SS = (float*)(ws + WS_SS); for (int i = blockIdx.x * 512 + F.tid; i < 5 * MALL; i += F.G * 512) SS[MALL + i] = 0.f; }
    {
        const float* lam_re = a.in[10]; const float* lam_im = a.in[11]; const float* lstep = a.in[12];
        const float* b_re = a.in[13]; const float* b_im = a.in[14]; const float* c_re = a.in[15]; const float* c_im = a.in[16];
        float* Lam = (float*)(ws + WS_LAM); float* LamT = (float*)(ws + WS_LAMT); f16* Bm = (f16*)(ws + WS_BMAT); f16* Cm = (f16*)(ws + WS_CMAT);
        for (int idx = blockIdx.x * 512 + F.tid; idx < 8192; idx += F.G * 512) {
            const int p = idx & 63, g = (idx >> 6) & 63, dir = idx >> 12;
            const double lr = fmin((double)lam_re[idx], -1e-4), li = (double)lam_im[idx];
            const double dt = (double)expf(lstep[dir * 64 + g]);
            const double mag = dexp_small(lr * dt);
            double th = li * dt; const double twopi = 6.283185307179586476925287;
            th -= twopi * rint(th / twopi);
            double sn, cs; dsincos(th, sn, cs);
            const double ar = mag * cs, ai = mag * sn;
            const double den = lr * lr + li * li;
            const double cr = ((ar - 1.0) * lr + ai * li) / den, ci = (ai * lr - (ar - 1.0) * li) / den;
            Lam[idx * 2] = (float)ar; Lam[idx * 2 + 1] = (float)ai;
            double pr = ar, pi = ai;
#pragma unroll
            for (int q = 0; q < 6; ++q) { const double nr = pr * pr - pi * pi, ni = 2.0 * pr * pi; pr = nr; pi = ni; }
            LamT[idx * 2] = (float)pr; LamT[idx * 2 + 1] = (float)pi;
            const float* br = b_re + (size_t)idx * 16; const float* bi = b_im + (size_t)idx * 16;
            f16* bo = Bm + ((size_t)(g * 2 + dir) * 128 + 2 * p) * 16;
#pragma unroll
            for (int h = 0; h < 16; ++h) { bo[h] = (f16)br[h]; bo[16 + h] = (f16)bi[h]; }
#pragma unroll
            for (int h = 0; h < 16; ++h) {
                const double Cr = (double)c_re[((size_t)(dir * 64 + g) * 16 + h) * 64 + p], Ci = (double)c_im[((size_t)(dir * 64 + g) * 16 + h) * 64 + p];
                const double er = Cr * cr - Ci * ci, ei = Cr * ci + Ci * cr;
                f16* co = Cm + ((size_t)(g * 2 + dir) * 16 + h) * 128 + 2 * p;
                co[0] = (f16)(float)(er * 1024.0); co[1] = (f16)(float)(-ei * 1024.0);
            }
        }
    }
}

__device__ __forceinline__ void p1_phase(Frame& F, const Args& a) {
    unsigned char* ws = a.ws;
    const float* MOD = (const float*)(ws + WS_MOD); const float* norm_g = a.in[4];
    float* X = (float*)(ws + WS_X); f16* H16 = (f16*)(ws + WS_H16); float* SS = (float*)(ws + WS_SS); float* GS = (float*)(ws + WS_GS); float* BIAS = (float*)(ws + WS_BIAS);
    const int gw = F.vcu * 8 + F.wave, NGW = F.G * 8;
    for (int rowb = gw; rowb < MALL; rowb += 3 * NGW) {
        f32x4 v[3][4];
#pragma unroll
        for (int r = 0; r < 3; ++r) { const int row = rowb + r * NGW;
            if (row < MALL) { const float* xr = row < MLAT ? a.in[0] + (size_t)row * D : a.in[2] + (size_t)(row - MLAT) * D;
#pragma unroll
                for (int j = 0; j < 4; ++j) v[r][j] = *((const f32x4*)xr + F.lane + 64 * j); } }
        asm volatile("" ::: "memory");
#pragma unroll
        for (int r = 0; r < 3; ++r) { const int row = rowb + r * NGW;
            if (row < MALL) {
                const int mi = row < SEQ ? 0 : (row < MLAT ? 1 : 2);
                const float* sc = MOD + mi * 9216 + 1024;
                float sq = 0.f;
#pragma unroll
                for (int j = 0; j < 4; ++j) sq += (v[r][j].x * v[r][j].x + v[r][j].y * v[r][j].y) + (v[r][j].z * v[r][j].z + v[r][j].w * v[r][j].w);
                sq = wave_sum(sq);
                if (F.lane == 0) SS[row] = sq;
#pragma unroll
                for (int j = 0; j < 4; ++j) { const int col = 4 * (F.lane + 64 * j);
                    const f32x4 gg = *(const f32x4*)(norm_g + col), s1 = *(const f32x4*)(sc + col);
                    const f32x4 h = v[r][j] * gg * (s1 + 1.0f);
                    u32x2 w; w.x = pk2h(h.x, h.y); w.y = pk2h(h.z, h.w);
                    *(u32x2*)(H16 + (size_t)row * D + col) = w;
                    *(f32x4*)(X + (size_t)row * D + col) = v[r][j]; } } }
    }
    for (int i = blockIdx.x * 512 + F.tid; i < 6 * 3 * 1024; i += F.G * 512) { const int col = i & 1023, mi = (i >> 10) % 3, sl = i / 3072, l = sl / 3, sb = sl % 3;
        GS[i] = norm_g[sl * 1024 + col] * (1.0f + MOD[(l * 3 + mi) * 9216 + sb * 3072 + 1024 + col]); }
    bias_rows(F, a, 0, 0);
}

__device__ __forceinline__ void s5_unit_decode(int unit, int w, int& gq, int& c, int& b, int& g, int& rowbase) {
    gq = unit & 15; c = (unit >> 4) % NCH; b = unit / (16 * NCH); g = gq * 4 + (w >> 1);
    rowbase = c < 4 ? MLAT + b * CTX + 64 * c : b * SEQ + 64 * (c - 4);
}
template <bool P2>
__device__ __forceinline__ void s5_load_unit(int unit, int w, int dir, int l, const f16* U16, const f32x2* Cin, f16x4 (&af)[4], f32x2& st) {
    int gq, c, b, g, rowbase; s5_unit_decode(unit, w, gq, c, b, g, rowbase);
    const int fq = l >> 4, fr = l & 15;
#pragma unroll
    for (int s = 0; s < 4; ++s) af[s] = *(const f16x4*)(U16 + (size_t)(rowbase + 16 * (dir ? 3 - s : s) + fr) * D + 16 * g + 4 * fq);
    if (P2) st = Cin[((size_t)((dir * 2 + b) * NCH + c) * 64 + g) * 64 + l];
}
__device__ __forceinline__ float fma_s(float a, float b, float c) { float r; asm("v_fma_f32 %0, %1, %2, %3" : "=v"(r) : "v"(a), "v"(b), "v"(c)); return r; }
template <bool P2>
__device__ __forceinline__ void s5_pass(Frame& F, unsigned char* ws, const float* ssm_d) {
    int l_ = F.lane; asm volatile("" : "+v"(l_));
    const int w = F.wave, l = l_, fq = l >> 4, fr = l & 15;
    LAS float* W = (LAS float*)(F.lds + w * 8448);
    LAS f16* XS = (LAS f16*)(F.lds + 67584 + w * 4352);
    LAS float* YBall = (LAS float*)(F.lds + 67584 + 34816);
    LAS float* YB = YBall + w * 1024;
    const float* Lam = (const float*)(ws + WS_LAM); const f16* Bm = (const f16*)(ws + WS_BMAT); const f16* Cm = (const f16*)(ws + WS_CMAT);
    const f16* U16 = (const f16*)(ws + WS_U16); f16* G16 = (f16*)(ws + WS_G16);
    f32x2* Eb = (f32x2*)(ws + WS_E); const f32x2* Cin = (const f32x2*)(ws + WS_CIN);
    const int dir = w & 1;
    int wstep = dir ? -132 : 132, xstep = dir ? -136 : 136, w0 = dir ? 15 * 132 : 0, x0 = dir ? 15 * 136 : 0;
    asm volatile("" : "+s"(wstep), "+s"(xstep), "+s"(w0), "+s"(x0));
    const LAS float* Wl = W + w0 + 2 * l; LAS f16* XSl = XS + x0 + 2 * l;
    constexpr int NU = NB * NCH * 16;
    int gcur = -1; float ar = 0.f, ai = 0.f;
    f16x4 bf[8]; f16x8 cfr[4];
    f16x4 af[4], afn[4]; f32x2 st = (f32x2){0.f, 0.f}, stn = (f32x2){0.f, 0.f};
    int unit = blockIdx.x;
    if (unit < NU) s5_load_unit<P2>(unit, w, dir, l, U16, Cin, af, st);
    for (; unit < NU; unit += F.G) {
        int gq, c, b, g, rowbase; s5_unit_decode(unit, w, gq, c, b, g, rowbase);
        if (g != gcur) {
            gcur = g;
            ar = Lam[((dir * 64 + g) * 64 + l) * 2]; ai = Lam[((dir * 64 + g) * 64 + l) * 2 + 1];
#pragma unroll
            for (int j = 0; j < 8; ++j) bf[j] = *(const f16x4*)(Bm + ((size_t)(g * 2 + dir) * 128 + 16 * j + fr) * 16 + 4 * fq);
            if (P2) {
#pragma unroll
                for (int kk = 0; kk < 4; ++kk) cfr[kk] = *(const f16x8*)(Cm + ((size_t)(g * 2 + dir) * 16 + fr) * 128 + 32 * kk + 8 * fq);
            }
        }
        if (unit + F.G < NU) s5_load_unit<P2>(unit + F.G, w, dir, l, U16, Cin, afn, stn);
        const size_t sidx = ((size_t)((dir * 2 + b) * NCH + c) * 64 + g) * 64 + l;
        float xr = st.x, xi = st.y; const float nai = -ai;
        const int cgl = F.tid >> 7, ct = (F.tid >> 1) & 63, chb = F.tid & 1, cgg = gq * 4 + cgl;
        const size_t co = (size_t)(rowbase + ct) * D + 16 * cgg + 8 * chb;
        f16x8 uu; f32x4 dv0, dv1;
        if (P2) { uu = *(const f16x8*)(U16 + co); dv0 = *(const f32x4*)(ssm_d + 16 * cgg + 8 * chb); dv1 = *(const f32x4*)(ssm_d + 16 * cgg + 8 * chb + 4); }
#pragma unroll
        for (int s = 0; s < 4; ++s) {
            const int sc = dir ? 3 - s : s;
            const f16x4 a4 = af[s];
#pragma unroll
            for (int j = 0; j < 8; ++j) { const f32x4 dd = __builtin_amdgcn_mfma_f32_16x16x16f16(bf[j], a4, (f32x4){0.f, 0.f, 0.f, 0.f}, 0, 0, 0);
                *(LAS f32x4*)(W + fr * 132 + 16 * j + 4 * fq) = dd; }
            CFENCE();
#pragma unroll
            for (int k = 0; k < 16; ++k) {
                const f32x2 bu = *(const LAS f32x2*)(Wl + k * wstep);
                const float nr = fma_s(nai, xi, fma_s(ar, xr, bu.x)), ni = fma_s(ai, xr, fma_s(ar, xi, bu.y)); xr = nr; xi = ni;
                if (P2) { f16x2 hv; hv.x = (f16)xr; hv.y = (f16)xi; *(LAS f16x2*)(XSl + k * xstep) = hv; } }
            if (P2) {
                CFENCE();
                f32x4 Y = (f32x4){0.f, 0.f, 0.f, 0.f};
#pragma unroll
                for (int kk = 0; kk < 4; ++kk) { const f16x8 xa = *(const LAS f16x8*)(XS + fr * 136 + 32 * kk + 8 * fq); Y = __builtin_amdgcn_mfma_f32_16x16x32_f16(cfr[kk], xa, Y, 0, 0, 0); }
                *(LAS f32x4*)(YB + (16 * sc + fr) * 16 + 4 * fq) = Y;
            }
            CFENCE();
        }
        if (!P2) { Eb[sidx] = (f32x2){xr, xi}; }
        else {
            __syncthreads();
            const LAS float* y0 = YBall + (cgl * 2) * 1024 + ct * 16 + 8 * chb; const LAS float* y1 = y0 + 1024;
            const size_t o = co;
            float hv[8];
#pragma unroll
            for (int e = 0; e < 8; ++e) { const float dd = e < 4 ? dv0[e & 3] : dv1[e & 3];
                const float y = (y0[e] + y1[e]) * (1.0f / 1024.0f) + (float)uu[e] * dd;
                const float z = 1.5957691216057308f * (y + 0.044715f * y * y * y);
                hv[e] = y * sigmoidf_(z); }
            u32x4 wv; wv.x = pk2h(hv[0], hv[1]); wv.y = pk2h(hv[2], hv[3]); wv.z = pk2h(hv[4], hv[5]); wv.w = pk2h(hv[6], hv[7]);
            *(u32x4*)(G16 + o) = wv;
            __syncthreads();
        }
#pragma unroll
        for (int s = 0; s < 4; ++s) af[s] = afn[s];
        st = stn;
    }
}

__device__ __forceinline__ void s5_carry(Frame& F, unsigned char* ws) {
    const float* LamT = (const float*)(ws + WS_LAMT); const f32x2* Eb = (const f32x2*)(ws + WS_E); f32x2* Cin = (f32x2*)(ws + WS_CIN);
    for (int wv = F.wave * F.G + blockIdx.x; wv < 256; wv += F.G * 8) {
        const int idx = wv * 64 + F.lane;
        const int p = idx & 63, g = (idx >> 6) & 63, b = (idx >> 12) & 1, dir = idx >> 13;
        const float lr = LamT[((dir * 64 + g) * 64 + p) * 2], li = LamT[((dir * 64 + g) * 64 + p) * 2 + 1];
        float sr = 0.f, si = 0.f;
        for (int k0 = 0; k0 < NCH; k0 += 12) {
            f32x2 e[12]; size_t ad[12];
#pragma unroll
            for (int j = 0; j < 12; ++j) { const int k = k0 + j; const int c = dir ? (k < 4 ? 3 - k : 135 - k) : k;
                ad[j] = ((size_t)((dir * 2 + b) * NCH + c) * 64 + g) * 64 + p; e[j] = Eb[ad[j]]; }
#pragma unroll
            for (int j = 0; j < 12; ++j) { Cin[ad[j]] = (f32x2){sr, si};
                const float nr = lr * sr - li * si + e[j].x, ni = lr * si + li * sr + e[j].y; sr = nr; si = ni; }
        }
    }
}

__device__ __forceinline__ void qknorm_phase(Frame& F, unsigned char* ws, const float* qg, const float* kg) {
    f16* Q = (f16*)(ws + WS_Q16); f16* Kp = (f16*)(ws + WS_K16); const f16* V = (const f16*)(ws + WS_V16); f16* VT = (f16*)(ws + WS_VT); f16* VTC = (f16*)(ws + WS_VTC);
    LAS f16* T = (LAS f16*)(F.lds + F.wave * 9216);
    const int gw = F.vcu * 8 + F.wave, NGW = F.G * 8, l = F.lane;
    const int dchunk = (l & 7) * 8;
    float qgv[8], kgv[8];
#pragma unroll
    for (int e = 0; e < 8; ++e) { qgv[e] = qg[dchunk + e] * 0.125f; kgv[e] = kg[dchunk + e]; }
    for (int u = gw; u < 264 * 16; u += NGW) {
        const int h = u & 15, tb = u >> 4, R0 = tb * 64;
#pragma unroll
        for (int which = 0; which < 2; ++which) {
            if (which == 0 && tb >= 256) continue;
            f16* P = which ? Kp : Q;
#pragma unroll 2
            for (int it = 0; it < 8; ++it) { f16* p = P + (size_t)(R0 + it * 8 + (l >> 3)) * D + h * 64 + dchunk;
                const f16x8 v = *(const f16x8*)p; float f[8], ss = 0.f;
#pragma unroll
                for (int e = 0; e < 8; ++e) { f[e] = (float)v[e]; ss += f[e] * f[e]; }
                ss += __shfl_xor(ss, 1); ss += __shfl_xor(ss, 2); ss += __shfl_xor(ss, 4);
                const float rinv = __builtin_amdgcn_rsqf(ss * (1.0f / 64.0f) + EPS);
                u32x4 o;
                if (which) { o.x = pk2h(f[0] * rinv * kgv[0], f[1] * rinv * kgv[1]); o.y = pk2h(f[2] * rinv * kgv[2], f[3] * rinv * kgv[3]); o.z = pk2h(f[4] * rinv * kgv[4], f[5] * rinv * kgv[5]); o.w = pk2h(f[6] * rinv * kgv[6], f[7] * rinv * kgv[7]); }
                else { o.x = pk2h(f[0] * rinv * qgv[0], f[1] * rinv * qgv[1]); o.y = pk2h(f[2] * rinv * qgv[2], f[3] * rinv * qgv[3]); o.z = pk2h(f[4] * rinv * qgv[4], f[5] * rinv * qgv[5]); o.w = pk2h(f[6] * rinv * qgv[6], f[7] * rinv * qgv[7]); }
                *(u32x4*)p = o; }
        }
#pragma unroll 2
        for (int it = 0; it < 8; ++it) { const int tok = it * 8 + (l >> 3);
            *(LAS u32x4*)(T + tok * 72 + dchunk) = *(const u32x4*)(V + (size_t)(R0 + tok) * D + h * 64 + dchunk); }
        LDS_WAIT();
        f16* dst; int ldt;
        if (tb < 256) { const int b = tb >> 7, t0 = (tb & 127) * 64; dst = VT + ((size_t)(b * 16 + h) * 64) * SEQ + t0; ldt = SEQ; }
        else { const int b = (tb - 256) >> 2, t0 = ((tb - 256) & 3) * 64; dst = VTC + ((size_t)(b * 16 + h) * 64) * CTX + t0; ldt = CTX; }
#pragma unroll 2
        for (int it = 0; it < 8; ++it) { const int d = it * 8 + (l >> 3), tc = (l & 7) * 8; f16x8 o;
#pragma unroll
            for (int e = 0; e < 8; ++e) o[e] = T[(tc + e) * 72 + d];
            *(f16x8*)(dst + (size_t)d * ldt + tc) = o; }
        LDS_WAIT();
    }
}

constexpr int AT_KROW = 144, AT_KC = 82944, AT_VC = 119808, AT_TAB = 156672;
#define AT_BAR() do { asm volatile("s_waitcnt lgkmcnt(0)" ::: "memory"); __builtin_amdgcn_s_barrier(); asm volatile("" ::: "memory"); } while (0)
typedef short v4i16_t __attribute__((ext_vector_type(4)));
__device__ __forceinline__ f16x4 at_vtr(const LAS unsigned char* p) { return __builtin_bit_cast(f16x4, __builtin_amdgcn_ds_read_tr16_b64_v4i16((LAS v4i16_t*)p)); }
__device__ __forceinline__ void attn_decode(int up, int G, int& rp, int& bh, int& rs0) {
    if (G == 256) { const int i = up & 255, k = up >> 8; bh = i >> 3; rp = (i & 7) * 8 + k; } else { rp = up & 63; bh = up >> 6; }
    rs0 = min(max(2 * rp - 4, 0), 120);
}
constexpr int AT_NPF = 5;
template <int I0, int I1, int NT>
__device__ __forceinline__ void attn_load_band(const f16* Src, int bh, int rs0, int tid, u32x4 (&tk)[NT]) {
    const int b = bh >> 4, h = bh & 15;
#pragma unroll
    for (int it = I0; it < I1; ++it) { const int q = it * 512 + tid, row = q >> 3, c16 = q & 7;
        const int gr = min(rs0 + (row >> 6), 127);
        tk[it - I0] = *(const u32x4*)(Src + (size_t)(b * SEQ + gr * 64 + (row & 63)) * D + h * 64 + c16 * 8); }
}
__device__ __forceinline__ u32x4 at_knorm(u32x4 raw, const float (&kgv)[8]) {
    const f16x8 v = __builtin_bit_cast(f16x8, raw); float f[8], ss = 0.f;
#pragma unroll
    for (int e = 0; e < 8; ++e) { f[e] = (float)v[e]; ss += f[e] * f[e]; }
    ss += __builtin_bit_cast(float, __builtin_amdgcn_update_dpp(0, __builtin_bit_cast(int, ss), 0xB1, 0xf, 0xf, true));
    ss += __builtin_bit_cast(float, __builtin_amdgcn_update_dpp(0, __builtin_bit_cast(int, ss), 0x4E, 0xf, 0xf, true));
    ss += __builtin_bit_cast(float, __builtin_amdgcn_update_dpp(0, __builtin_bit_cast(int, ss), 0x141, 0xf, 0xf, true));
    const float rinv = __builtin_amdgcn_rsqf(ss * (1.0f / 64.0f) + EPS);
    u32x4 o; o.x = pk2h(f[0] * rinv * kgv[0], f[1] * rinv * kgv[1]); o.y = pk2h(f[2] * rinv * kgv[2], f[3] * rinv * kgv[3]);
    o.z = pk2h(f[4] * rinv * kgv[4], f[5] * rinv * kgv[5]); o.w = pk2h(f[6] * rinv * kgv[6], f[7] * rinv * kgv[7]); return o;
}
__device__ __forceinline__ void attn_phase(Frame& F, unsigned char* ws, const float* rpb, const float* qg, const float* kg) {
    f16* Q = (f16*)(ws + WS_Q16); const f16* Kp = (const f16*)(ws + WS_K16); const f16* Vp = (const f16*)(ws + WS_V16);
    const int w = F.wave;
    LAS unsigned char* SM = F.lds;
    constexpr int NUP = NB * 16 * 64;
    u32x4 tk[AT_NPF];
    int bh_cur = -1;
    { int rp, bh, rs0; if ((int)blockIdx.x < NUP) { attn_decode(blockIdx.x, F.G, rp, bh, rs0); attn_load_band<0, AT_NPF, AT_NPF>(Kp, bh, rs0, F.tid, tk); } }
    for (int up = blockIdx.x; up < NUP; up += F.G) {
        int l_ = F.lane; asm volatile("" : "+v"(l_));
        const int l = l_, fr = l & 15, fq = l >> 4, tid = w * 64 + l;
        int rp, bh, rs0; attn_decode(up, F.G, rp, bh, rs0);
        const int b = bh >> 4, h = bh & 15;
        const int r0 = 2 * rp;
        const int r = r0 + (w >> 2), qt = w & 3;
        const int rs = min(max(r - 4, 0), 120), i0 = rs - rs0;
        const int cw = qt == 0 ? 0 : (qt == 1 ? 8 : (qt == 2 ? 24 : 32));
        const int qc = 16 * qt + fr, cs = min(max(qc - 8, 0), 48);
        const size_t qrow = (size_t)(b * SEQ + r * 64 + qc) * D + h * 64;
        float kgv[8];
#pragma unroll
        for (int e = 0; e < 8; ++e) kgv[e] = kg[(tid & 7) * 8 + e];
        u32x4 trk[9 - AT_NPF]; attn_load_band<AT_NPF, 9, 9 - AT_NPF>(Kp, bh, rs0, tid, trk);
        f16x8 q0, q1;
        { const f16x8 r0v = *(const f16x8*)(Q + qrow + 8 * fq), r1v = *(const f16x8*)(Q + qrow + 32 + 8 * fq); float f0[8], f1[8], ss = 0.f;
#pragma unroll
            for (int e = 0; e < 8; ++e) { f0[e] = (float)r0v[e]; f1[e] = (float)r1v[e]; ss += f0[e] * f0[e] + f1[e] * f1[e]; }
            ss += __shfl_xor(ss, 16); ss += __shfl_xor(ss, 32);
            const float rinv = __builtin_amdgcn_rsqf(ss * (1.0f / 64.0f) + EPS) * (0.125f * 1.4426950408889634f);
#pragma unroll
            for (int e = 0; e < 8; ++e) { q0[e] = (f16)(f0[e] * rinv * qg[8 * fq + e]); q1[e] = (f16)(f1[e] * rinv * qg[32 + 8 * fq + e]); } }
        {
#pragma unroll
        for (int it = 0; it < 9; ++it) { const int q = it * 512 + tid, row = q >> 3, c16 = q & 7; *(LAS u32x4*)(SM + row * AT_KROW + c16 * 16) = at_knorm(it < AT_NPF ? tk[it < AT_NPF ? it : 0] : trk[it >= AT_NPF ? it - AT_NPF : 0], kgv); } }
        if (bh != bh_cur) {
            bh_cur = bh;
#pragma unroll
            for (int it = 0; it < 4; ++it) { const int q = it * 512 + tid, row = q >> 3, c16 = q & 7; const size_t go = (size_t)(MLAT + b * CTX + row) * D + h * 64 + c16 * 8;
                *(LAS u32x4*)(SM + AT_KC + row * AT_KROW + c16 * 16) = at_knorm(*(const u32x4*)(Kp + go), kgv);
                *(LAS u32x4*)(SM + AT_VC + row * AT_KROW + c16 * 16) = *(const u32x4*)(Vp + go); }
            if (tid < 465) ((LAS float*)(SM + AT_TAB))[tid] = rpb[h * 465 + tid] * 1.4426950408889634f;
        }
        const LAS float* rp_ = (const LAS float*)(SM + AT_TAB);
        AT_BAR();
        f32x4 S[32];
        float mx = -INFINITY;
#pragma unroll
        for (int i = 0; i < 8; ++i)
#pragma unroll
            for (int hf = 0; hf < 2; ++hf) {
                const LAS unsigned char* kr = SM + ((i0 + i) * 64 + cw + 16 * hf + fr) * AT_KROW + 16 * fq;
                const f16x8 k0 = *(const LAS f16x8*)kr, k1 = *(const LAS f16x8*)(kr + 64);
                f32x4 sv = __builtin_amdgcn_mfma_f32_16x16x32_f16(k0, q0, (f32x4){0.f, 0.f, 0.f, 0.f}, 0, 0, 0);
                sv = __builtin_amdgcn_mfma_f32_16x16x32_f16(k1, q1, sv, 0, 0, 0);
                const int ri = rs + i - r + 7;
#pragma unroll
                for (int e = 0; e < 4; ++e) { const int kc = cw + 16 * hf + 4 * fq + e; const bool valid = (kc >= cs) && (kc < cs + 16);
                    const int ci = min(max(kc - qc + 15, 0), 30);
                    const float bz = rp_[ri * 31 + ci];
                    const float z = (sv[e] + bz) + (valid ? 0.f : -INFINITY); sv[e] = z; mx = fmaxf(mx, z); }
                S[i * 2 + hf] = sv;
            }
#pragma unroll
        for (int j = 0; j < 16; ++j) {
            const LAS unsigned char* kr = SM + AT_KC + (16 * j + fr) * AT_KROW + 16 * fq;
            const f16x8 k0 = *(const LAS f16x8*)kr, k1 = *(const LAS f16x8*)(kr + 64);
            f32x4 sv = __builtin_amdgcn_mfma_f32_16x16x32_f16(k0, q0, (f32x4){0.f, 0.f, 0.f, 0.f}, 0, 0, 0);
            sv = __builtin_amdgcn_mfma_f32_16x16x32_f16(k1, q1, sv, 0, 0, 0);
#pragma unroll
            for (int e = 0; e < 4; ++e) mx = fmaxf(mx, sv[e]);
            S[16 + j] = sv;
        }
        mx = fmaxf(mx, __shfl_xor(mx, 16)); mx = fmaxf(mx, __shfl_xor(mx, 32));
        float sum = 0.f;
        f16x4 P[32];
#pragma unroll
        for (int t = 0; t < 32; ++t) {
#pragma unroll
            for (int e = 0; e < 4; ++e) { const float p = __builtin_amdgcn_exp2f(S[t][e] - mx); sum += p; P[t][e] = (f16)p; } }
        sum += __shfl_xor(sum, 16); sum += __shfl_xor(sum, 32);
        const float rsum = __builtin_amdgcn_rcpf(sum);
        __builtin_amdgcn_sched_barrier(0);
        u32x4 tv[9];
        attn_load_band<0, 9, 9>(Vp, bh, rs0, tid, tv);
        __builtin_amdgcn_sched_barrier(0);
        AT_BAR();
#pragma unroll
        for (int it = 0; it < 9; ++it) { const int q = it * 512 + tid, row = q >> 3, c16 = q & 7; *(LAS u32x4*)(SM + row * AT_KROW + c16 * 16) = tv[it]; }
        AT_BAR();
        if (up + F.G < NUP) { int rp2, bh2, rs2; attn_decode(up + F.G, F.G, rp2, bh2, rs2); attn_load_band<0, AT_NPF, AT_NPF>(Kp, bh2, rs2, tid, tk); }
        __builtin_amdgcn_sched_barrier(0);
        f32x4 O[4];
#pragma unroll
        for (int dt = 0; dt < 4; ++dt) O[dt] = (f32x4){0.f, 0.f, 0.f, 0.f};
        const int trq = fr >> 2, trp = fr & 3;
#pragma unroll
        for (int i = 0; i < 8; ++i) {
            f16x8 pf;
#pragma unroll
            for (int e = 0; e < 4; ++e) { pf[e] = P[2 * i][e]; pf[4 + e] = P[2 * i + 1][e]; }
            const LAS unsigned char* vb_ = SM + ((i0 + i) * 64 + cw + 4 * fq + trq) * AT_KROW + 8 * trp;
#pragma unroll
            for (int dt = 0; dt < 4; ++dt) { const f16x4 va = at_vtr(vb_ + 32 * dt), vb = at_vtr(vb_ + 16 * AT_KROW + 32 * dt); f16x8 vf;
#pragma unroll
                for (int e = 0; e < 4; ++e) { vf[e] = va[e]; vf[4 + e] = vb[e]; }
                O[dt] = __builtin_amdgcn_mfma_f32_16x16x32_f16(vf, pf, O[dt], 0, 0, 0); }
        }
#pragma unroll
        for (int jp = 0; jp < 8; ++jp) {
            f16x8 pf;
#pragma unroll
            for (int e = 0; e < 4; ++e) { pf[e] = P[16 + 2 * jp][e]; pf[4 + e] = P[17 + 2 * jp][e]; }
            const LAS unsigned char* vb_ = SM + AT_VC + (32 * jp + 4 * fq + trq) * AT_KROW + 8 * trp;
#pragma unroll
            for (int dt = 0; dt < 4; ++dt) { const f16x4 va = at_vtr(vb_ + 32 * dt), vb = at_vtr(vb_ + 16 * AT_KROW + 32 * dt); f16x8 vf;
#pragma unroll
                for (int e = 0; e < 4; ++e) { vf[e] = va[e]; vf[4 + e] = vb[e]; }
                O[dt] = __builtin_amdgcn_mfma_f32_16x16x32_f16(vf, pf, O[dt], 0, 0, 0); }
        }
#pragma unroll
        for (int dt = 0; dt < 4; ++dt) { u32x2 o; o.x = pk2h(O[dt][0] * rsum, O[dt][1] * rsum); o.y = pk2h(O[dt][2] * rsum, O[dt][3] * rsum);
            *(u32x2*)(Q + qrow + 16 * dt + 4 * fq) = o; }
        AT_BAR();
    }
}

template <int NT, int MODE, int CB = 0>
__device__ __forceinline__ void ctx_gemm(Frame& F, const f16* A, int lda, const f16* Bt, int K, const pg8::Epi& E) {
    constexpr int KC = 256, PITCH = KC * 2 + 16, NROWS = 32 + 16 * NT, NLD = NROWS / 16;
    LAS unsigned char* SM = F.lds;
    const int w = F.wave, rt = w >> 2, kq = w & 3;
    for (int tile = blockIdx.x; tile < 256; tile += F.G) {
        int l_ = F.lane; asm volatile("" : "+v"(l_));
        const int l = l_, fr = l & 15, fq = l >> 4, tid = w * 64 + l;
        const int rb = tile & 15, cb = tile >> 4;
        const int row = MLAT + rb * 32 + 16 * rt + fr;
        const f16* src[NLD];
#pragma unroll
        for (int it = 0; it < NLD; ++it) { const int q = it * 512 + tid, srow = q >> 5, c16 = q & 31;
            if (srow < 32) src[it] = A + (size_t)(MLAT + rb * 32 + srow) * lda + c16 * 8;
            else { const int j = srow - 32; int brow;
                if (MODE == 3) { const int jj = cb * 64 + 16 * ((j >> 4) & 3) + (j & 15); brow = (jj >> 7) * 256 + (jj & 127) + ((j >> 4) >= 4 ? 128 : 0); }
                else brow = CB + cb * (16 * NT) + j;
                src[it] = Bt + (size_t)brow * K + c16 * 8; } }
        f32x4 fin[NT / 4];
#pragma unroll
        for (int i = 0; i < NT / 4; ++i) fin[i] = (f32x4){0.f, 0.f, 0.f, 0.f};
        u32x4 tr[NLD];
#pragma unroll
        for (int it = 0; it < NLD; ++it) tr[it] = *(const u32x4*)src[it];
        for (int kc = 0; kc < K; kc += KC) {
            __syncthreads();
#pragma unroll
            for (int it = 0; it < NLD; ++it) { const int q = it * 512 + tid; *(LAS u32x4*)(SM + (q >> 5) * PITCH + (q & 31) * 16) = tr[it]; }
            __syncthreads();
            if (kc + KC < K) {
#pragma unroll
                for (int it = 0; it < NLD; ++it) tr[it] = *(const u32x4*)(src[it] + kc + KC);
            }
#pragma unroll
            for (int ks = 0; ks < KC / 32; ++ks) { const f16x8 av = *(const LAS f16x8*)(SM + (16 * rt + fr) * PITCH + ks * 64 + 16 * fq);
#pragma unroll
                for (int i = 0; i < NT / 4; ++i) { const f16x8 bv = *(const LAS f16x8*)(SM + (32 + 16 * (kq + 4 * i) + fr) * PITCH + ks * 64 + 16 * fq);
                    fin[i] = __builtin_amdgcn_mfma_f32_16x16x32_f16(bv, av, fin[i], 0, 0, 0); } }
        }
        if (MODE == 0) {
            const float rinv = __builtin_amdgcn_rsqf(E.ss[row] * (1.0f / 1024.0f) + 1e-6f);
#pragma unroll
            for (int i = 0; i < NT / 4; ++i) { int col = CB + cb * (16 * NT) + 16 * (kq + 4 * i) + 4 * fq; f16* base = E.O16;
                const f32x4 v = fin[i] * rinv + *(const f32x4*)(E.bias + 2 * 5632 + col);
                if (E.split_cols) { const int t = col / E.split_cols; base += (size_t)t * E.split_stride; col -= t * E.split_cols; }
                u32x2 o; o.x = pk2h(v[0], v[1]); o.y = pk2h(v[2], v[3]);
                *(u32x2*)(base + (size_t)row * E.ldo + col) = o; }
        } else {
            const int col = cb * 64 + 16 * kq + 4 * fq; const size_t off = (size_t)row * D + col;
            const f32x4 xs = *(const f32x4*)(E.Xs + off); f32x4 xn;
            if (MODE == 2) { const f32x4 gv = *(const f32x4*)(E.gate + 2 * 9216 + col) * E.coef; xn = xs + gv * fin[0]; }
            else { const f32x4 gv = *(const f32x4*)(E.gate + 2 * 9216 + col);
#pragma unroll
                for (int e = 0; e < 4; ++e) xn[e] = xs[e] + gv[e] * fin[0][e] * sigmoidf_(fin[NT / 4 - 1][e]); }
            *(f32x4*)(E.Xd + off) = xn;
            if (E.An) { const f32x4 a0 = xn * *(const f32x4*)(E.gsn + 2 * 1024 + col);
                u32x2 o; o.x = pk2h(a0[0], a0[1]); o.y = pk2h(a0[2], a0[3]);
                *(u32x2*)(E.An + off) = o;
                float sq = (xn[0] * xn[0] + xn[1] * xn[1]) + (xn[2] * xn[2] + xn[3] * xn[3]);
                sq += __shfl_xor(sq, 16); sq += __shfl_xor(sq, 32); if (fq == 0) atomicAdd(E.ssn + row, sq); }
        }
        __syncthreads();
    }
}

#define XB_TMO      128
#define XB_XCNT(j)  (256  + 64 * (j))
#define XB_XSUB(j)  (1280 + 64 * (j))
#define XB_XGEN(j)  (2304 + 64 * (j))
#define XB_TOP      3328
#define XB_TOPGEN   3392
#define XCD_BAR_WORDS 3456
#define XB_SPIN_CAP (1u << 18)

__device__ __forceinline__ unsigned xb_ld(unsigned* p)              { return __hip_atomic_load(p, __ATOMIC_RELAXED, __HIP_MEMORY_SCOPE_AGENT); }
__device__ __forceinline__ unsigned xb_add(unsigned* p, unsigned v) { return __hip_atomic_fetch_add(p, v, __ATOMIC_RELAXED, __HIP_MEMORY_SCOPE_AGENT); }
__device__ __forceinline__ unsigned xb_xcc_id() { return (unsigned)__builtin_amdgcn_s_getreg((3 << 11) | 20) & 0xFu; }
#define XB_SPIN(cond, bar) do { unsigned _sp = 0; while (cond) { __builtin_amdgcn_s_sleep(1); \
    if ((++_sp & 255u) == 0u) { if (xb_ld(&(bar)[XB_TMO])) break; if (_sp > XB_SPIN_CAP) { atomicAdd(&(bar)[XB_TMO], 1u); break; } } } } while (0)

struct XcdBarrier {
    unsigned* bar; unsigned x;
    volatile LAS unsigned* st;
};

__device__ __forceinline__ XcdBarrier xcd_barrier_post(unsigned* bar, volatile LAS unsigned* st) {
    XcdBarrier b; b.bar = bar; b.x = xb_xcc_id(); b.st = st;
    if (threadIdx.x == 0) (void)xb_add(&bar[XB_XCNT(b.x)], 1u);
    return b;
}
__device__ __forceinline__ void xcd_barrier_complete(unsigned* bar, unsigned x, unsigned& nloc, unsigned& nx) {
    const unsigned G = gridDim.x * gridDim.y * gridDim.z;
    unsigned sum, cnt, mine, sp = 0u;
    for (;;) {
        sum = 0u; cnt = 0u; mine = 0u;
#pragma unroll
        for (unsigned j = 0; j < 16; ++j) { const unsigned c = xb_ld(&bar[XB_XCNT(j)]); sum += c; cnt += (c > 0u) ? 1u : 0u; mine = (j == x) ? c : mine; }
        if (sum == G) break;
        __builtin_amdgcn_s_sleep(1);
        if ((++sp & 255u) == 0u) { if (xb_ld(&bar[XB_TMO])) break; if (sp > XB_SPIN_CAP) { atomicAdd(&bar[XB_TMO], 1u); break; } }
    }
    nloc = mine > 0u ? mine : 1u; nx = cnt > 0u ? cnt : 1u;
}

__device__ __forceinline__ void xcd_barrier(const XcdBarrier& b) {
    asm volatile("s_waitcnt vmcnt(0)" ::: "memory");
    __syncthreads();
    if (threadIdx.x == 0) {
        unsigned* bar = b.bar;
        __builtin_amdgcn_s_waitcnt(0);
        unsigned nloc = b.st[0], nx = b.st[1];
        if (nloc == 0u) { xcd_barrier_complete(bar, b.x, nloc, nx); b.st[0] = nloc; b.st[1] = nx; }
        const unsigned old = xb_add(&bar[XB_XSUB(b.x)], 1u);
        const unsigned gen = old / nloc;
        if (old + 1u == (gen + 1u) * nloc) {
            __builtin_amdgcn_fence(__ATOMIC_RELEASE, "agent");
            asm volatile("s_waitcnt vmcnt(0)" ::: "memory");
            const unsigned og = xb_add(&bar[XB_TOP], 1u);
            const unsigned tg = og / nx;
            if (og + 1u == (tg + 1u) * nx) xb_add(&bar[XB_TOPGEN], 1u);
            else XB_SPIN(xb_ld(&bar[XB_TOPGEN]) == tg, bar);
            __builtin_amdgcn_fence(__ATOMIC_ACQUIRE, "agent");
            xb_add(&bar[XB_XGEN(b.x)], 1u);
            asm volatile("s_waitcnt vmcnt(0)" ::: "memory");
        } else {
            XB_SPIN(xb_ld(&bar[XB_XGEN(b.x)]) == gen, bar);
            __builtin_amdgcn_fence(__ATOMIC_ACQUIRE, "agent");
            asm volatile("s_waitcnt vmcnt(0)" ::: "memory");
        }
    }
    __syncthreads();
}

__global__ void __launch_bounds__(512, 2) fwd_megakernel(Args args) {
    extern __shared__ __attribute__((aligned(16))) unsigned char lds_raw[];
    Frame F;
    F.lds = (LAS unsigned char*)lds_raw;
    F.tid = threadIdx.x; F.lane = F.tid & 63; F.wave = __builtin_amdgcn_readfirstlane(F.tid >> 6);
    F.G = gridDim.x; { const int bx = blockIdx.x; F.vcu = (F.G % 8 == 0) ? (bx % 8) * (F.G / 8) + bx / 8 : bx; }
    unsigned char* ws = args.ws;
    float* MOD = (float*)(ws + WS_MOD); float* X = (float*)(ws + WS_X); f16* H16 = (f16*)(ws + WS_H16); f16* HID = (f16*)(ws + WS_HID);
    const float* norm_g = args.in[4];
    cg::grid_group grid = cg::this_grid();
    volatile LAS unsigned* bst = (volatile LAS unsigned*)(F.lds + LDS_BYTES - 16);
    if (F.tid < 4) bst[F.tid] = 0u;
    __syncthreads();
    XcdBarrier xbar = xcd_barrier_post((unsigned*)(ws + WS_BAR), bst);

    const int lo = args.ph_lo, hi = args.ph_hi;
    if (hi > (1 << 20)) grid.sync();
#define IN(k) (lo <= (k) && (k) < hi)
#define SEAM(k) do { if (IN(k) && IN((k) + 1)) xcd_barrier(xbar); asm volatile("" : "+v"(F.tid), "+v"(F.lane)); } while (0)
#define RUN_GEMM(Ap, Bp, Mr, Nc, Kc) do { pg8::Gemm g{(const u16*)(Ap), (const u16*)(Bp), (Mr), (Nc), (Kc)}; pg8::StaticOrder S; S.init(g.M, g.N, F.G, (int)blockIdx.x); pg8::gemm_phase(F.lds, g, S, E); } while (0)
#define CONV_TAIL(job) do { const int rem_ = (66 * 22) % F.G; \
        if (rem_ == 0) conv_job(F, args, (job), F.vcu * 8 + F.wave, F.G * 8); \
        else if ((int)blockIdx.x >= rem_) conv_job(F, args, (job), ((int)blockIdx.x - rem_) * 8 + F.wave, (F.G - rem_) * 8); } while (0)
#define SSP(sl) ((float*)(ws + WS_SS) + (size_t)(sl) * MALL)
#define GSP(sl) ((const float*)(ws + WS_GS) + (sl) * 3072)
#define BIASP(sl) ((const float*)(ws + WS_BIAS) + (sl) * 3 * 5632)
#define EPI_F16(dst, ld, sc, sst, sl) pg8::Epi E{(dst), (sst), nullptr, nullptr, nullptr, SSP(sl), BIASP(sl), nullptr, nullptr, nullptr, 0, (ld), (sc), 0.f}
#define EPI_SWIGLU(sl) pg8::Epi E{HID, 0, nullptr, nullptr, nullptr, SSP(sl), BIASP(sl), nullptr, nullptr, nullptr, 1, FH, 0, 0.f}
#define EPI_RES(md, dst, gt, cf, nsl) pg8::Epi E{nullptr, 0, X, (dst), (gt), nullptr, nullptr, (nsl) >= 0 ? H16 : nullptr, GSP((nsl) >= 0 ? (nsl) : 0), SSP((nsl) >= 0 ? (nsl) : 0), (md), 0, 0, (cf)}
    if (IN(0)) { p0_phase(F, args); } SEAM(0);
    if (IN(1)) { p1_phase(F, args); } SEAM(1);
    if (IN(2)) { EPI_SWIGLU(0); RUN_GEMM(H16, ws + WS_WFI + 0 * WFI_SZ, MALL, 5632, 1024); CONV_TAIL(1); } SEAM(2);
#if REP_FFNIN > 1
    if (IN(2)) { EPI_SWIGLU(0); RUN_GEMM(H16, ws + WS_WFI + 0 * WFI_SZ, MALL, 5632, 1024); } SEAM(2);
#endif
    if (IN(3)) { EPI_RES(2, X, MOD + 0 * 3072 + 2048, 0.5f, 1); RUN_GEMM(HID, ws + WS_WFO + 0 * WFO_SZ, MLAT, 1024, FH); ctx_gemm<4, 2>(F, HID, FH, (const f16*)(ws + WS_WFO + 0 * WFO_SZ), FH, E); bias_rows(F, args, 1, 2); } SEAM(3);
    if (IN(5)) { EPI_F16((f16*)(ws + WS_U16), D, 0, 0, 1); RUN_GEMM(H16, ws + WS_WSI, MLAT, 1024, 1024); ctx_gemm<4, 0>(F, H16, D, (const f16*)(ws + WS_WSI), 1024, E); } SEAM(5);
    if (IN(6)) { s5_pass<false>(F, ws, args.in[17]); } SEAM(6);
#if REP_S5 == 2
    if (IN(6)) { s5_pass<false>(F, ws, args.in[17]); } SEAM(6);
#endif
    if (IN(7)) { s5_carry(F, ws); } SEAM(7);
    if (IN(8)) { s5_pass<true>(F, ws, args.in[17]); } SEAM(8);
#if REP_S5 == 4
    if (IN(8)) { s5_pass<true>(F, ws, args.in[17]); } SEAM(8);
#endif
    if (IN(9)) { EPI_RES(3, X, MOD + 1 * 3072 + 2048, 1.f, 2); RUN_GEMM(ws + WS_G16, ws + WS_WGLU, MLAT, 2048, 1024); ctx_gemm<8, 3>(F, (const f16*)(ws + WS_G16), D, (const f16*)(ws + WS_WGLU), 1024, E); } SEAM(9);
    if (IN(11)) { EPI_SWIGLU(2); RUN_GEMM(H16, ws + WS_WFI + 1 * WFI_SZ, MALL, 5632, 1024); CONV_TAIL(2); } SEAM(11);
    if (IN(12)) { EPI_RES(2, X, MOD + 2 * 3072 + 2048, 0.5f, 3); RUN_GEMM(HID, ws + WS_WFO + 1 * WFO_SZ, MLAT, 1024, FH); ctx_gemm<4, 2>(F, HID, FH, (const f16*)(ws + WS_WFO + 1 * WFO_SZ), FH, E); bias_rows(F, args, 3, 4); } SEAM(12);
    if (IN(14)) { EPI_SWIGLU(3); RUN_GEMM(H16, ws + WS_WFI + 2 * WFI_SZ, MALL, 5632, 1024); CONV_TAIL(3); } SEAM(14);
    if (IN(15)) { EPI_RES(2, X, MOD + 3 * 9216 + 0 * 3072 + 2048, 0.5f, 4); RUN_GEMM(HID, ws + WS_WFO + 2 * WFO_SZ, MLAT, 1024, FH); ctx_gemm<4, 2>(F, HID, FH, (const f16*)(ws + WS_WFO + 2 * WFO_SZ), FH, E); bias_rows(F, args, 5, 5); } SEAM(15);
    if (IN(17)) { EPI_F16((f16*)(ws + WS_Q16), D, 1024, (size_t)MALL * D, 4); RUN_GEMM(H16, ws + WS_WQKV, MLAT, 3072, 1024); ctx_gemm<8, 0, 1024>(F, H16, D, (const f16*)(ws + WS_WQKV), 1024, E); } SEAM(17);
    if (IN(19)) { attn_phase(F, ws, args.in[22], args.in[20], args.in[21]); } SEAM(19);
#if REP_ATTN > 1
    if (IN(19)) { attn_phase(F, ws, args.in[22], args.in[20], args.in[21]); } SEAM(19);
#endif
    if (IN(20)) { EPI_RES(2, X, MOD + 3 * 9216 + 1 * 3072 + 2048, 1.f, 5); RUN_GEMM(ws + WS_Q16, ws + WS_WO, MLAT, 1024, 1024); } SEAM(20);
    if (IN(22)) { EPI_SWIGLU(5); RUN_GEMM(H16, ws + WS_WFI + 3 * WFI_SZ, MLAT, 5632, 1024); } SEAM(22);
    if (IN(23)) { EPI_RES(2, args.out, MOD + 3 * 9216 + 2 * 3072 + 2048, 0.5f, -1); RUN_GEMM(HID, ws + WS_WFO + 3 * WFO_SZ, MLAT, 1024, FH); }
}

extern "C" void kernel_launch(void* const* d_in, const int* in_sizes, int n_in, void* d_out, int out_size, void* d_ws, size_t ws_size, hipStream_t stream) {
    static int grid = 0;
    if (grid == 0) {
        if (n_in != 24 || ws_size < WS_END) { fprintf(stderr, "kernel_launch: unexpected n_in %d or ws_size %zu (< %zu)\n", n_in, ws_size, (size_t)WS_END); grid = -1; return; }
        int dev = 0, cus = 0, per_cu = 0;
        hipGetDevice(&dev); hipDeviceGetAttribute(&cus, hipDeviceAttributeMultiprocessorCount, dev);
        if (hipFuncSetAttribute((const void*)fwd_megakernel, hipFuncAttributeMaxDynamicSharedMemorySize, LDS_BYTES) != hipSuccess) { fprintf(stderr, "kernel_launch: hipFuncSetAttribute failed\n"); }
        if (hipOccupancyMaxActiveBlocksPerMultiprocessor(&per_cu, (const void*)fwd_megakernel, 512, LDS_BYTES) != hipSuccess || per_cu < 1) { fprintf(stderr, "kernel_launch: occupancy query says %d\n", per_cu); per_cu = 1; }
        (void)hipGetLastError();
        grid = cus * 1;
        if (grid <= 0) grid = 256;
    }
    if (grid < 0) return;
    hipMemsetAsync((char*)d_ws + WS_MOD, 0, MOD_BYTES, stream);
    Args a{};
    for (int i = 0; i < 24; ++i) a.in[i] = (const float*)d_in[i];
    a.out = (float*)d_out; a.ws = (unsigned char*)d_ws;
#if MK_COOP
    a.ph_lo = 0; a.ph_hi = NPHASE;
    void* kargs[] = {&a};
    hipError_t e = hipLaunchCooperativeKernel((const void*)fwd_megakernel, dim3(grid), dim3(512), kargs, LDS_BYTES, stream);
    if (e != hipSuccess) fprintf(stderr, "cooperative launch failed: %s (grid %d)\n", hipGetErrorString(e), grid);
#else
    for (int ph = 0; ph < NPHASE; ++ph) {
        a.ph_lo = ph; a.ph_hi = ph + 1;
        hipLaunchKernelGGL(fwd_megakernel, dim3(grid), dim3(512), LDS_BYTES, stream, a);
    }
#endif
}
```
